# Optimizing an MI355X kernel written in HIP

```python
import math
import jax, jax.numpy as jnp
from jax import lax
import numpy as np

D_MODEL = 1024
BATCH = 2
SEQ = 8192
DEPTH = 1

CHUNK = 64
A_HEADS = 4
A_HEAD_DIM = 64
A_VDIM = 2 * A_HEAD_DIM
B_HEADS = 8
B_HEAD_DIM = 64
B_LEFT_CHUNKS = 8
B_MAX_REL = 128
T5_BUCKETS = 32
T5_MAX_DIST = 128
N_GROUPS = 4
EXPERTS_PER_GROUP = 8
N_EXPERTS = N_GROUPS * EXPERTS_PER_GROUP
TOP_K = 2
D_EXPERT = 512
MOE_BLOCK = 128
Q_BLOCK = 128
EPS = 1e-6

A_QK_W = A_HEADS * A_HEAD_DIM
A_V_W = A_HEADS * A_VDIM
B_W = B_HEADS * B_HEAD_DIM
PROJ_SIZES = [A_QK_W] * 4 + [A_V_W] + [B_W] * 3 + [D_MODEL] * 2
PROJ_W = sum(PROJ_SIZES)

kernel_name = "hybrid_diffattn_bandattn_hiermoe"


def rmsnorm(x, g):
    xf = x.astype(jnp.float32)
    y = xf * lax.rsqrt(jnp.mean(xf * xf, axis=-1, keepdims=True) + EPS)
    return (y * g.astype(jnp.float32)).astype(x.dtype)


def t5_bucket(rel):
    nb = T5_BUCKETS // 2
    max_exact = nb // 2
    side = jnp.where(rel > 0, nb, 0)
    n = jnp.abs(rel)
    nf = jnp.maximum(n, 1).astype(jnp.float32)
    large = max_exact + (jnp.log(nf / max_exact) / math.log(T5_MAX_DIST / max_exact)
                         * (nb - max_exact)).astype(jnp.int32)
    large = jnp.minimum(large, nb - 1)
    return side + jnp.where(n < max_exact, n, large)


def diff_attention(q1, q2, k1, k2, v, t5_table, lam):
    bsz, s_len, h, d = q1.shape
    nqb = s_len // Q_BLOCK
    scale = d ** -0.5
    k_pos = jnp.arange(s_len)

    def to_blocks(t):
        return t.reshape(bsz, nqb, Q_BLOCK, h, d).transpose(1, 0, 2, 3, 4)

    def block(args):
        qb1, qb2, bi = args
        q_pos = bi * Q_BLOCK + jnp.arange(Q_BLOCK)
        bias = t5_table[t5_bucket(k_pos[None, :] - q_pos[:, None])]
        bias = jnp.transpose(bias, (2, 0, 1)).astype(jnp.float32)
        allowed = (k_pos[None, :] // CHUNK) <= (q_pos[:, None] // CHUNK)

        def probs(qb, kk):
            s = jnp.einsum('bqhd,bkhd->bhqk', qb, kk).astype(jnp.float32) * scale + bias
            s = jnp.where(allowed, s, -1e30)
            return jax.nn.softmax(s, axis=-1)

        attn = probs(qb1, k1) - lam * probs(qb2, k2)
        return jnp.einsum('bhqk,bkhe->bqhe', attn.astype(v.dtype), v)

    out = lax.map(block, (to_blocks(q1), to_blocks(q2), jnp.arange(nqb)))
    return out.transpose(1, 0, 2, 3, 4).reshape(bsz, s_len, h, v.shape[-1])


def chunk_band_attention(q, k, v, rel_table):
    bsz, s_len, h, d = q.shape
    nc = s_len // CHUNK
    w = B_LEFT_CHUNKS
    band_len = (w + 1) * CHUNK
    qc = q.reshape(bsz, nc, CHUNK, h, d)

    def band(t):
        tp = jnp.pad(t, ((0, 0), (w * CHUNK, 0), (0, 0), (0, 0)))
        tp = tp.reshape(bsz, nc + w, CHUNK, h, t.shape[-1])
        return jnp.concatenate([tp[:, j:j + nc] for j in range(w + 1)], axis=2)

    kb, vb = band(k), band(v)
    qi = jnp.arange(CHUNK)
    kj = jnp.arange(band_len)
    rel = kj[None, :] - w * CHUNK - qi[:, None]
    rel_idx = jnp.clip(rel, -B_MAX_REL, B_MAX_REL) + B_MAX_REL
    bias = jnp.transpose(rel_table[rel_idx], (2, 0, 1)).astype(jnp.float32)
    valid = (jnp.arange(nc)[:, None] - w + kj[None, :] // CHUNK) >= 0
    s = jnp.einsum('bcqhd,bckhd->bchqk', qc, kb).astype(jnp.float32) * (d ** -0.5) + bias
    s = jnp.where(valid[None, :, None, None, :], s, -1e30)
    p = jax.nn.softmax(s, axis=-1)
    o = jnp.einsum('bchqk,bckhe->bcqhe', p.astype(v.dtype), vb)
    return o.reshape(bsz, s_len, h, d)


def hier_moe(x, w_rg, b_rg, w_re, b_re, w_gate, w_up, w_down):
    bsz, s_len, dm = x.shape
    n_tok = bsz * s_len
    xf = x.reshape(n_tok, dm)
    g_prob = jax.nn.softmax((xf @ w_rg).astype(jnp.float32) + b_rg.astype(jnp.float32), axis=-1)
    p_g, g_idx = lax.top_k(g_prob, 1)
    e_logits = ((xf @ w_re).astype(jnp.float32) + b_re.astype(jnp.float32)).reshape(n_tok, N_GROUPS, EXPERTS_PER_GROUP)
    e_in_group = jnp.take_along_axis(e_logits, g_idx[:, :, None], axis=1)[:, 0]
    top_l, top_j = lax.top_k(e_in_group, TOP_K)
    comb = p_g * jax.nn.softmax(top_l, axis=-1)
    expert_id = g_idx * EXPERTS_PER_GROUP + top_j

    n_assign = n_tok * TOP_K
    e_flat = expert_id.reshape(n_assign)
    tok_flat = jnp.repeat(jnp.arange(n_tok, dtype=jnp.int32), TOP_K)
    w_flat = comb.reshape(n_assign)
    order = jnp.argsort(e_flat)
    se, stok, sw = e_flat[order], tok_flat[order], w_flat[order]
    counts = jax.ops.segment_sum(jnp.ones((n_assign,), jnp.int32), e_flat, num_segments=N_EXPERTS)
    padded = ((counts + MOE_BLOCK - 1) // MOE_BLOCK) * MOE_BLOCK
    start = jnp.cumsum(counts) - counts
    pend = jnp.cumsum(padded)
    pstart = pend - padded
    dest = pstart[se] + (jnp.arange(n_assign) - start[se])
    n_blocks = (n_assign + MOE_BLOCK - 1) // MOE_BLOCK + N_EXPERTS
    n_rows = n_blocks * MOE_BLOCK
    buf_tok = jnp.zeros((n_rows,), jnp.int32).at[dest].set(stok)
    buf_w = jnp.zeros((n_rows,), jnp.float32).at[dest].set(sw)
    block_expert = jnp.minimum(jnp.searchsorted(pend, jnp.arange(n_blocks) * MOE_BLOCK, side='right'),
                               N_EXPERTS - 1)

    def run_block(args):
        tok, e = args
        xb = xf[tok]
        hb = jax.nn.silu(xb @ w_gate[e]) * (xb @ w_up[e])
        return hb @ w_down[e]

    yb = lax.map(run_block, (buf_tok.reshape(n_blocks, MOE_BLOCK), block_expert))
    yb = yb.reshape(n_rows, dm) * buf_w[:, None].astype(yb.dtype)
    y = jnp.zeros((n_tok, dm), x.dtype).at[buf_tok].add(yb.astype(x.dtype))
    return y.reshape(bsz, s_len, dm)


def setup_inputs(seed: int = 0) -> dict:
    key = jax.random.key(seed)
    ks = jax.random.split(key, 24)
    f = jnp.float32

    def nrm(k, shape, scale):
        return jax.random.normal(k, shape, f) * scale

    def gain(k, shape):
        return 1.0 + 0.05 * jax.random.normal(k, shape, f)

    L = DEPTH
    return {
        "x": nrm(ks[0], (BATCH, SEQ, D_MODEL), 1.0),
        "norm1_g": gain(ks[1], (L, D_MODEL)),
        "w_in": nrm(ks[2], (L, D_MODEL, PROJ_W), D_MODEL ** -0.5),
        "a_qnorm_g": gain(ks[3], (L, A_HEAD_DIM)),
        "a_knorm_g": gain(ks[4], (L, A_HEAD_DIM)),
        "a_lambda": nrm(ks[5], (L, 4, A_HEAD_DIM), 0.1),
        "a_subln_g": gain(ks[6], (L, A_VDIM)),
        "t5_table": nrm(ks[7], (T5_BUCKETS, A_HEADS), 0.5),
        "b_qnorm_g": gain(ks[8], (L, B_HEAD_DIM)),
        "b_knorm_g": gain(ks[9], (L, B_HEAD_DIM)),
        "b_rel_table": nrm(ks[10], (L, 2 * B_MAX_REL + 1, B_HEADS), 0.5),
        "w_branch_a": nrm(ks[11], (L, A_V_W, D_MODEL), A_V_W ** -0.5),
        "w_branch_b": nrm(ks[12], (L, B_W, D_MODEL), B_W ** -0.5),
        "w_out": nrm(ks[13], (L, D_MODEL, D_MODEL), D_MODEL ** -0.5),
        "norm2_g": gain(ks[14], (L, D_MODEL)),
        "w_router_group": nrm(ks[15], (L, D_MODEL, N_GROUPS), D_MODEL ** -0.5),
        "b_router_group": nrm(ks[16], (L, N_GROUPS), 0.01),
        "w_router_expert": nrm(ks[17], (L, D_MODEL, N_EXPERTS), D_MODEL ** -0.5),
        "b_router_expert": nrm(ks[18], (L, N_EXPERTS), 0.01),
        "w_gate": nrm(ks[19], (L, N_EXPERTS, D_MODEL, D_EXPERT), D_MODEL ** -0.5),
        "w_up": nrm(ks[20], (L, N_EXPERTS, D_MODEL, D_EXPERT), D_MODEL ** -0.5),
        "w_down": nrm(ks[21], (L, N_EXPERTS, D_EXPERT, D_MODEL), D_EXPERT ** -0.5),
    }


def reference(x, norm1_g, w_in, a_qnorm_g, a_knorm_g, a_lambda, a_subln_g, t5_table,
              b_qnorm_g, b_knorm_g, b_rel_table, w_branch_a, w_branch_b, w_out, norm2_g,
              w_router_group, b_router_group, w_router_expert, b_router_expert,
              w_gate, w_up, w_down):
    bsz, s_len, _ = x.shape
    split_idx = np.cumsum(PROJ_SIZES)[:-1].tolist()

    def heads(t, h):
        return t.reshape(bsz, s_len, h, -1)

    for l in range(DEPTH):
        xn = rmsnorm(x, norm1_g[l])
        proj = xn @ w_in[l]
        q1, q2, k1, k2, va, qb, kb, vb, gate_a, gate_b = jnp.split(proj, split_idx, axis=-1)

        q1 = rmsnorm(heads(q1, A_HEADS), a_qnorm_g[l])
        q2 = rmsnorm(heads(q2, A_HEADS), a_qnorm_g[l])
        k1 = rmsnorm(heads(k1, A_HEADS), a_knorm_g[l])
        k2 = rmsnorm(heads(k2, A_HEADS), a_knorm_g[l])
        va = heads(va, A_HEADS)
        lam_init = 0.8 - 0.6 * math.exp(-0.3 * l)
        lp = a_lambda[l].astype(jnp.float32)
        lam = jnp.exp(jnp.sum(lp[0] * lp[1])) - jnp.exp(jnp.sum(lp[2] * lp[3])) + lam_init
        oa = diff_attention(q1, q2, k1, k2, va, t5_table, lam)
        oa = rmsnorm(oa, a_subln_g[l]) * (1.0 - lam_init)
        ya = oa.reshape(bsz, s_len, A_V_W) @ w_branch_a[l]

        qb = rmsnorm(heads(qb, B_HEADS), b_qnorm_g[l])
        kb = rmsnorm(heads(kb, B_HEADS), b_knorm_g[l])
        vb = heads(vb, B_HEADS)
        ob = chunk_band_attention(qb, kb, vb, b_rel_table[l])
        yb = ob.reshape(bsz, s_len, B_W) @ w_branch_b[l]

        mixed = jax.nn.sigmoid(gate_a) * ya + jax.nn.sigmoid(gate_b) * yb
        x = x + mixed @ w_out[l]

        hn = rmsnorm(x, norm2_g[l])
        x = x + hier_moe(hn, w_router_group[l], b_router_group[l], w_router_expert[l],
                         b_router_expert[l], w_gate[l], w_up[l], w_down[l])
    return x
```

```cpp
#include <hip/hip_runtime.h>
#include <cstdio>
#include <cstdint>

#ifndef MK_N_LAUNCHES
#define MK_N_LAUNCHES 1
#endif
constexpr int NPHASE = 10;

#define GAS __attribute__((address_space(1)))
#define LAS __attribute__((address_space(3)))
typedef unsigned short bf16;
typedef short bf16x8 __attribute__((ext_vector_type(8)));
typedef short s16x4 __attribute__((ext_vector_type(4)));
typedef float f32x4 __attribute__((ext_vector_type(4)));
typedef float f32x16 __attribute__((ext_vector_type(16)));
typedef unsigned u32x4 __attribute__((ext_vector_type(4)));
typedef unsigned u32x2 __attribute__((ext_vector_type(2)));

constexpr int T = 16384, SEQ = 8192, D = 1024, PROJ = 5120;
constexpr int NEXP = 32, DEXP = 512;
constexpr int MAXSLOT = 40960, MAXTILES = MAXSLOT / 256;
constexpr float EPS = 1e-6f;
constexpr float LOG2E = 1.4426950408889634f;
constexpr float C2 = 0.125f * LOG2E;

constexpr size_t MiB = 1u << 20;
constexpr size_t WS_CTL = 0, CTL_ZERO_BYTES = 64 * 1024;
constexpr size_t WS_TBLA = 1 * MiB;
constexpr size_t WS_TBLB = WS_TBLA + 4096;
constexpr size_t WS_LAM = WS_TBLB + 8192;
constexpr size_t WS_TILEE = WS_LAM + 256;
constexpr size_t WS_WR = 1 * MiB + 64 * 1024;
constexpr size_t WS_TOKINFO = 1 * MiB + 512 * 1024;
constexpr size_t WS_HIST = 2 * MiB;
constexpr size_t WS_SLOTTOK = 2 * MiB + 64 * 1024;
constexpr size_t WS_SLOTW = 2 * MiB + 256 * 1024;
constexpr size_t WS_TOKSLOT = 2 * MiB + 512 * 1024;
constexpr size_t WS_WINT = 4 * MiB;
constexpr size_t WS_WABT = 14 * MiB;
constexpr size_t WS_WOT = 16 * MiB;
constexpr size_t WS_WGUT = 18 * MiB;
constexpr size_t WS_WDT = 82 * MiB;
constexpr size_t WS_XB = 114 * MiB;
constexpr size_t WS_OAB = 114 * MiB;
constexpr size_t WS_QK = 146 * MiB;
constexpr size_t WS_MIXED = 146 * MiB;
constexpr size_t WS_VA = 178 * MiB;
constexpr size_t WS_QB = 194 * MiB, WS_KB = 210 * MiB, WS_VB = 226 * MiB;
constexpr size_t WS_HN = 114 * MiB;
constexpr size_t WS_H = 202 * MiB;
constexpr size_t WS_Y = 114 * MiB;
constexpr size_t WS_END = 242 * MiB;
constexpr int CW_BAR = 1024;

constexpr int RING_BYTES = 131072;
constexpr int MISC_OFF = RING_BYTES;
constexpr int LDS_BYTES = 147456;

#define LDS_WAIT() asm volatile("s_waitcnt lgkmcnt(0)" ::: "memory")
#define VM_WAIT() asm volatile("s_waitcnt vmcnt(0)" ::: "memory")
__device__ __forceinline__ unsigned cvt_pk_bf16(float lo, float hi) { unsigned r; asm volatile("v_cvt_pk_bf16_f32 %0, %1, %2" : "=v"(r) : "v"(lo), "v"(hi)); return r; }
__device__ __forceinline__ float bf2f(unsigned short b) { return __uint_as_float((unsigned)b << 16); }
__device__ __forceinline__ float wave_sum(float v) {
#pragma unroll
    for (int o = 1; o < 64; o <<= 1) v += __shfl_xor(v, o);
    return v;
}

#define XB_TMO      128
#define XB_XCNT(j)  (256  + 64 * (j))
#define XB_XSUB(j)  (1280 + 64 * (j))
#define XB_XGEN(j)  (2304 + 64 * (j))
#define XB_TOP      3328
#define XB_TOPGEN   3392
#define XCD_BAR_WORDS 3456
#define XB_SPIN_CAP (1u << 18)
__device__ __forceinline__ unsigned xb_ld(unsigned* p)              { return __hip_atomic_load(p, __ATOMIC_RELAXED, __HIP_MEMORY_SCOPE_AGENT); }
__device__ __forceinline__ unsigned xb_add(unsigned* p, unsigned v) { return __hip_atomic_fetch_add(p, v, __ATOMIC_RELAXED, __HIP_MEMORY_SCOPE_AGENT); }
__device__ __forceinline__ unsigned xb_xcc_id() { return (unsigned)__builtin_amdgcn_s_getreg((3 << 11) | 20) & 0xFu; }
#define XB_SPIN(cond, bar) do { unsigned _sp = 0; while (cond) { __builtin_amdgcn_s_sleep(1); \
    if ((++_sp & 255u) == 0u) { if (xb_ld(&(bar)[XB_TMO])) break; if (_sp > XB_SPIN_CAP) { atomicAdd(&(bar)[XB_TMO], 1u); break; } } } } while (0)
struct XcdBarrier { unsigned* bar; unsigned x; volatile LAS unsigned* st; };
__device__ __forceinline__ XcdBarrier xcd_barrier_post(unsigned* bar, volatile LAS unsigned* st) {
    XcdBarrier b; b.bar = bar; b.x = xb_xcc_id(); b.st = st;
    if (threadIdx.x == 0) (void)xb_add(&bar[XB_XCNT(b.x)], 1u);
    return b;
}
__device__ __forceinline__ void xcd_barrier_complete(unsigned* bar, unsigned x, unsigned& nloc, unsigned& nx) {
    const unsigned G = gridDim.x * gridDim.y * gridDim.z;
    unsigned sum, cnt, mine, sp = 0u;
    for (;;) {
        sum = 0u; cnt = 0u; mine = 0u;
#pragma unroll
        for (unsigned j = 0; j < 16; ++j) { const unsigned c = xb_ld(&bar[XB_XCNT(j)]); sum += c; cnt += (c > 0u) ? 1u : 0u; mine = (j == x) ? c : mine; }
        if (sum == G) break;
        __builtin_amdgcn_s_sleep(1);
        if ((++sp & 255u) == 0u) { if (xb_ld(&bar[XB_TMO])) break; if (sp > XB_SPIN_CAP) { atomicAdd(&bar[XB_TMO], 1u); break; } }
    }
    nloc = mine > 0u ? mine : 1u; nx = cnt > 0u ? cnt : 1u;
}
__device__ __forceinline__ void xcd_barrier(const XcdBarrier& b) {
    asm volatile("s_waitcnt vmcnt(0)" ::: "memory");
    __syncthreads();
    if (threadIdx.x == 0) {
        unsigned* bar = b.bar;
        __builtin_amdgcn_s_waitcnt(0);
        unsigned nloc = b.st[0], nx = b.st[1];
        if (nloc == 0u) { xcd_barrier_complete(bar, b.x, nloc, nx); b.st[0] = nloc; b.st[1] = nx; }
        const unsigned old = xb_add(&bar[XB_XSUB(b.x)], 1u);
        const unsigned gen = old / nloc;
        if (old + 1u == (gen + 1u) * nloc) {
            __builtin_amdgcn_fence(__ATOMIC_RELEASE, "agent");
            asm volatile("s_waitcnt vmcnt(0)" ::: "memory");
            const unsigned og = xb_add(&bar[XB_TOP], 1u);
            const unsigned tg = og / nx;
            if (og + 1u == (tg + 1u) * nx) xb_add(&bar[XB_TOPGEN], 1u);
            else XB_SPIN(xb_ld(&bar[XB_TOPGEN]) == tg, bar);
            __builtin_amdgcn_fence(__ATOMIC_ACQUIRE, "agent");
            xb_add(&bar[XB_XGEN(b.x)], 1u);
            asm volatile("s_waitcnt vmcnt(0)" ::: "memory");
        } else {
            XB_SPIN(xb_ld(&bar[XB_XGEN(b.x)]) == gen, bar);
            __builtin_amdgcn_fence(__ATOMIC_ACQUIRE, "agent");
            asm volatile("s_waitcnt vmcnt(0)" ::: "memory");
        }
    }
    __syncthreads();
}

namespace pg8 {
constexpr int BM = 256, BK = 64, HALF = 128, HTB = HALF * BK * 2, NXCD = 8, WGM = 8;
__host__ __device__ __forceinline__ int lds_byte(int r, int c) { const int st = (r >> 4) * 2 + (c >> 5), rr = r & 15, cc = c & 31, ob = rr * 64 + cc * 2; return st * 1024 + (ob ^ (((ob >> 9) & 1) << 5)); }
__host__ __device__ __forceinline__ void stage_rc(int b, int& R, int& C) { const int st = b / 1024, sb = b % 1024, swz = sb ^ (((sb >> 9) & 1) << 5); R = (st >> 1) * 16 + swz / 64; C = (st & 1) * 32 + (swz % 64) / 2; }
__host__ __device__ __forceinline__ int perm32(int rho) { const int n = rho >> 4, i = rho & 15; return 8 * (i >> 2) + 4 * n + (i & 3); }

struct Unit { int pm, pn, e, part; };

__device__ __forceinline__ void tile_of(int L, int nM, int nN, int& pm, int& pn) {
    const int nwg = nM * nN; int wgid = L;
    { const int q = nwg / NXCD, r = nwg % NXCD, xcd = wgid % NXCD, off = wgid / NXCD; wgid = (xcd < r ? xcd * (q + 1) : r * (q + 1) + (xcd - r) * q) + off; }
    const int nig = WGM * nN, gid = wgid / nig, fm = gid * WGM, gsz = (nM - fm) < WGM ? (nM - fm) : WGM;
    pm = fm + ((wgid % nig) % gsz); pn = (wgid % nig) / gsz;
}

template <class Epi, class Sched, bool ALIGN_EPI>
__device__ __forceinline__ void gemm_phase(LAS unsigned char* lds, const int K, const Sched& S, const Epi& E) {
    const int tid = threadIdx.x, wid = __builtin_amdgcn_readfirstlane(tid >> 6), lane = tid & 63, wr = wid >> 2, wc = wid & 3, fr = lane & 15, fq = lane >> 4;
    const int nt = K / BK;
    int Rr[2], Cc[2]; unsigned voffB[2];
#pragma unroll
    for (int i = 0; i < 2; ++i) { int R, C; stage_rc(tid * 16 + i * 8192, R, C); Rr[i] = R; Cc[i] = C; const int Rb = Epi::PERM ? ((R & ~31) + perm32(R & 31)) : R; voffB[i] = (unsigned)(Rb * S.ldb + C) * 2u; }
    const size_t kstep = (size_t)(BK * 2);
    const size_t hstepB = (size_t)HALF * S.ldb * 2;
    const unsigned ldsw = (unsigned)wid * 1024u;
    const int aoff = lds_byte(wr * 64 + fr, fq * 8), boff = lds_byte(wc * 32 + fr, fq * 8);
#define PG8_SA(b, h) (((b) * 2 + (h)) * HTB)
#define PG8_SB(b, h) ((4 + (b) * 2 + (h)) * HTB)
#define PG8_STAGE_A(bufoff, gbase, offh) do { _Pragma("unroll") for (int _i = 0; _i < 2; ++_i) \
        __builtin_amdgcn_global_load_lds((const unsigned*)((const char*)(gbase) + (offh)[_i]), (LAS unsigned*)(lds + (bufoff) + ldsw + _i * 8192), 16, 0, 0); } while (0)
#define PG8_STAGE_B(bufoff, gbase) do { _Pragma("unroll") for (int _i = 0; _i < 2; ++_i) \
        __builtin_amdgcn_global_load_lds((const unsigned*)((const char*)(gbase) + voffB[_i]), (LAS unsigned*)(lds + (bufoff) + ldsw + _i * 8192), 16, 0, 0); } while (0)
#define PG8_LDA(dst, b, h) do { _Pragma("unroll") for (int m = 0; m < 4; ++m) _Pragma("unroll") for (int k = 0; k < 2; ++k) dst[m][k] = *(const LAS bf16x8*)(lds + PG8_SA(b, h) + aoff + m * 2048 + k * 1024); } while (0)
#define PG8_LDB(dst, b, h) do { _Pragma("unroll") for (int n = 0; n < 2; ++n) _Pragma("unroll") for (int k = 0; k < 2; ++k) dst[n][k] = *(const LAS bf16x8*)(lds + PG8_SB(b, h) + boff + n * 2048 + k * 1024); } while (0)
#define PG8_MMA(ai, bj, At, Bt) do { __builtin_amdgcn_s_setprio(1); _Pragma("unroll") for (int m = 0; m < 4; ++m) _Pragma("unroll") for (int n = 0; n < 2; ++n) _Pragma("unroll") for (int k = 0; k < 2; ++k) \
        acc[ai][bj][m][n] = __builtin_amdgcn_mfma_f32_16x16x32_bf16(Bt[n][k], At[m][k], acc[ai][bj][m][n], 0, 0, 0); __builtin_amdgcn_s_setprio(0); } while (0)
#define PG8_WAIT_V(n) asm volatile("s_waitcnt vmcnt(" #n ")" ::: "memory")
#define PG8_WAIT_L(n) asm volatile("s_waitcnt lgkmcnt(" #n ")" ::: "memory")
#define PG8_BAR __builtin_amdgcn_s_barrier()
#define PG8_SCHED __builtin_amdgcn_sched_barrier(0)
    Unit cur, nxt; int ui = 0;
    if (!S.next(0, cur)) return;
    f32x4 acc[2][2][4][2];
#pragma unroll
    for (int a = 0; a < 2; ++a)
#pragma unroll
        for (int b = 0; b < 2; ++b)
#pragma unroll
            for (int m = 0; m < 4; ++m)
#pragma unroll
                for (int n = 0; n < 2; ++n) acc[a][b][m][n] = (f32x4){0.f, 0.f, 0.f, 0.f};
    bf16x8 At[4][2], B0[2][2], B1[2][2];
    const char* cA = S.a_base(cur); const char* cB = S.b_base(cur);
    unsigned oA[2][2], nraw[2][2];
    {
        unsigned raw[2][2];
#pragma unroll
        for (int h = 0; h < 2; ++h)
#pragma unroll
            for (int i = 0; i < 2; ++i) raw[h][i] = S.a_raw(cur, h, Rr[i]);
        if (Sched::GATHER) PG8_WAIT_V(0);
#pragma unroll
        for (int h = 0; h < 2; ++h)
#pragma unroll
            for (int i = 0; i < 2; ++i) oA[h][i] = S.a_conv(raw[h][i], Cc[i]);
    }
    PG8_STAGE_B(PG8_SB(0, 0), cB); PG8_STAGE_B(PG8_SB(0, 1), cB + hstepB); PG8_STAGE_A(PG8_SA(0, 0), cA, oA[0]); PG8_STAGE_A(PG8_SA(0, 1), cA, oA[1]);
    if (wr == 1) PG8_BAR;
    PG8_WAIT_V(2); PG8_BAR;
    PG8_STAGE_B(PG8_SB(1, 0), cB + kstep); PG8_STAGE_A(PG8_SA(1, 0), cA + kstep, oA[0]); PG8_STAGE_B(PG8_SB(1, 1), cB + hstepB + kstep);
    PG8_WAIT_V(6); PG8_BAR;
    for (;;) {
        const bool has_next = S.next(ui + 1, nxt);
        const char* nA = has_next ? S.a_base(nxt) : cA; const char* nB = has_next ? S.b_base(nxt) : cB;
        if (has_next) {
#pragma unroll
            for (int h = 0; h < 2; ++h)
#pragma unroll
                for (int i = 0; i < 2; ++i) nraw[h][i] = S.a_raw(nxt, h, Rr[i]);
        }
        for (int t = 0; t < nt; t += 2) {
            const bool last = (t == nt - 2);
            const char* a1 = cA + (size_t)(t + 1) * kstep;
            const char* a2 = last ? nA : cA + (size_t)(t + 2) * kstep; const char* b2 = last ? nB : cB + (size_t)(t + 2) * kstep;
            const char* a3 = a2 + kstep; const char* b3 = b2 + kstep;
            PG8_LDB(B0, 0, 0); PG8_LDB(B1, 0, 1); PG8_SCHED; PG8_LDA(At, 0, 0); PG8_STAGE_A(PG8_SA(1, 1), a1, oA[1]);
            PG8_WAIT_V(8); PG8_WAIT_L(0); PG8_BAR; PG8_MMA(0, 0, At, B0); PG8_MMA(0, 1, At, B1); PG8_BAR; PG8_SCHED;
            if (last && has_next) {
#pragma unroll
                for (int h = 0; h < 2; ++h)
#pragma unroll
                    for (int i = 0; i < 2; ++i) oA[h][i] = S.a_conv(nraw[h][i], Cc[i]);
            }
            PG8_LDA(At, 0, 1); PG8_STAGE_B(PG8_SB(0, 0), b2); PG8_STAGE_B(PG8_SB(0, 1), b2 + hstepB); PG8_STAGE_A(PG8_SA(0, 0), a2, oA[0]);
            PG8_WAIT_V(8); PG8_WAIT_L(0); PG8_BAR; PG8_MMA(1, 0, At, B0); PG8_MMA(1, 1, At, B1); PG8_BAR; PG8_SCHED;
            PG8_LDB(B0, 1, 0); PG8_LDB(B1, 1, 1); PG8_SCHED; PG8_LDA(At, 1, 0); PG8_STAGE_A(PG8_SA(0, 1), a2, oA[1]);
            PG8_WAIT_V(8); PG8_WAIT_L(0); PG8_BAR; PG8_MMA(0, 0, At, B0); PG8_MMA(0, 1, At, B1); PG8_BAR; PG8_SCHED;
            PG8_LDA(At, 1, 1); PG8_STAGE_B(PG8_SB(1, 0), b3); PG8_STAGE_B(PG8_SB(1, 1), b3 + hstepB); PG8_STAGE_A(PG8_SA(1, 0), a3, oA[0]);
            PG8_WAIT_V(8); PG8_WAIT_L(0); PG8_BAR; PG8_MMA(1, 0, At, B0); PG8_MMA(1, 1, At, B1); PG8_BAR; PG8_SCHED;
        }
        if constexpr (ALIGN_EPI) { if (wr == 0) PG8_BAR; }
        E(acc, cur, wr, wc, fr, fq);
        if (!has_next) break;
        if (!E.keep(cur)) {
#pragma unroll
            for (int a = 0; a < 2; ++a)
#pragma unroll
                for (int b = 0; b < 2; ++b)
#pragma unroll
                    for (int m = 0; m < 4; ++m)
#pragma unroll
                        for (int n = 0; n < 2; ++n) acc[a][b][m][n] = (f32x4){0.f, 0.f, 0.f, 0.f};
        }
        cur = nxt; cA = nA; cB = nB; ++ui;
        if constexpr (ALIGN_EPI) { if (wr == 1) PG8_BAR; }
    }
    PG8_WAIT_V(0);
    if constexpr (!ALIGN_EPI) { if (wr == 0) PG8_BAR; }
    PG8_BAR;
#undef PG8_SA
#undef PG8_SB
#undef PG8_STAGE_A
#undef PG8_STAGE_B
#undef PG8_LDA
#undef PG8_LDB
#undef PG8_MMA
#undef PG8_WAIT_V
#undef PG8_WAIT_L
#undef PG8_BAR
#undef PG8_SCHED
}

struct DenseSched {
    static constexpr bool GATHER = false;
    const char* A; const char* Bt; int lda, ldb, nM, nN, G, c, nparts, K;
    __device__ __forceinline__ bool next(int i, Unit& u) const {
        const int ti = i / nparts; const long L = (long)ti * G + c; if (L >= (long)nM * nN) return false;
        tile_of((int)L, nM, nN, u.pm, u.pn); u.part = i - ti * nparts; u.e = 0; return true;
    }
    __device__ __forceinline__ const char* a_base(const Unit& u) const { return A + (size_t)u.part * K * 2; }
    __device__ __forceinline__ const char* b_base(const Unit& u) const { return Bt + ((size_t)u.pn * BM * ldb + (size_t)u.part * K) * 2; }
    __device__ __forceinline__ unsigned a_raw(const Unit& u, int h, int R) const { return (unsigned)(u.pm * BM + h * HALF + R); }
    __device__ __forceinline__ unsigned a_conv(unsigned raw, int C) const { return (raw * (unsigned)lda + (unsigned)C) * 2u; }
};
template <bool GATHER_>
struct MoeSched {
    static constexpr bool GATHER = GATHER_;
    const char* A; const char* Bt; const int* slot_tok; int lda, ldb, G, c, nunits; int e0, e1, e2; size_t bstride;
    __device__ __forceinline__ bool next(int i, Unit& u) const {
        const int L = i * G + c; if (i > 2 || L >= nunits) return false;
        u.pm = L >> 2; u.pn = L & 3; u.e = (i == 0) ? e0 : (i == 1 ? e1 : e2); u.part = 0; return true;
    }
    __device__ __forceinline__ const char* a_base(const Unit&) const { return A; }
    __device__ __forceinline__ const char* b_base(const Unit& u) const { return Bt + (size_t)u.e * bstride + (size_t)u.pn * BM * ldb * 2; }
    __device__ __forceinline__ unsigned a_raw(const Unit& u, int h, int R) const {
        const unsigned row = (unsigned)(u.pm * BM + h * HALF + R);
        if (GATHER_) { unsigned v; const int* p = slot_tok + row; asm volatile("global_load_dword %0, %1, off" : "=v"(v) : "v"(p) : "memory"); return v; }
        return row;
    }
    __device__ __forceinline__ unsigned a_conv(unsigned raw, int C) const {
        if (GATHER_) { unsigned o; const unsigned c2 = (unsigned)C * 2u; asm volatile("v_mad_u32_u24 %0, %1, %2, %3" : "=v"(o) : "v"(raw), "v"((unsigned)lda * 2u), "v"(c2)); return o; }
        return (raw * (unsigned)lda + (unsigned)C) * 2u;
    }
};
}

struct EpiProj {
    static constexpr bool PERM = true;
    bf16* QK; bf16* VA; bf16* QB; bf16* KB; bf16* VB; bf16* GATES;
    const float *aq, *ak, *bq, *bk;
    __device__ __forceinline__ bool keep(const pg8::Unit&) const { return false; }
    __device__ __forceinline__ void operator()(f32x4 (&acc)[2][2][4][2], const pg8::Unit& u, int wr, int wc, int fr, int fq) const {
        const int pn = u.pn; int mode, ld, colbase; bf16* dst; const float* gain = nullptr; float scale = 1.f;
        if (pn < 4) { mode = 1; dst = QK + (size_t)pn * T * 256; ld = 256; colbase = 0; gain = pn < 2 ? aq : ak; scale = pn < 2 ? C2 : 1.f; }
        else if (pn < 6) { mode = 0; dst = VA; ld = 512; colbase = (pn - 4) * 256; }
        else if (pn < 8) { mode = 1; dst = QB; ld = 512; colbase = (pn - 6) * 256; gain = bq; scale = C2; }
        else if (pn < 10) { mode = 1; dst = KB; ld = 512; colbase = (pn - 8) * 256; gain = bk; }
        else if (pn < 12) { mode = 0; dst = VB; ld = 512; colbase = (pn - 10) * 256; }
        else { mode = 2; dst = GATES; ld = 2048; colbase = (pn - 12) * 256; }
        const int row0 = u.pm * 256 + wr * 64 + fr;
        float g[2][8];
        if (mode == 1) {
#pragma unroll
            for (int bj = 0; bj < 2; ++bj) { const f32x4 a = *(const f32x4*)(gain + 32 * bj + 8 * fq), b = *(const f32x4*)(gain + 32 * bj + 8 * fq + 4);
                g[bj][0] = a[0] * scale; g[bj][1] = a[1] * scale; g[bj][2] = a[2] * scale; g[bj][3] = a[3] * scale; g[bj][4] = b[0] * scale; g[bj][5] = b[1] * scale; g[bj][6] = b[2] * scale; g[bj][7] = b[3] * scale; }
        }
#pragma unroll
        for (int ai = 0; ai < 2; ++ai)
#pragma unroll
            for (int m = 0; m < 4; ++m) {
                float v[2][8];
#pragma unroll
                for (int bj = 0; bj < 2; ++bj)
#pragma unroll
                    for (int n = 0; n < 2; ++n)
#pragma unroll
                        for (int j = 0; j < 4; ++j) v[bj][4 * n + j] = acc[ai][bj][m][n][j];
                if (mode == 1) {
                    float ss = 0.f;
#pragma unroll
                    for (int bj = 0; bj < 2; ++bj)
#pragma unroll
                        for (int j = 0; j < 8; ++j) ss += v[bj][j] * v[bj][j];
                    ss += __shfl_xor(ss, 16); ss += __shfl_xor(ss, 32);
                    const float rs = __builtin_amdgcn_rsqf(ss * (1.f / 64.f) + EPS);
#pragma unroll
                    for (int bj = 0; bj < 2; ++bj)
#pragma unroll
                        for (int j = 0; j < 8; ++j) v[bj][j] = v[bj][j] * rs * g[bj][j];
                } else if (mode == 2) {
#pragma unroll
                    for (int bj = 0; bj < 2; ++bj)
#pragma unroll
                        for (int j = 0; j < 8; ++j) v[bj][j] = __builtin_amdgcn_rcpf(1.f + __builtin_amdgcn_exp2f(-LOG2E * v[bj][j]));
                }
                bf16* rowp = dst + (size_t)(row0 + ai * 128 + m * 16) * ld + colbase + 64 * wc + 8 * fq;
#pragma unroll
                for (int bj = 0; bj < 2; ++bj) { u32x4 w; w.x = cvt_pk_bf16(v[bj][0], v[bj][1]); w.y = cvt_pk_bf16(v[bj][2], v[bj][3]); w.z = cvt_pk_bf16(v[bj][4], v[bj][5]); w.w = cvt_pk_bf16(v[bj][6], v[bj][7]);
                    *(u32x4*)(rowp + 32 * bj) = w; }
            }
    }
};
struct EpiAB {
    static constexpr bool PERM = true;
    const bf16* GATES; bf16* MIXED;
    __device__ __forceinline__ bool keep(const pg8::Unit& u) const { return u.part == 0; }
    __device__ __forceinline__ void operator()(f32x4 (&acc)[2][2][4][2], const pg8::Unit& u, int wr, int wc, int fr, int fq) const {
        const int row0 = u.pm * 256 + wr * 64 + fr, col0 = u.pn * 256 + wc * 32 + 8 * fq;
#pragma unroll
        for (int ai = 0; ai < 2; ++ai)
#pragma unroll
            for (int m = 0; m < 4; ++m) {
                const size_t row = (size_t)(row0 + ai * 128 + m * 16);
#pragma unroll
                for (int bj = 0; bj < 2; ++bj) {
                    const int col = col0 + bj * 128;
                    const u32x4 sbw = *(const u32x4*)(GATES + row * 2048 + 1024 + col);
                    float sb[8];
#pragma unroll
                    for (int q = 0; q < 4; ++q) { sb[2 * q] = __uint_as_float(sbw[q] << 16); sb[2 * q + 1] = __uint_as_float(sbw[q] & 0xffff0000u); }
                    if (u.part == 0) {
                        const u32x4 saw = *(const u32x4*)(GATES + row * 2048 + col);
#pragma unroll
                        for (int q = 0; q < 4; ++q) { const float sa0 = __uint_as_float(saw[q] << 16), sa1 = __uint_as_float(saw[q] & 0xffff0000u);
                            const int n = q >> 1, j = (q & 1) * 2;
                            acc[ai][bj][m][n][j] *= sa0 * __builtin_amdgcn_rcpf(sb[2 * q]); acc[ai][bj][m][n][j + 1] *= sa1 * __builtin_amdgcn_rcpf(sb[2 * q + 1]); }
                    } else {
                        u32x4 w;
#pragma unroll
                        for (int q = 0; q < 4; ++q) { const int n = q >> 1, j = (q & 1) * 2; w[q] = cvt_pk_bf16(acc[ai][bj][m][n][j] * sb[2 * q], acc[ai][bj][m][n][j + 1] * sb[2 * q + 1]); }
                        *(u32x4*)(MIXED + row * 1024 + col) = w;
                    }
                }
            }
    }
};
struct EpiRes {
    static constexpr bool PERM = false;
    const float* X; float* OUT;
    __device__ __forceinline__ bool keep(const pg8::Unit&) const { return false; }
    __device__ __forceinline__ void operator()(f32x4 (&acc)[2][2][4][2], const pg8::Unit& u, int wr, int wc, int fr, int fq) const {
        const int row0 = u.pm * 256 + wr * 64 + fr, col0 = u.pn * 256 + wc * 32 + 4 * fq;
#pragma unroll
        for (int ai = 0; ai < 2; ++ai)
#pragma unroll
            for (int m = 0; m < 4; ++m) { const size_t off = (size_t)(row0 + ai * 128 + m * 16) * D + col0;
#pragma unroll
                for (int bj = 0; bj < 2; ++bj)
#pragma unroll
                    for (int n = 0; n < 2; ++n) { const f32x4 xv = *(const f32x4*)(X + off + bj * 128 + n * 16); *(f32x4*)(OUT + off + bj * 128 + n * 16) = xv + acc[ai][bj][m][n]; } }
    }
};
struct EpiGU {
    static constexpr bool PERM = true;
    bf16* H;
    __device__ __forceinline__ bool keep(const pg8::Unit&) const { return false; }
    __device__ __forceinline__ void operator()(f32x4 (&acc)[2][2][4][2], const pg8::Unit& u, int wr, int wc, int fr, int fq) const {
        const int row0 = u.pm * 256 + wr * 64 + fr, col0 = u.pn * 128 + wc * 32 + 8 * fq;
#pragma unroll
        for (int ai = 0; ai < 2; ++ai)
#pragma unroll
            for (int m = 0; m < 4; ++m) {
                float h[8];
#pragma unroll
                for (int n = 0; n < 2; ++n)
#pragma unroll
                    for (int j = 0; j < 4; ++j) { const float gt = acc[ai][0][m][n][j], up = acc[ai][1][m][n][j];
                        h[4 * n + j] = gt * __builtin_amdgcn_rcpf(1.f + __builtin_amdgcn_exp2f(-LOG2E * gt)) * up; }
                u32x4 w; w.x = cvt_pk_bf16(h[0], h[1]); w.y = cvt_pk_bf16(h[2], h[3]); w.z = cvt_pk_bf16(h[4], h[5]); w.w = cvt_pk_bf16(h[6], h[7]);
                *(u32x4*)(H + (size_t)(row0 + ai * 128 + m * 16) * DEXP + col0) = w;
            }
    }
};
struct EpiDown {
    static constexpr bool PERM = true;
    bf16* Y; const float* slot_w;
    __device__ __forceinline__ bool keep(const pg8::Unit&) const { return false; }
    __device__ __forceinline__ void operator()(f32x4 (&acc)[2][2][4][2], const pg8::Unit& u, int wr, int wc, int fr, int fq) const {
        const int row0 = u.pm * 256 + wr * 64 + fr, col0 = u.pn * 256 + wc * 32 + 8 * fq;
#pragma unroll
        for (int ai = 0; ai < 2; ++ai)
#pragma unroll
            for (int m = 0; m < 4; ++m) { const int row = row0 + ai * 128 + m * 16; const float w = slot_w[row];
#pragma unroll
                for (int bj = 0; bj < 2; ++bj) { u32x4 o; o.x = cvt_pk_bf16(acc[ai][bj][m][0][0] * w, acc[ai][bj][m][0][1] * w); o.y = cvt_pk_bf16(acc[ai][bj][m][0][2] * w, acc[ai][bj][m][0][3] * w);
                    o.z = cvt_pk_bf16(acc[ai][bj][m][1][0] * w, acc[ai][bj][m][1][1] * w); o.w = cvt_pk_bf16(acc[ai][bj][m][1][2] * w, acc[ai][bj][m][1][3] * w);
                    *(u32x4*)(Y + (size_t)row * D + col0 + bj * 128) = o; } }
    }
};

namespace att {
__device__ __forceinline__ int crow(int r, int hi) { return (r & 3) + 8 * (r >> 2) + 4 * hi; }
__device__ __forceinline__ void glds16(const void* gsrc, unsigned lds_dst) { unsigned keep;
    asm volatile("s_mov_b32 %0, m0\n\ts_mov_b32 m0, %2\n\ts_nop 0\n\tglobal_load_lds_dwordx4 %1, off\n\ts_mov_b32 m0, %0" : "=&s"(keep) : "v"(gsrc), "s"(lds_dst) : "memory"); }
typedef LAS const char* lds_cptr;
typedef short v4i16_t __attribute__((ext_vector_type(4)));
__device__ __forceinline__ s16x4 vtr(lds_cptr p) { return __builtin_bit_cast(s16x4, __builtin_amdgcn_ds_read_tr16_b64_v4i16((LAS v4i16_t*)p)); }
#define ATT_WAIT_BAR(N) asm volatile("s_waitcnt vmcnt(" #N ") lgkmcnt(0)\n\ts_barrier" ::: "memory")

constexpr int LDS_K = 0, LDS_V = 49152, LDS_TBL = 98304, LDS_WS = 99328, LDS_X = 0;

template <int NS, int DV, int QP, int VP>
__device__ __forceinline__ void attn_unit(const bf16* Q0, const bf16* Q1p, const bf16* K0, const bf16* K1p, const bf16* V, long rowbase, int q0,
                                          const float* tblg, const float* gsub, float lam, bf16* OUT  , char* shm) {
    constexpr int KSLOT = NS * 8192, VSLOT = DV * 128, ND = DV / 32, NVP = DV / 64;
    const int tid = threadIdx.x, lane = tid & 63, r32 = lane & 31, hi = lane >> 5; const int wid = __builtin_amdgcn_readfirstlane(tid >> 6);
    const int s = (NS == 2) ? (wid >> 2) : 0, j = (NS == 2) ? (wid & 3) : wid;
    const int ROWS = (NS == 2) ? 128 : 256;
    const int cw = (q0 + 32 * j) >> 6, qi = ((32 * j) & 63) + r32;
    const int t1 = (q0 + ROWS - 1) >> 6;
    int t0 = 0, lo_w = 0;
    if (NS == 1) { t0 = (q0 >> 6) - 8; if (t0 < 0) t0 = 0; lo_w = cw - 8; if (lo_w < 0) lo_w = 0; }
    const unsigned lds0 = (unsigned)(uintptr_t)shm;
    LAS float* tb = (LAS float*)((LAS char*)shm + LDS_TBL);
    LAS float* wsf = (LAS float*)((LAS char*)shm + LDS_WS) + wid * 64;
    if (tid < 256) tb[tid] = tblg[tid];
    const bf16* Qs = (s == 0) ? Q0 : Q1p;
    const bf16* Qw = Qs + (rowbase + q0 + 32 * j) * QP;
    const bf16* ksrc0 = K0 + (rowbase + lane) * QP + wid * 8;
    const bf16* ksrc1 = (NS == 2) ? K1p + (rowbase + lane) * QP + wid * 8 : nullptr;
    const unsigned kdst = lds0 + LDS_K + wid * 1024, vdst = lds0 + LDS_V;
    bf16x8 qr[4];
#pragma unroll
    for (int d0 = 0; d0 < 4; ++d0) qr[d0] = *reinterpret_cast<const bf16x8*>(&Qw[(long)r32 * QP + d0 * 16 + hi * 8]);
#define ATT_DMA(t, sl) do { \
        glds16(ksrc0 + (long)(t) * 64 * QP, (unsigned)__builtin_amdgcn_readfirstlane(kdst + (sl) * KSLOT)); \
        if (NS == 2) glds16(ksrc1 + (long)(t) * 64 * QP, (unsigned)__builtin_amdgcn_readfirstlane(kdst + (sl) * KSLOT + 8192)); \
        _Pragma("unroll") for (int i_ = 0; i_ < NVP; ++i_) { const int p_ = wid + 8 * i_; \
            glds16(V + (rowbase + (long)(t) * 64 + 16 * (p_ & 3) + (lane >> 2)) * VP + (p_ >> 2) * 32 + (lane & 3) * 8, (unsigned)__builtin_amdgcn_readfirstlane(vdst + (sl) * VSLOT + p_ * 1024)); } \
    } while (0)
    ATT_DMA(t0, 0);
    if (t0 + 1 <= t1) ATT_DMA(t0 + 1, 1);
    f32x16 o[ND];
#pragma unroll
    for (int d = 0; d < ND; ++d) o[d] = f32x16{};
    float l_reg = 0.f;
    LDS_WAIT();
    __builtin_amdgcn_s_barrier();
    asm volatile("" :: "v"(qr[0]), "v"(qr[1]), "v"(qr[2]), "v"(qr[3]));
    const float cfar = tb[255];
    f32x16 cinit;
#pragma unroll
    for (int r = 0; r < 16; ++r) cinit[r] = cfar;
    const lds_cptr shm3 = (lds_cptr)shm;
    const lds_cptr kp0 = shm3 + LDS_K + s * 8192 + hi * 1024 + r32 * 16;
    const lds_cptr vp0 = shm3 + LDS_V + ((lane >> 4) & 1) * 32 + (lane & 3) * 8 + (4 * hi + ((lane & 15) >> 2)) * 64;
    int sl = 0;
    for (int t = t0; t <= t1; ++t) {
        if (t < t1) { if (NS == 2) ATT_WAIT_BAR(4); else ATT_WAIT_BAR(2); } else ATT_WAIT_BAR(0);
        if (t + 2 <= t1) { const int s2 = (sl == 0) ? 2 : sl - 1; ATT_DMA(t + 2, s2); }
        if (t >= lo_w && t <= cw) {
            const lds_cptr kp = kp0 + sl * KSLOT; const lds_cptr vp = vp0 + sl * VSLOT;
            f32x16 p0, p1;
#pragma unroll
            for (int d0 = 0; d0 < 4; ++d0) {
                const bf16x8 b0 = *(const LAS bf16x8*)(kp + d0 * 2048), b1 = *(const LAS bf16x8*)(kp + d0 * 2048 + 512);
                if (d0 == 0) { p0 = __builtin_amdgcn_mfma_f32_32x32x16_bf16(b0, qr[0], cinit, 0, 0, 0); p1 = __builtin_amdgcn_mfma_f32_32x32x16_bf16(b1, qr[0], cinit, 0, 0, 0); }
                else { p0 = __builtin_amdgcn_mfma_f32_32x32x16_bf16(b0, qr[d0], p0, 0, 0, 0); p1 = __builtin_amdgcn_mfma_f32_32x32x16_bf16(b1, qr[d0], p1, 0, 0, 0); }
            }
            if (t >= cw - 2) {
                const LAS float* tp = tb + (64 * (t - cw) + 191 - qi + 4 * hi);
#pragma unroll
                for (int r = 0; r < 16; ++r) { p0[r] += tp[(r & 3) + 8 * (r >> 2)]; p1[r] += tp[32 + (r & 3) + 8 * (r >> 2)]; }
            }
            float sacc = 0.f;
#pragma unroll
            for (int r = 0; r < 16; ++r) { p0[r] = __builtin_amdgcn_exp2f(p0[r]); p1[r] = __builtin_amdgcn_exp2f(p1[r]); sacc += p0[r] + p1[r]; }
            l_reg += sacc;
            u32x4 pw[4];
#pragma unroll
            for (int q = 0; q < 4; ++q) { pw[0][q] = cvt_pk_bf16(p0[2 * q], p0[2 * q + 1]); pw[1][q] = cvt_pk_bf16(p0[8 + 2 * q], p0[9 + 2 * q]);
                pw[2][q] = cvt_pk_bf16(p1[2 * q], p1[2 * q + 1]); pw[3][q] = cvt_pk_bf16(p1[8 + 2 * q], p1[9 + 2 * q]); }
#pragma unroll
            for (int d0 = 0; d0 < ND; ++d0)
#pragma unroll
                for (int ks = 0; ks < 4; ++ks) {
                    const s16x4 vlo = vtr(vp + d0 * 4096 + ks * 1024), vhi = vtr(vp + d0 * 4096 + ks * 1024 + 512);
                    const bf16x8 vf = (bf16x8){vlo[0], vlo[1], vlo[2], vlo[3], vhi[0], vhi[1], vhi[2], vhi[3]};
                    o[d0] = __builtin_amdgcn_mfma_f32_32x32x16_bf16(__builtin_bit_cast(bf16x8, pw[ks]), vf, o[d0], 0, 0, 0);
                }
        }
        sl = (sl == 2) ? 0 : sl + 1;
    }
#undef ATT_DMA
    { auto rr = __builtin_amdgcn_permlane32_swap(__float_as_uint(l_reg), __float_as_uint(l_reg), false, false); l_reg = __uint_as_float(rr[0]) + __uint_as_float(rr[1]); }
    if (hi == 0) wsf[r32] = l_reg;
    LDS_WAIT();
    float rli[16];
#pragma unroll
    for (int r = 0; r < 16; ++r) rli[r] = __builtin_amdgcn_rcpf(wsf[crow(r, hi)]);
    const long orow0 = rowbase + q0 + 32 * j;
    if (NS == 2) {
        LAS float* X = (LAS float*)((LAS char*)shm + LDS_X);
        asm volatile("s_waitcnt lgkmcnt(0)\n\ts_barrier" ::: "memory");
        if (s == 1) {
#pragma unroll
            for (int d0 = 0; d0 < ND; ++d0)
#pragma unroll
                for (int r = 0; r < 16; ++r) X[((j * ND + d0) * 16 + r) * 64 + lane] = lam * o[d0][r] * rli[r];
        }
        asm volatile("s_waitcnt lgkmcnt(0)\n\ts_barrier" ::: "memory");
        if (s == 0) {
            float gs[ND];
#pragma unroll
            for (int d0 = 0; d0 < ND; ++d0) gs[d0] = gsub[32 * d0 + r32] * 0.8f;
#pragma unroll
            for (int r = 0; r < 16; ++r) {
                float ss = 0.f;
#pragma unroll
                for (int d0 = 0; d0 < ND; ++d0) { o[d0][r] = o[d0][r] * rli[r] - X[((j * ND + d0) * 16 + r) * 64 + lane]; ss += o[d0][r] * o[d0][r]; }
#pragma unroll
                for (int m = 1; m < 32; m <<= 1) ss += __shfl_xor(ss, m);
                const float rs = __builtin_amdgcn_rsqf(ss * (1.f / DV) + EPS);
                bf16* op = OUT + (orow0 + crow(r, hi)) * 1024 + r32;
#pragma unroll
                for (int d0 = 0; d0 < ND; ++d0) op[32 * d0] = (bf16)(cvt_pk_bf16(o[d0][r] * rs * gs[d0], 0.f) & 0xffffu);
            }
        }
    } else {
#pragma unroll
        for (int r = 0; r < 16; ++r) {
            bf16* op = OUT + (orow0 + crow(r, hi)) * 1024 + r32;
#pragma unroll
            for (int d0 = 0; d0 < ND; ++d0) op[32 * d0] = (bf16)(cvt_pk_bf16(o[d0][r] * rli[r], 0.f) & 0xffffu);
        }
    }
    asm volatile("s_waitcnt vmcnt(0) lgkmcnt(0)\n\ts_barrier" ::: "memory");
}
}

__device__ __forceinline__ unsigned f2bf(float f) { unsigned u = __builtin_bit_cast(unsigned, f); return (u + 0x7fffu + ((u >> 16) & 1u)) >> 16; }
__device__ __forceinline__ unsigned pk2(float lo, float hi) { return f2bf(lo) | (f2bf(hi) << 16); }
__device__ __forceinline__ void p0_tr_item(const float* W, int ldw, int k0, int n0, bf16* dst, int ldd, int drow0, int kd0, LAS float* scr, int lane) {
#pragma unroll 8
    for (int i = 0; i < 32; ++i) { const int kk = 2 * i + (lane >> 5); scr[kk * 33 + (lane & 31)] = W[(size_t)(k0 + kk) * ldw + n0 + (lane & 31)]; }
    LDS_WAIT(); asm volatile("" ::: "memory");
    const int c = lane & 7;
#pragma unroll
    for (int j = 0; j < 4; ++j) { const int n = (lane >> 3) + 8 * j; const LAS float* sp = scr + (8 * c) * 33 + n;
        u32x4 o; o.x = pk2(sp[0 * 33], sp[1 * 33]); o.y = pk2(sp[2 * 33], sp[3 * 33]); o.z = pk2(sp[4 * 33], sp[5 * 33]); o.w = pk2(sp[6 * 33], sp[7 * 33]);
        *(GAS u32x4*)(dst + (size_t)(drow0 + n) * ldd + kd0 + 8 * c) = o; }
    LDS_WAIT(); asm volatile("" ::: "memory");
}
__device__ __forceinline__ int t5_bucket(int rel) {
    const int side = rel > 0 ? 16 : 0; const int n = rel < 0 ? -rel : rel;
    int b;
    if (n < 8) b = n; else if (n < 12) b = 8; else if (n < 16) b = 9; else if (n < 23) b = 10; else if (n < 32) b = 11; else if (n < 46) b = 12; else if (n < 64) b = 13; else if (n < 91) b = 14; else b = 15;
    return side + b;
}

struct Args { const float* in[22]; float* out; unsigned char* ws; int ph_lo, ph_hi; };

__global__ void __launch_bounds__(512, 2) mk_fwd(Args args) {
    extern __shared__ __attribute__((aligned(16))) unsigned char lds_raw[];
    LAS unsigned char* lds = (LAS unsigned char*)lds_raw;
    volatile LAS unsigned* MISC = (volatile LAS unsigned*)(lds + MISC_OFF);
    const int tid = threadIdx.x, lane = tid & 63, wave = __builtin_amdgcn_readfirstlane(tid >> 6);
    const int G = gridDim.x; const int bx = blockIdx.x; const int vcu = (G % 8 == 0) ? (bx % 8) * (G / 8) + bx / 8 : bx;
    unsigned char* ws = args.ws;
    unsigned* ctl = (unsigned*)(ws + WS_CTL);
    for (int u = tid; u < 64; u += 512) ((LAS unsigned*)(lds + MISC_OFF))[u] = 0u;
    __syncthreads();
    XcdBarrier bar; bar.bar = ctl + CW_BAR; bar.x = 0; bar.st = nullptr;
    if (MK_N_LAUNCHES == 1) bar = xcd_barrier_post(ctl + CW_BAR, MISC + 8);
    const int lo = args.ph_lo, hi = args.ph_hi;
#define IN(k) (lo <= (k) && (k) < hi)
#define SEAM(k) do { if (MK_N_LAUNCHES == 1 && IN(k) && IN((k) + 1)) xcd_barrier(bar); } while (0)

    const float* x = args.in[0];
    float* out = args.out;
    bf16* WINT = (bf16*)(ws + WS_WINT); bf16* WABT = (bf16*)(ws + WS_WABT); bf16* WOT = (bf16*)(ws + WS_WOT); bf16* WGUT = (bf16*)(ws + WS_WGUT); bf16* WDT = (bf16*)(ws + WS_WDT);
    bf16* XB = (bf16*)(ws + WS_XB); bf16* OAB = (bf16*)(ws + WS_OAB); bf16* QK = (bf16*)(ws + WS_QK); bf16* MIXED = (bf16*)(ws + WS_MIXED);
    bf16* VA = (bf16*)(ws + WS_VA); bf16* QBb = (bf16*)(ws + WS_QB); bf16* KBb = (bf16*)(ws + WS_KB); bf16* VBb = (bf16*)(ws + WS_VB);
    bf16* HN = (bf16*)(ws + WS_HN); bf16* HB = (bf16*)(ws + WS_H); bf16* YB = (bf16*)(ws + WS_Y);
    bf16* GATES = (bf16*)out;
    float* TBLA = (float*)(ws + WS_TBLA); float* TBLB = (float*)(ws + WS_TBLB); float* LAMV = (float*)(ws + WS_LAM);
    int* TILEE = (int*)(ws + WS_TILEE); float* WR = (float*)(ws + WS_WR);
    int* TOKINFO = (int*)(ws + WS_TOKINFO); int* HIST = (int*)(ws + WS_HIST); int* SLOTTOK = (int*)(ws + WS_SLOTTOK); float* SLOTW = (float*)(ws + WS_SLOTW); int* TOKSLOT = (int*)(ws + WS_TOKSLOT);

    if (IN(0)) {
        LAS float* scr = (LAS float*)(lds + wave * 16384);
        const int gw = vcu * 8 + wave, NGW = G * 8;
        constexpr int I_IN = 16 * 160, I_A = 8 * 32, I_B = 8 * 32, I_O = 16 * 32, I_G = 32 * 256, I_U = 32 * 256, I_D = 32 * 256;
        constexpr int NITEMS = I_IN + I_A + I_B + I_O + I_G + I_U + I_D;
        for (int it = gw; it < NITEMS; it += NGW) {
            int r = it;
            if (r < I_IN) { const int kb = r / 160, nb = r % 160, n0 = 32 * nb, pn = n0 >> 8, cg = (n0 & 255) >> 5, wcc = cg >> 1, bjj = cg & 1;
                p0_tr_item(args.in[2], PROJ, 64 * kb, n0, WINT, 1024, pn * 256 + 128 * bjj + 32 * wcc, 64 * kb, scr, lane); continue; } r -= I_IN;
            if (r < I_A) { const int kb = r / 32, nb = r % 32; p0_tr_item(args.in[11], 1024, 64 * kb, 32 * nb, WABT, 1024, 32 * nb, 64 * kb, scr, lane); continue; } r -= I_A;
            if (r < I_B) { const int kb = r / 32, nb = r % 32; p0_tr_item(args.in[12], 1024, 64 * kb, 32 * nb, WABT, 1024, 32 * nb, 512 + 64 * kb, scr, lane); continue; } r -= I_B;
            if (r < I_O) { const int kb = r / 32, nb = r % 32; p0_tr_item(args.in[13], 1024, 64 * kb, 32 * nb, WOT, 1024, 32 * nb, 64 * kb, scr, lane); continue; } r -= I_O;
            if (r < I_G + I_U) { const int up = r >= I_G; if (up) r -= I_G; const int e = r >> 8, q = r & 255, kb = q / 16, nb = q % 16, n0 = 32 * nb;
                p0_tr_item((up ? args.in[20] : args.in[19]) + (size_t)e * 1024 * 512, 512, 64 * kb, n0, WGUT, 1024, e * 1024 + (n0 >> 7) * 256 + (n0 & 127) + (up ? 128 : 0), 64 * kb, scr, lane); continue; } r -= I_G + I_U;
            { const int e = r >> 8, q = r & 255, kb = q / 32, nb = q % 32; p0_tr_item(args.in[21] + (size_t)e * 512 * 1024, 1024, 64 * kb, 32 * nb, WDT, 512, e * 1024 + 32 * nb, 64 * kb, scr, lane); }
        }
        for (int m = gw; m < T; m += NGW) {
            const GAS f32x4* xr = (const GAS f32x4*)(x + (size_t)m * D) + lane; const GAS f32x4* gr = (const GAS f32x4*)args.in[1] + lane;
            f32x4 v[4]; float ssq = 0.f;
#pragma unroll
            for (int j = 0; j < 4; ++j) { v[j] = xr[64 * j]; ssq += (v[j].x * v[j].x + v[j].y * v[j].y) + (v[j].z * v[j].z + v[j].w * v[j].w); }
            const float rstd = __builtin_amdgcn_rsqf(wave_sum(ssq) * (1.f / D) + EPS);
            GAS u32x2* o8 = (GAS u32x2*)(XB + (size_t)m * D) + lane;
#pragma unroll
            for (int j = 0; j < 4; ++j) { const f32x4 g = gr[64 * j]; u32x2 w; w.x = pk2(v[j].x * rstd * g.x, v[j].y * rstd * g.y); w.y = pk2(v[j].z * rstd * g.z, v[j].w * rstd * g.w); o8[64 * j] = w; }
        }
        for (int idx = gw * 64 + lane; idx < 48 * 1024; idx += NGW * 64) { const int n = idx >> 10, k = idx & 1023; float w = 0.f;
            if (n < 32) w = args.in[17][k * 32 + n]; else if (n < 36) w = args.in[15][k * 4 + (n - 32)];
            WR[idx] = w * args.in[14][k]; }
        for (int idx = gw * 64 + lane; idx < 12 * 256; idx += NGW * 64) {
            const int hh = idx >> 8, i = idx & 255; const bool isA = hh < 4; const int h = isA ? hh : hh - 4;
            const float farv = isA ? args.in[7][15 * 4 + h] : args.in[10][0 * 8 + h];
            float v;
            if (i == 255) v = farv * LOG2E;
            else { const int rel = i - 191; float b;
                if (isA) b = args.in[7][t5_bucket(rel) * 4 + h];
                else { int ri = rel < -128 ? -128 : (rel > 128 ? 128 : rel); b = args.in[10][(ri + 128) * 8 + h]; }
                v = (b - farv) * LOG2E; }
            (isA ? TBLA : TBLB)[h * 256 + i] = v;
        }
        if (gw == 0) { const float* lp = args.in[5]; const float a = wave_sum(lp[lane] * lp[64 + lane]), b = wave_sum(lp[128 + lane] * lp[192 + lane]);
            if (lane == 0) LAMV[0] = expf(a) - expf(b) + 0.2f; }
    }
    SEAM(0);

    if (IN(1)) {
        pg8::DenseSched S{(const char*)XB, (const char*)WINT, 1024, 1024, T / 256, PROJ / 256, G, bx, 1, 1024};
        EpiProj E{QK, VA, QBb, KBb, VBb, GATES, args.in[3], args.in[4], args.in[8], args.in[9]};
        pg8::gemm_phase<EpiProj, pg8::DenseSched, true>(lds, 1024, S, E);
    }
    SEAM(1);

    if (IN(2)) {
        const float lam = LAMV[0];
        for (int i = 0; i < 2; ++i) {
            const int uidx = vcu; const int bh = uidx >> 5, sidx = uidx & 31; const int qb = (i == 0) ? sidx : 63 - sidx;
            const int b = bh >> 2, h = bh & 3;
            if (vcu < 256)
            att::attn_unit<2, 128, 256, 512>(QK + h * 64, QK + (size_t)T * 256 + h * 64, QK + (size_t)2 * T * 256 + h * 64, QK + (size_t)3 * T * 256 + h * 64, VA + h * 128,
                                              (long)b * SEQ, qb * 128, TBLA + h * 256, args.in[6], lam, OAB + h * 128, (char*)lds_raw);
        }
        for (int i = 0; i < 2; ++i) {
            const int uidx = vcu * 2 + i; const int bh = uidx >> 5, grp = uidx & 31; const int b = bh >> 3, h = bh & 7;
            if (vcu < 256)
            att::attn_unit<1, 64, 512, 512>(QBb + h * 64, nullptr, KBb + h * 64, nullptr, VBb + h * 64, (long)b * SEQ, grp * 256, TBLB + h * 256, nullptr, 0.f, OAB + 512 + h * 64, (char*)lds_raw);
        }
    }
    SEAM(2);

    if (IN(3)) {
        pg8::DenseSched S{(const char*)OAB, (const char*)WABT, 1024, 1024, T / 256, D / 256, G, bx, 2, 512};
        EpiAB E{GATES, MIXED};
        pg8::gemm_phase<EpiAB, pg8::DenseSched, false>(lds, 512, S, E);
    }
    SEAM(3);

    if (IN(4)) {
        pg8::DenseSched S{(const char*)MIXED, (const char*)WOT, 1024, 1024, T / 256, D / 256, G, bx, 1, 1024};
        EpiRes E{x, out};
        pg8::gemm_phase<EpiRes, pg8::DenseSched, false>(lds, 1024, S, E);
    }
    SEAM(4);

    if (IN(5)) {
        LAS float* LG = (LAS float*)lds;
        LAS float* RS = LG + 64 * 48;
        LAS int* HI = (LAS int*)(RS + 64);
        for (int task = vcu; task < T / 64; task += G) {
            if (tid < 32) HI[tid] = 0;
            if (wave < 4) {
                const int rl = lane & 15, q = lane >> 4; const int row = task * 64 + wave * 16 + rl;
                const float* xr = out + (size_t)row * D + 4 * q; const float* w0p = WR + (size_t)rl * 1024 + 4 * q;
                f32x4 a0 = {0.f, 0.f, 0.f, 0.f}, a1 = a0, a2 = a0; float ssq = 0.f;
#pragma unroll 4
                for (int c = 0; c < 64; ++c) {
                    const f32x4 xa = *(const f32x4*)(xr + 16 * c);
                    const f32x4 w0 = *(const f32x4*)(w0p + 16 * c), w1 = *(const f32x4*)(w0p + 16 * 1024 + 16 * c), w2 = *(const f32x4*)(w0p + 32 * 1024 + 16 * c);
#pragma unroll
                    for (int s = 0; s < 4; ++s) { a0 = __builtin_amdgcn_mfma_f32_16x16x4f32(xa[s], w0[s], a0, 0, 0, 0); a1 = __builtin_amdgcn_mfma_f32_16x16x4f32(xa[s], w1[s], a1, 0, 0, 0);
                        a2 = __builtin_amdgcn_mfma_f32_16x16x4f32(xa[s], w2[s], a2, 0, 0, 0); }
                    ssq += (xa.x * xa.x + xa.y * xa.y) + (xa.z * xa.z + xa.w * xa.w);
                }
                ssq += __shfl_xor(ssq, 16); ssq += __shfl_xor(ssq, 32);
                const float rstd = __builtin_amdgcn_rsqf(ssq * (1.f / D) + EPS);
#pragma unroll
                for (int r = 0; r < 4; ++r) { LAS float* lp = LG + (wave * 16 + 4 * q + r) * 48 + rl; lp[0] = a0[r]; lp[16] = a1[r]; lp[32] = a2[r]; }
                if (q == 0) RS[wave * 16 + rl] = rstd;
            }
            __syncthreads();
            if (tid < 64) {
                const int row = task * 64 + tid; const float rs = RS[tid]; const LAS float* lg = LG + tid * 48;
                float gl[4]; float gmax = -3.0e38f; int gi = 0;
#pragma unroll
                for (int jj = 0; jj < 4; ++jj) { gl[jj] = lg[32 + jj] * rs + args.in[16][jj]; if (gl[jj] > gmax) { gmax = gl[jj]; gi = jj; } }
                float gsum = 0.f;
#pragma unroll
                for (int jj = 0; jj < 4; ++jj) gsum += __expf(gl[jj] - gmax);
                const float pg = 1.f / gsum;
                float el[8]; float b1 = -3.0e38f, b2 = -3.0e38f; int i1 = 0, i2 = 0;
#pragma unroll
                for (int jj = 0; jj < 8; ++jj) { el[jj] = lg[8 * gi + jj] * rs + args.in[18][8 * gi + jj]; if (el[jj] > b1) { b1 = el[jj]; i1 = jj; } }
#pragma unroll
                for (int jj = 0; jj < 8; ++jj) { if (jj != i1 && el[jj] > b2) { b2 = el[jj]; i2 = jj; } }
                const float wa = pg / (1.f + __expf(b2 - b1)), wb = pg - wa;
                const int e1 = 8 * gi + i1, e2 = 8 * gi + i2;
                int4 info; info.x = e1; info.y = e2; info.z = __float_as_int(wa); info.w = __float_as_int(wb);
                *(int4*)(TOKINFO + 4 * row) = info;
                __hip_atomic_fetch_add(&HI[e1], 1, __ATOMIC_RELAXED, __HIP_MEMORY_SCOPE_WORKGROUP); __hip_atomic_fetch_add(&HI[e2], 1, __ATOMIC_RELAXED, __HIP_MEMORY_SCOPE_WORKGROUP);
            }
            for (int rr = 0; rr < 8; ++rr) {
                const int r = wave * 8 + rr; const int row = task * 64 + r; const float rs = RS[r];
                const GAS f32x4* xr = (const GAS f32x4*)(out + (size_t)row * D) + lane; const GAS f32x4* gr = (const GAS f32x4*)args.in[14] + lane;
                GAS u32x2* o8 = (GAS u32x2*)(HN + (size_t)row * D) + lane;
#pragma unroll
                for (int j = 0; j < 4; ++j) { const f32x4 v = xr[64 * j], g = gr[64 * j]; u32x2 w; w.x = pk2(v.x * rs * g.x, v.y * rs * g.y); w.y = pk2(v.z * rs * g.z, v.w * rs * g.w); o8[64 * j] = w; }
            }
            __syncthreads();
            if (tid < 32) HIST[task * 32 + tid] = HI[tid];
            __syncthreads();
        }
    }
    SEAM(5);

    if (IN(6)) {
        LAS int* CUR = (LAS int*)lds;
        for (int task = vcu; task < T / 64; task += G) {
            if (wave == 0) {
                const int e = lane & 31; int tot = 0, pre = 0;
#pragma unroll 8
                for (int tt = 0; tt < T / 64; ++tt) { const int v = HIST[tt * 32 + e]; pre += (tt < task) ? v : 0; tot += v; }
                const int pad = (tot + 255) & ~255;
                int seg = pad;
#pragma unroll
                for (int o = 1; o < 32; o <<= 1) { const int v = __shfl_up(seg, o); if ((lane & 31) >= o) seg += v; }
                const int segend = seg; seg -= pad;
                if (lane < 32) CUR[e] = seg + pre;
                if (task == 0 && lane < 32) { for (int rt = seg >> 8; rt < (segend >> 8); ++rt) TILEE[rt] = e; if (lane == 31) TILEE[MAXTILES] = segend >> 8; }
                if (task < 32) { const int se = __shfl(seg, task), te = __shfl(tot, task), pe = __shfl(pad, task);
                    for (int sidx = se + te + lane; sidx < se + pe; sidx += 64) { SLOTTOK[sidx] = 0; SLOTW[sidx] = 0.f; } }
                LDS_WAIT();
                const int row = task * 64 + lane; const int4 info = *(const int4*)(TOKINFO + 4 * row);
#pragma unroll
                for (int k = 0; k < 2; ++k) {
                    const int ek = k == 0 ? info.x : info.y; const float wk = __int_as_float(k == 0 ? info.z : info.w); int slot = 0;
                    for (int ee = 0; ee < 32; ++ee) {
                        const unsigned long long mk = __ballot(ek == ee); const int base = CUR[ee];
                        if (ek == ee) slot = base + __popcll(mk & ((1ull << lane) - 1ull));
                        LDS_WAIT();
                        if (lane == 0) CUR[ee] = base + __popcll(mk);
                        LDS_WAIT();
                    }
                    SLOTTOK[slot] = row; SLOTW[slot] = wk; TOKSLOT[row * 2 + k] = slot;
                }
            }
            __syncthreads();
        }
    }
    SEAM(6);

    if (IN(7)) {
        const int ntiles = TILEE[MAXTILES]; const int nunits = ntiles * 4;
        int e0 = 0, e1 = 0, e2 = 0; { const int L0 = vcu, L1 = G + vcu, L2 = 2 * G + vcu; if (L0 < nunits) e0 = TILEE[L0 >> 2]; if (L1 < nunits) e1 = TILEE[L1 >> 2]; if (L2 < nunits) e2 = TILEE[L2 >> 2]; }
        e0 = __builtin_amdgcn_readfirstlane(e0); e1 = __builtin_amdgcn_readfirstlane(e1); e2 = __builtin_amdgcn_readfirstlane(e2);
        pg8::MoeSched<true> S{(const char*)HN, (const char*)WGUT, SLOTTOK, 1024, 1024, G, vcu, nunits, e0, e1, e2, (size_t)1024 * 1024 * 2};
        EpiGU E{HB};
        pg8::gemm_phase<EpiGU, pg8::MoeSched<true>, true>(lds, 1024, S, E);
    }
    SEAM(7);

    if (IN(8)) {
        const int ntiles = TILEE[MAXTILES]; const int nunits = ntiles * 4;
        int e0 = 0, e1 = 0, e2 = 0; { const int L0 = vcu, L1 = G + vcu, L2 = 2 * G + vcu; if (L0 < nunits) e0 = TILEE[L0 >> 2]; if (L1 < nunits) e1 = TILEE[L1 >> 2]; if (L2 < nunits) e2 = TILEE[L2 >> 2]; }
        e0 = __builtin_amdgcn_readfirstlane(e0); e1 = __builtin_amdgcn_readfirstlane(e1); e2 = __builtin_amdgcn_readfirstlane(e2);
        pg8::MoeSched<false> S{(const char*)HB, (const char*)WDT, SLOTTOK, 512, 512, G, vcu, nunits, e0, e1, e2, (size_t)1024 * 512 * 2};
        EpiDown E{YB, SLOTW};
        pg8::gemm_phase<EpiDown, pg8::MoeSched<false>, true>(lds, 512, S, E);
    }
    SEAM(8);

    if (IN(9)) {
        const int gw = vcu * 8 + wave, NGW = G * 8;
        for (int m = gw; m < T; m += NGW) {
            const int s1 = TOKSLOT[2 * m], s2 = TOKSLOT[2 * m + 1];
            GAS f32x4* xr = (GAS f32x4*)(out + (size_t)m * D) + lane;
            const GAS u32x2* y1 = (const GAS u32x2*)(YB + (size_t)s1 * D) + lane; const GAS u32x2* y2 = (const GAS u32x2*)(YB + (size_t)s2 * D) + lane;
#pragma unroll
            for (int j = 0; j < 4; ++j) { f32x4 v = xr[64 * j]; const u32x2 a = y1[64 * j], b = y2[64 * j];
                v.x += __uint_as_float(a.x << 16) + __uint_as_float(b.x << 16); v.y += __uint_as_float(a.x & 0xffff0000u) + __uint_as_float(b.x & 0xffff0000u);
                v.z += __uint_as_float(a.y << 16) + __uint_as_float(b.y << 16); v.w += __uint_as_float(a.y & 0xffff0000u) + __uint_as_float(b.y & 0xffff0000u);
                xr[64 * j] = v; }
        }
    }
#undef IN
#undef SEAM
}

extern "C" void kernel_launch(void* const* d_in, const int* in_sizes, int n_in, void* d_out, int out_size, void* d_ws, size_t ws_size, hipStream_t stream) {
    static int grid = 0;
    if (grid == 0) {
        if (n_in != 22 || out_size != T * D || ws_size < WS_END) { fprintf(stderr, "kernel_launch: unexpected shapes (n_in %d out %d ws %zu)\n", n_in, out_size, ws_size); grid = -1; return; }
        if (hipFuncSetAttribute((const void*)mk_fwd, hipFuncAttributeMaxDynamicSharedMemorySize, LDS_BYTES) != hipSuccess) { fprintf(stderr, "kernel_launch: hipFuncSetAttribute failed\n"); grid = -1; return; }
        int dev = 0, cus = 0, per_cu = 0;
        (void)hipGetDevice(&dev); (void)hipDeviceGetAttribute(&cus, hipDeviceAttributeMultiprocessorCount, dev);
        (void)hipOccupancyMaxActiveBlocksPerMultiprocessor(&per_cu, (const void*)mk_fwd, 512, LDS_BYTES);
        (void)hipGetLastError();
        if (cus != 256 || per_cu < 1) fprintf(stderr, "kernel_launch: note: %d CUs, occupancy query %d\n", cus, per_cu);
        grid = 256;
    }
    if (grid < 0) return;
    (void)hipMemsetAsync((char*)d_ws + WS_CTL, 0, CTL_ZERO_BYTES, stream);
    Args a{};
    for (int i = 0; i < 22; ++i) a.in[i] = (const float*)d_in[i];
    a.out = (float*)d_out; a.ws = (unsigned char*)d_ws;
    if (MK_N_LAUNCHES == 1) { a.ph_lo = 0; a.ph_hi = NPHASE; hipLaunchKernelGGL(mk_fwd, dim3(grid), dim3(512), LDS_BYTES, stream, a); }
    else { for (int p = 0; p < NPHASE; ++p) { a.ph_lo = p; a.ph_hi = p + 1; hipLaunchKernelGGL(mk_fwd, dim3(grid), dim3(512), LDS_BYTES, stream, a); } }
}
```

```cpp
#include <hip/hip_runtime.h>
#include <cstdio>
#include <cstdint>

#ifndef MK_N_LAUNCHES
#define MK_N_LAUNCHES 1
#endif
constexpr int NPHASE = 9;
#ifndef REP0
#define REP0 1
#endif
#ifndef REP1
#define REP1 1
#endif
#ifndef REP2A
#define REP2A 1
#endif
#ifndef REP2B
#define REP2B 1
#endif
#ifndef REP3
#define REP3 1
#endif
#ifndef REP4
#define REP4 1
#endif
#ifndef REP5
#define REP5 1
#endif
#ifndef REP6
#define REP6 1
#endif
#ifndef REP7
#define REP7 1
#endif
#ifndef REP8
#define REP8 1
#endif

#define GAS __attribute__((address_space(1)))
#define LAS __attribute__((address_space(3)))
typedef unsigned short bf16;
typedef short bf16x8 __attribute__((ext_vector_type(8)));
typedef short s16x4 __attribute__((ext_vector_type(4)));
typedef float f32x4 __attribute__((ext_vector_type(4)));
typedef float f32x16 __attribute__((ext_vector_type(16)));
typedef unsigned u32x4 __attribute__((ext_vector_type(4)));
typedef unsigned u32x2 __attribute__((ext_vector_type(2)));

constexpr int T = 16384, SEQ = 8192, D = 1024, PROJ = 5120;
constexpr int NEXP = 32, DEXP = 512;
constexpr int MAXSLOT = 40960, MAXTILES = MAXSLOT / 256;
constexpr float EPS = 1e-6f;
constexpr float LOG2E = 1.4426950408889634f;
constexpr float C2 = 0.125f * LOG2E;

constexpr size_t MiB = 1u << 20;
constexpr size_t WS_CTL = 0, CTL_ZERO_BYTES = 64 * 1024;
constexpr size_t WS_TBLA = 1 * MiB;
constexpr size_t WS_TBLB = WS_TBLA + 4096;
constexpr size_t WS_LAM = WS_TBLB + 8192;
constexpr size_t WS_WR = 1 * MiB + 64 * 1024;
constexpr size_t WS_TOKPOS = 1 * MiB + 512 * 1024;
constexpr size_t WS_LISTTOK = 2 * MiB;
constexpr size_t WS_LISTW = 242 * MiB;
constexpr size_t WS_WINT = 4 * MiB;
constexpr size_t WS_WABT = 14 * MiB;
constexpr size_t WS_WOT = 16 * MiB;
constexpr size_t WS_WGUT = 18 * MiB;
constexpr size_t WS_WDT = 82 * MiB;
constexpr size_t WS_XB = 114 * MiB;
constexpr size_t WS_OAB = 114 * MiB;
constexpr size_t WS_QK = 146 * MiB;
constexpr size_t WS_MIXED = 146 * MiB;
constexpr size_t WS_VA = 178 * MiB;
constexpr size_t WS_QB = 194 * MiB, WS_KB = 210 * MiB, WS_VB = 226 * MiB;
constexpr size_t WS_HN = 114 * MiB;
constexpr size_t WS_H = 202 * MiB;
constexpr size_t WS_Y = 114 * MiB;
constexpr size_t WS_END = 244 * MiB;
constexpr int CW_BAR = 1024;
constexpr int CW_CURSOR = 8192;
constexpr int CAP = 16384;

constexpr int RING_BYTES = 131072;
constexpr int MISC_OFF = RING_BYTES;
constexpr int LDS_BYTES = 147456;

#define LDS_WAIT() asm volatile("s_waitcnt lgkmcnt(0)" ::: "memory")
#define VM_WAIT() asm volatile("s_waitcnt vmcnt(0)" ::: "memory")
__device__ __forceinline__ unsigned cvt_pk_bf16(float lo, float hi) { unsigned r; asm volatile("v_cvt_pk_bf16_f32 %0, %1, %2" : "=v"(r) : "v"(lo), "v"(hi)); return r; }
__device__ __forceinline__ float bf2f(unsigned short b) { return __uint_as_float((unsigned)b << 16); }
__device__ __forceinline__ float wave_sum(float v) {
#pragma unroll
    for (int o = 1; o < 64; o <<= 1) v += __shfl_xor(v, o);
    return v;
}

#define XB_TMO      128
#define XB_XCNT(j)  (256  + 64 * (j))
#define XB_XSUB(j)  (1280 + 64 * (j))
#define XB_XGEN(j)  (2304 + 64 * (j))
#define XB_TOP      3328
#define XB_TOPGEN   3392
#define XCD_BAR_WORDS 3456
#define XB_SPIN_CAP (1u << 18)
__device__ __forceinline__ unsigned xb_ld(unsigned* p)              { return __hip_atomic_load(p, __ATOMIC_RELAXED, __HIP_MEMORY_SCOPE_AGENT); }
__device__ __forceinline__ unsigned xb_add(unsigned* p, unsigned v) { return __hip_atomic_fetch_add(p, v, __ATOMIC_RELAXED, __HIP_MEMORY_SCOPE_AGENT); }
__device__ __forceinline__ unsigned xb_xcc_id() { return (unsigned)__builtin_amdgcn_s_getreg((3 << 11) | 20) & 0xFu; }
#define XB_SPIN(cond, bar) do { unsigned _sp = 0; while (cond) { __builtin_amdgcn_s_sleep(1); \
    if ((++_sp & 255u) == 0u) { if (xb_ld(&(bar)[XB_TMO])) break; if (_sp > XB_SPIN_CAP) { atomicAdd(&(bar)[XB_TMO], 1u); break; } } } } while (0)
struct XcdBarrier { unsigned* bar; unsigned x; volatile LAS unsigned* st; };
__device__ __forceinline__ XcdBarrier xcd_barrier_post(unsigned* bar, volatile LAS unsigned* st) {
    XcdBarrier b; b.bar = bar; b.x = xb_xcc_id(); b.st = st;
    if (threadIdx.x == 0) (void)xb_add(&bar[XB_XCNT(b.x)], 1u);
    return b;
}
__device__ __forceinline__ void xcd_barrier_complete(unsigned* bar, unsigned x, unsigned& nloc, unsigned& nx) {
    const unsigned G = gridDim.x * gridDim.y * gridDim.z;
    unsigned sum, cnt, mine, sp = 0u;
    for (;;) {
        sum = 0u; cnt = 0u; mine = 0u;
#pragma unroll
        for (unsigned j = 0; j < 16; ++j) { const unsigned c = xb_ld(&bar[XB_XCNT(j)]); sum += c; cnt += (c > 0u) ? 1u : 0u; mine = (j == x) ? c : mine; }
        if (sum == G) break;
        __builtin_amdgcn_s_sleep(1);
        if ((++sp & 255u) == 0u) { if (xb_ld(&bar[XB_TMO])) break; if (sp > XB_SPIN_CAP) { atomicAdd(&bar[XB_TMO], 1u); break; } }
    }
    nloc = mine > 0u ? mine : 1u; nx = cnt > 0u ? cnt : 1u;
}
__device__ __forceinline__ void xcd_barrier(const XcdBarrier& b) {
    asm volatile("s_waitcnt vmcnt(0)" ::: "memory");
    __syncthreads();
    if (threadIdx.x == 0) {
        unsigned* bar = b.bar;
        __builtin_amdgcn_s_waitcnt(0);
        unsigned nloc = b.st[0], nx = b.st[1];
        if (nloc == 0u) { xcd_barrier_complete(bar, b.x, nloc, nx); b.st[0] = nloc; b.st[1] = nx; }
        const unsigned old = xb_add(&bar[XB_XSUB(b.x)], 1u);
        const unsigned gen = old / nloc;
        if (old + 1u == (gen + 1u) * nloc) {
            __builtin_amdgcn_fence(__ATOMIC_RELEASE, "agent");
            asm volatile("s_waitcnt vmcnt(0)" ::: "memory");
            const unsigned og = xb_add(&bar[XB_TOP], 1u);
            const unsigned tg = og / nx;
            if (og + 1u == (tg + 1u) * nx) xb_add(&bar[XB_TOPGEN], 1u);
            else XB_SPIN(xb_ld(&bar[XB_TOPGEN]) == tg, bar);
            __builtin_amdgcn_fence(__ATOMIC_ACQUIRE, "agent");
            xb_add(&bar[XB_XGEN(b.x)], 1u);
            asm volatile("s_waitcnt vmcnt(0)" ::: "memory");
        } else {
            XB_SPIN(xb_ld(&bar[XB_XGEN(b.x)]) == gen, bar);
            __builtin_amdgcn_fence(__ATOMIC_ACQUIRE, "agent");
            asm volatile("s_waitcnt vmcnt(0)" ::: "memory");
        }
    }
    __syncthreads();
}

namespace pg8 {
constexpr int BM = 256, BK = 64, HALF = 128, HTB = HALF * BK * 2, NXCD = 8, WGM = 8;
__host__ __device__ __forceinline__ int lds_byte(int r, int c) { const int st = (r >> 4) * 2 + (c >> 5), rr = r & 15, cc = c & 31, ob = rr * 64 + cc * 2; return st * 1024 + (ob ^ (((ob >> 9) & 1) << 5)); }
__host__ __device__ __forceinline__ void stage_rc(int b, int& R, int& C) { const int st = b / 1024, sb = b % 1024, swz = sb ^ (((sb >> 9) & 1) << 5); R = (st >> 1) * 16 + swz / 64; C = (st & 1) * 32 + (swz % 64) / 2; }
__host__ __device__ __forceinline__ int perm32(int rho) { const int n = rho >> 4, i = rho & 15; return 8 * (i >> 2) + 4 * n + (i & 3); }

struct Unit { int pm, pn, e, part, pos0, n; };

__device__ __forceinline__ void tile_of(int L, int nM, int nN, int& pm, int& pn) {
    const int nwg = nM * nN; int wgid = L;
    { const int q = nwg / NXCD, r = nwg % NXCD, xcd = wgid % NXCD, off = wgid / NXCD; wgid = (xcd < r ? xcd * (q + 1) : r * (q + 1) + (xcd - r) * q) + off; }
    const int nig = WGM * nN, gid = wgid / nig, fm = gid * WGM, gsz = (nM - fm) < WGM ? (nM - fm) : WGM;
    pm = fm + ((wgid % nig) % gsz); pn = (wgid % nig) / gsz;
}

template <class Epi, class Sched, bool ALIGN_EPI>
__device__ __forceinline__ void gemm_phase(LAS unsigned char* lds, const int K, const Sched& S, const Epi& E) {
    const int tid = threadIdx.x, wid = __builtin_amdgcn_readfirstlane(tid >> 6), lane = tid & 63, wr = wid >> 2, wc = wid & 3, fr = lane & 15, fq = lane >> 4;
    const int nt = K / BK;
    int Rr[2], Cc[2]; unsigned voffB[2];
#pragma unroll
    for (int i = 0; i < 2; ++i) { int R, C; stage_rc(tid * 16 + i * 8192, R, C); Rr[i] = R; Cc[i] = C; const int Rb = Epi::PERM ? ((R & ~31) + perm32(R & 31)) : R; voffB[i] = (unsigned)(Rb * S.ldb + C) * 2u; }
    const size_t kstep = (size_t)(BK * 2);
    const size_t hstepB = (size_t)HALF * S.ldb * 2;
    const unsigned ldsw = (unsigned)wid * 1024u;
    const int aoff = lds_byte(wr * 64 + fr, fq * 8), boff = lds_byte(wc * 32 + fr, fq * 8);
#define PG8_SA(b, h) (((b) * 2 + (h)) * HTB)
#define PG8_SB(b, h) ((4 + (b) * 2 + (h)) * HTB)
#define PG8_STAGE_A(bufoff, gbase, offh) do { _Pragma("unroll") for (int _i = 0; _i < 2; ++_i) \
        __builtin_amdgcn_global_load_lds((const unsigned*)((const char*)(gbase) + (offh)[_i]), (LAS unsigned*)(lds + (bufoff) + ldsw + _i * 8192), 16, 0, 0); } while (0)
#define PG8_STAGE_B(bufoff, gbase) do { _Pragma("unroll") for (int _i = 0; _i < 2; ++_i) \
        __builtin_amdgcn_global_load_lds((const unsigned*)((const char*)(gbase) + voffB[_i]), (LAS unsigned*)(lds + (bufoff) + ldsw + _i * 8192), 16, 0, 0); } while (0)
#define PG8_LDA(dst, b, h) do { _Pragma("unroll") for (int m = 0; m < 4; ++m) _Pragma("unroll") for (int k = 0; k < 2; ++k) dst[m][k] = *(const LAS bf16x8*)(lds + PG8_SA(b, h) + aoff + m * 2048 + k * 1024); } while (0)
#define PG8_LDB(dst, b, h) do { _Pragma("unroll") for (int n = 0; n < 2; ++n) _Pragma("unroll") for (int k = 0; k < 2; ++k) dst[n][k] = *(const LAS bf16x8*)(lds + PG8_SB(b, h) + boff + n * 2048 + k * 1024); } while (0)
#define PG8_MMA(ai, bj, At, Bt) do { __builtin_amdgcn_s_setprio(1); _Pragma("unroll") for (int m = 0; m < 4; ++m) _Pragma("unroll") for (int n = 0; n < 2; ++n) _Pragma("unroll") for (int k = 0; k < 2; ++k) \
        acc[ai][bj][m][n] = __builtin_amdgcn_mfma_f32_16x16x32_bf16(Bt[n][k], At[m][k], acc[ai][bj][m][n], 0, 0, 0); __builtin_amdgcn_s_setprio(0); } while (0)
#define PG8_WAIT_V(n) asm volatile("s_waitcnt vmcnt(" #n ")" ::: "memory")
#define PG8_WAIT_L(n) asm volatile("s_waitcnt lgkmcnt(" #n ")" ::: "memory")
#define PG8_BAR __builtin_amdgcn_s_barrier()
#define PG8_SCHED __builtin_amdgcn_sched_barrier(0)
    Unit cur, nxt; int ui = 0;
    if (!S.next(0, cur)) return;
    f32x4 acc[2][2][4][2];
#pragma unroll
    for (int a = 0; a < 2; ++a)
#pragma unroll
        for (int b = 0; b < 2; ++b)
#pragma unroll
            for (int m = 0; m < 4; ++m)
#pragma unroll
                for (int n = 0; n < 2; ++n) acc[a][b][m][n] = (f32x4){0.f, 0.f, 0.f, 0.f};
    bf16x8 At[4][2], B0[2][2], B1[2][2];
    const char* cA = S.a_base(cur); const char* cB = S.b_base(cur);
    unsigned oA[2][2], nraw[2][2];
    {
        unsigned raw[2][2];
#pragma unroll
        for (int h = 0; h < 2; ++h)
#pragma unroll
            for (int i = 0; i < 2; ++i) raw[h][i] = S.a_raw(cur, h, Rr[i]);
        if (Sched::GATHER) PG8_WAIT_V(0);
#pragma unroll
        for (int h = 0; h < 2; ++h)
#pragma unroll
            for (int i = 0; i < 2; ++i) oA[h][i] = S.a_conv(raw[h][i], Cc[i]);
    }
    PG8_STAGE_B(PG8_SB(0, 0), cB); PG8_STAGE_B(PG8_SB(0, 1), cB + hstepB); PG8_STAGE_A(PG8_SA(0, 0), cA, oA[0]); PG8_STAGE_A(PG8_SA(0, 1), cA, oA[1]);
    if (wr == 1) PG8_BAR;
    PG8_WAIT_V(2); PG8_BAR;
    PG8_STAGE_B(PG8_SB(1, 0), cB + kstep); PG8_STAGE_A(PG8_SA(1, 0), cA + kstep, oA[0]); PG8_STAGE_B(PG8_SB(1, 1), cB + hstepB + kstep);
    PG8_WAIT_V(6); PG8_BAR;
    for (;;) {
        const bool has_next = S.next(ui + 1, nxt);
        const char* nA = has_next ? S.a_base(nxt) : cA; const char* nB = has_next ? S.b_base(nxt) : cB;
        if (has_next) {
#pragma unroll
            for (int h = 0; h < 2; ++h)
#pragma unroll
                for (int i = 0; i < 2; ++i) nraw[h][i] = S.a_raw(nxt, h, Rr[i]);
        }
        for (int t = 0; t < nt; t += 2) {
            const bool last = (t == nt - 2);
            const char* a1 = cA + (size_t)(t + 1) * kstep;
            const char* a2 = last ? nA : cA + (size_t)(t + 2) * kstep; const char* b2 = last ? nB : cB + (size_t)(t + 2) * kstep;
            const char* a3 = a2 + kstep; const char* b3 = b2 + kstep;
            PG8_LDB(B0, 0, 0); PG8_LDB(B1, 0, 1); PG8_SCHED; PG8_LDA(At, 0, 0); PG8_STAGE_A(PG8_SA(1, 1), a1, oA[1]);
            PG8_WAIT_V(8); PG8_WAIT_L(0); PG8_BAR; PG8_MMA(0, 0, At, B0); PG8_MMA(0, 1, At, B1); PG8_BAR; PG8_SCHED;
            if (last && has_next) {
#pragma unroll
                for (int h = 0; h < 2; ++h)
#pragma unroll
                    for (int i = 0; i < 2; ++i) oA[h][i] = S.a_conv(nraw[h][i], Cc[i]);
            }
            PG8_LDA(At, 0, 1); PG8_STAGE_B(PG8_SB(0, 0), b2); PG8_STAGE_B(PG8_SB(0, 1), b2 + hstepB); PG8_STAGE_A(PG8_SA(0, 0), a2, oA[0]);
            PG8_WAIT_V(8); PG8_WAIT_L(0); PG8_BAR; PG8_MMA(1, 0, At, B0); PG8_MMA(1, 1, At, B1); PG8_BAR; PG8_SCHED;
            PG8_LDB(B0, 1, 0); PG8_LDB(B1, 1, 1); PG8_SCHED; PG8_LDA(At, 1, 0); PG8_STAGE_A(PG8_SA(0, 1), a2, oA[1]);
            PG8_WAIT_V(8); PG8_WAIT_L(0); PG8_BAR; PG8_MMA(0, 0, At, B0); PG8_MMA(0, 1, At, B1); PG8_BAR; PG8_SCHED;
            PG8_LDA(At, 1, 1); PG8_STAGE_B(PG8_SB(1, 0), b3); PG8_STAGE_B(PG8_SB(1, 1), b3 + hstepB); PG8_STAGE_A(PG8_SA(1, 0), a3, oA[0]);
            PG8_WAIT_V(8); PG8_WAIT_L(0); PG8_BAR; PG8_MMA(1, 0, At, B0); PG8_MMA(1, 1, At, B1); PG8_BAR; PG8_SCHED;
        }
        if constexpr (ALIGN_EPI) { if (wr == 0) PG8_BAR; }
        E(acc, cur, wr, wc, fr, fq);
        if (!has_next) break;
        if (!E.keep(cur)) {
#pragma unroll
            for (int a = 0; a < 2; ++a)
#pragma unroll
                for (int b = 0; b < 2; ++b)
#pragma unroll
                    for (int m = 0; m < 4; ++m)
#pragma unroll
                        for (int n = 0; n < 2; ++n) acc[a][b][m][n] = (f32x4){0.f, 0.f, 0.f, 0.f};
        }
        cur = nxt; cA = nA; cB = nB; ++ui;
        if constexpr (ALIGN_EPI) { if (wr == 1) PG8_BAR; }
    }
    PG8_WAIT_V(0);
    if constexpr (!ALIGN_EPI) { if (wr == 0) PG8_BAR; }
    PG8_BAR;
#undef PG8_SA
#undef PG8_SB
#undef PG8_STAGE_A
#undef PG8_STAGE_B
#undef PG8_LDA
#undef PG8_LDB
#undef PG8_MMA
#undef PG8_WAIT_V
#undef PG8_WAIT_L
#undef PG8_BAR
#undef PG8_SCHED
}

struct DenseSched {
    static constexpr bool GATHER = false;
    const char* A; const char* Bt; int lda, ldb, nM, nN, G, c, nparts, K;
    __device__ __forceinline__ bool next(int i, Unit& u) const {
        const int ti = i / nparts; const long L = (long)ti * G + c; if (L >= (long)nM * nN) return false;
        tile_of((int)L, nM, nN, u.pm, u.pn); u.part = i - ti * nparts; u.e = 0; return true;
    }
    __device__ __forceinline__ const char* a_base(const Unit& u) const { return A + (size_t)u.part * K * 2; }
    __device__ __forceinline__ const char* b_base(const Unit& u) const { return Bt + ((size_t)u.pn * BM * ldb + (size_t)u.part * K) * 2; }
    __device__ __forceinline__ unsigned a_raw(const Unit& u, int h, int R) const { return (unsigned)(u.pm * BM + h * HALF + R); }
    __device__ __forceinline__ unsigned a_conv(unsigned raw, int C) const { return (raw * (unsigned)lda + (unsigned)C) * 2u; }
};
struct MoeUnits { int e[3], pos0[3], n[3]; };
template <bool GATHER_>
struct MoeSched {
    static constexpr bool GATHER = GATHER_;
    const char* A; const char* Bt; const int* list_tok; int lda, ldb, G, c, nunits; MoeUnits mu; size_t bstride;
    __device__ __forceinline__ bool next(int i, Unit& u) const {
        const int L = i * G + c; if (i > 2 || L >= nunits) return false;
        u.pm = L >> 2; u.pn = L & 3; u.part = 0;
        u.e = (i == 0) ? mu.e[0] : (i == 1 ? mu.e[1] : mu.e[2]); u.pos0 = (i == 0) ? mu.pos0[0] : (i == 1 ? mu.pos0[1] : mu.pos0[2]); u.n = (i == 0) ? mu.n[0] : (i == 1 ? mu.n[1] : mu.n[2]);
        return true;
    }
    __device__ __forceinline__ const char* a_base(const Unit&) const { return A; }
    __device__ __forceinline__ const char* b_base(const Unit& u) const { return Bt + (size_t)u.e * bstride + (size_t)u.pn * BM * ldb * 2; }
    __device__ __forceinline__ unsigned a_raw(const Unit& u, int h, int R) const {
        if (GATHER_) { int pos = u.pos0 + h * HALF + R; pos = pos < u.n ? pos : u.n - 1;
            unsigned v; const int* p = list_tok + u.e * CAP + pos; asm volatile("global_load_dword %0, %1, off" : "=v"(v) : "v"(p) : "memory"); return v; }
        return (unsigned)(u.pm * BM + h * HALF + R);
    }
    __device__ __forceinline__ unsigned a_conv(unsigned raw, int C) const {
        if (GATHER_) { unsigned o; const unsigned c2 = (unsigned)C * 2u; asm volatile("v_mad_u32_u24 %0, %1, %2, %3" : "=v"(o) : "v"(raw), "v"((unsigned)lda * 2u), "v"(c2)); return o; }
        return (raw * (unsigned)lda + (unsigned)C) * 2u;
    }
};
}

struct EpiProj {
    static constexpr bool PERM = true;
    bf16* QK; bf16* VA; bf16* QB; bf16* KB; bf16* VB; bf16* GATES;
    const float *aq, *ak, *bq, *bk;
    __device__ __forceinline__ bool keep(const pg8::Unit&) const { return false; }
    __device__ __forceinline__ void operator()(f32x4 (&acc)[2][2][4][2], const pg8::Unit& u, int wr, int wc, int fr, int fq) const {
        const int pn = u.pn; int mode, ld, colbase; bf16* dst; const float* gain = nullptr; float scale = 1.f;
        if (pn < 4) { mode = 1; dst = QK + (size_t)pn * T * 256; ld = 256; colbase = 0; gain = pn < 2 ? aq : ak; scale = pn < 2 ? C2 : 1.f; }
        else if (pn < 6) { mode = 0; dst = VA; ld = 512; colbase = (pn - 4) * 256; }
        else if (pn < 8) { mode = 1; dst = QB; ld = 512; colbase = (pn - 6) * 256; gain = bq; scale = C2; }
        else if (pn < 10) { mode = 1; dst = KB; ld = 512; colbase = (pn - 8) * 256; gain = bk; }
        else if (pn < 12) { mode = 0; dst = VB; ld = 512; colbase = (pn - 10) * 256; }
        else { mode = 2; dst = GATES; ld = 2048; colbase = (pn - 12) * 256; }
        const int row0 = u.pm * 256 + wr * 64 + fr;
        float g[2][8];
        if (mode == 1) {
#pragma unroll
            for (int bj = 0; bj < 2; ++bj) { const f32x4 a = *(const f32x4*)(gain + 32 * bj + 8 * fq), b = *(const f32x4*)(gain + 32 * bj + 8 * fq + 4);
                g[bj][0] = a[0] * scale; g[bj][1] = a[1] * scale; g[bj][2] = a[2] * scale; g[bj][3] = a[3] * scale; g[bj][4] = b[0] * scale; g[bj][5] = b[1] * scale; g[bj][6] = b[2] * scale; g[bj][7] = b[3] * scale; }
        }
#pragma unroll
        for (int ai = 0; ai < 2; ++ai)
#pragma unroll
            for (int m = 0; m < 4; ++m) {
                float v[2][8];
#pragma unroll
                for (int bj = 0; bj < 2; ++bj)
#pragma unroll
                    for (int n = 0; n < 2; ++n)
#pragma unroll
                        for (int j = 0; j < 4; ++j) v[bj][4 * n + j] = acc[ai][bj][m][n][j];
                if (mode == 1) {
                    float ss = 0.f;
#pragma unroll
                    for (int bj = 0; bj < 2; ++bj)
#pragma unroll
                        for (int j = 0; j < 8; ++j) ss += v[bj][j] * v[bj][j];
                    ss += __shfl_xor(ss, 16); ss += __shfl_xor(ss, 32);
                    const float rs = __builtin_amdgcn_rsqf(ss * (1.f / 64.f) + EPS);
#pragma unroll
                    for (int bj = 0; bj < 2; ++bj)
#pragma unroll
                        for (int j = 0; j < 8; ++j) v[bj][j] = v[bj][j] * rs * g[bj][j];
                } else if (mode == 2) {
#pragma unroll
                    for (int bj = 0; bj < 2; ++bj)
#pragma unroll
                        for (int j = 0; j < 8; ++j) v[bj][j] = __builtin_amdgcn_rcpf(1.f + __builtin_amdgcn_exp2f(-LOG2E * v[bj][j]));
                }
                bf16* rowp = dst + (size_t)(row0 + ai * 128 + m * 16) * ld + colbase + 64 * wc + 8 * fq;
#pragma unroll
                for (int bj = 0; bj < 2; ++bj) { u32x4 w; w.x = cvt_pk_bf16(v[bj][0], v[bj][1]); w.y = cvt_pk_bf16(v[bj][2], v[bj][3]); w.z = cvt_pk_bf16(v[bj][4], v[bj][5]); w.w = cvt_pk_bf16(v[bj][6], v[bj][7]);
                    *(u32x4*)(rowp + 32 * bj) = w; }
            }
    }
};
struct EpiAB {
    static constexpr bool PERM = true;
    const bf16* GATES; bf16* MIXED;
    __device__ __forceinline__ bool keep(const pg8::Unit& u) const { return u.part == 0; }
    __device__ __forceinline__ void operator()(f32x4 (&acc)[2][2][4][2], const pg8::Unit& u, int wr, int wc, int fr, int fq) const {
        const int row0 = u.pm * 256 + wr * 64 + fr, col0 = u.pn * 256 + wc * 32 + 8 * fq;
#pragma unroll
        for (int ai = 0; ai < 2; ++ai)
#pragma unroll
            for (int m = 0; m < 4; ++m) {
                const size_t row = (size_t)(row0 + ai * 128 + m * 16);
#pragma unroll
                for (int bj = 0; bj < 2; ++bj) {
                    const int col = col0 + bj * 128;
                    const u32x4 sbw = *(const u32x4*)(GATES + row * 2048 + 1024 + col);
                    float sb[8];
#pragma unroll
                    for (int q = 0; q < 4; ++q) { sb[2 * q] = __uint_as_float(sbw[q] << 16); sb[2 * q + 1] = __uint_as_float(sbw[q] & 0xffff0000u); }
                    if (u.part == 0) {
                        const u32x4 saw = *(const u32x4*)(GATES + row * 2048 + col);
#pragma unroll
                        for (int q = 0; q < 4; ++q) { const float sa0 = __uint_as_float(saw[q] << 16), sa1 = __uint_as_float(saw[q] & 0xffff0000u);
                            const int n = q >> 1, j = (q & 1) * 2;
                            acc[ai][bj][m][n][j] *= sa0 * __builtin_amdgcn_rcpf(sb[2 * q]); acc[ai][bj][m][n][j + 1] *= sa1 * __builtin_amdgcn_rcpf(sb[2 * q + 1]); }
                    } else {
                        u32x4 w;
#pragma unroll
                        for (int q = 0; q < 4; ++q) { const int n = q >> 1, j = (q & 1) * 2; w[q] = cvt_pk_bf16(acc[ai][bj][m][n][j] * sb[2 * q], acc[ai][bj][m][n][j + 1] * sb[2 * q + 1]); }
                        *(u32x4*)(MIXED + row * 1024 + col) = w;
                    }
                }
            }
    }
};
struct EpiRes {
    static constexpr bool PERM = false;
    const float* X; float* OUT;
    __device__ __forceinline__ bool keep(const pg8::Unit&) const { return false; }
    __device__ __forceinline__ void operator()(f32x4 (&acc)[2][2][4][2], const pg8::Unit& u, int wr, int wc, int fr, int fq) const {
        const int row0 = u.pm * 256 + wr * 64 + fr, col0 = u.pn * 256 + wc * 32 + 4 * fq;
#pragma unroll
        for (int ai = 0; ai < 2; ++ai)
#pragma unroll
            for (int m = 0; m < 4; ++m) { const size_t off = (size_t)(row0 + ai * 128 + m * 16) * D + col0;
#pragma unroll
                for (int bj = 0; bj < 2; ++bj)
#pragma unroll
                    for (int n = 0; n < 2; ++n) { const f32x4 xv = *(const f32x4*)(X + off + bj * 128 + n * 16); *(f32x4*)(OUT + off + bj * 128 + n * 16) = xv + acc[ai][bj][m][n]; } }
    }
};
struct EpiGU {
    static constexpr bool PERM = true;
    bf16* H;
    __device__ __forceinline__ bool keep(const pg8::Unit&) const { return false; }
    __device__ __forceinline__ void operator()(f32x4 (&acc)[2][2][4][2], const pg8::Unit& u, int wr, int wc, int fr, int fq) const {
        const int row0 = u.pm * 256 + wr * 64 + fr, col0 = u.pn * 128 + wc * 32 + 8 * fq;
#pragma unroll
        for (int ai = 0; ai < 2; ++ai)
#pragma unroll
            for (int m = 0; m < 4; ++m) {
                float h[8];
#pragma unroll
                for (int n = 0; n < 2; ++n)
#pragma unroll
                    for (int j = 0; j < 4; ++j) { const float gt = acc[ai][0][m][n][j], up = acc[ai][1][m][n][j];
                        h[4 * n + j] = gt * __builtin_amdgcn_rcpf(1.f + __builtin_amdgcn_exp2f(-LOG2E * gt)) * up; }
                u32x4 w; w.x = cvt_pk_bf16(h[0], h[1]); w.y = cvt_pk_bf16(h[2], h[3]); w.z = cvt_pk_bf16(h[4], h[5]); w.w = cvt_pk_bf16(h[6], h[7]);
                *(u32x4*)(H + (size_t)(row0 + ai * 128 + m * 16) * DEXP + col0) = w;
            }
    }
};
struct EpiDown {
    static constexpr bool PERM = true;
    bf16* Y; const float* list_w;
    __device__ __forceinline__ bool keep(const pg8::Unit&) const { return false; }
    __device__ __forceinline__ void operator()(f32x4 (&acc)[2][2][4][2], const pg8::Unit& u, int wr, int wc, int fr, int fq) const {
        const int r0 = wr * 64 + fr, col0 = u.pn * 256 + wc * 32 + 8 * fq;
#pragma unroll
        for (int ai = 0; ai < 2; ++ai)
#pragma unroll
            for (int m = 0; m < 4; ++m) { const int r = r0 + ai * 128 + m * 16; int pos = u.pos0 + r; pos = pos < u.n ? pos : u.n - 1; const float w = list_w[u.e * CAP + pos]; const int row = u.pm * 256 + r;
#pragma unroll
                for (int bj = 0; bj < 2; ++bj) { u32x4 o; o.x = cvt_pk_bf16(acc[ai][bj][m][0][0] * w, acc[ai][bj][m][0][1] * w); o.y = cvt_pk_bf16(acc[ai][bj][m][0][2] * w, acc[ai][bj][m][0][3] * w);
                    o.z = cvt_pk_bf16(acc[ai][bj][m][1][0] * w, acc[ai][bj][m][1][1] * w); o.w = cvt_pk_bf16(acc[ai][bj][m][1][2] * w, acc[ai][bj][m][1][3] * w);
                    *(u32x4*)(Y + (size_t)row * D + col0 + bj * 128) = o; } }
    }
};

namespace att {
__device__ __forceinline__ int crow(int r, int hi) { return (r & 3) + 8 * (r >> 2) + 4 * hi; }
__device__ __forceinline__ void glds16(const void* sbase_, unsigned voff, unsigned lds_dst) { unsigned keep;
    const unsigned long long a_ = (unsigned long long)(uintptr_t)sbase_;
    const unsigned long long sbase = ((unsigned long long)(unsigned)__builtin_amdgcn_readfirstlane((int)(a_ >> 32)) << 32) | (unsigned)__builtin_amdgcn_readfirstlane((int)a_);
    asm volatile("s_mov_b32 %0, m0\n\ts_mov_b32 m0, %3\n\ts_nop 0\n\tglobal_load_lds_dwordx4 %1, %2\n\ts_mov_b32 m0, %0" : "=&s"(keep) : "v"(voff), "s"(sbase), "s"(lds_dst) : "memory"); }
__device__ __forceinline__ void glds16p(const void* gsrc, unsigned lds_dst) { unsigned keep;
    asm volatile("s_mov_b32 %0, m0\n\ts_mov_b32 m0, %2\n\ts_nop 0\n\tglobal_load_lds_dwordx4 %1, off\n\ts_mov_b32 m0, %0" : "=&s"(keep) : "v"(gsrc), "s"(lds_dst) : "memory"); }
typedef LAS const char* lds_cptr;
typedef short v4i16_t __attribute__((ext_vector_type(4)));
typedef float f32x2_t __attribute__((ext_vector_type(2))); typedef __bf16 bf16x2_t __attribute__((ext_vector_type(2)));
__device__ __forceinline__ s16x4 vtr(lds_cptr p) { return __builtin_bit_cast(s16x4, __builtin_amdgcn_ds_read_tr16_b64_v4i16((LAS v4i16_t*)p)); }
__device__ __forceinline__ unsigned cvtpk(float lo, float hi) { f32x2_t v = {lo, hi}; bf16x2_t b = __builtin_convertvector(v, bf16x2_t); return __builtin_bit_cast(unsigned, b); }
#define ATT_WAIT_BAR(N) asm volatile("s_waitcnt vmcnt(" #N ") lgkmcnt(0)\n\ts_barrier" ::: "memory")
#define ATT_SB() __builtin_amdgcn_sched_barrier(0)
#define ATT_PIN(x) asm volatile("" : "+v"(x))
#define ATT_MFMA(a, b, c) __builtin_amdgcn_mfma_f32_32x32x16_bf16(a, b, c, 0, 0, 0)

constexpr int LDS_K = 0, LDS_V = 49152, LDS_TBL = 98304, LDS_WS = 99328, LDS_X = 0;

template <int NS, int DV, int QP, int VP> struct attn_dummy {};
template <int NS, int DV, int QP, int VP>
__device__ __forceinline__ void attn_unit_simple(const bf16* Q0, const bf16* Q1p, const bf16* K0, const bf16* K1p, const bf16* V, long rowbase, int q0,
                                          const float* tblg, const float* gsub, float lam, bf16* OUT  , char* shm) {
    constexpr int KSLOT = NS * 8192, VSLOT = DV * 128, ND = DV / 32, NVP = DV / 64;
    const int tid = threadIdx.x, lane = tid & 63, r32 = lane & 31, hi = lane >> 5; const int wid = __builtin_amdgcn_readfirstlane(tid >> 6);
    const int s = (NS == 2) ? (wid >> 2) : 0, j = (NS == 2) ? (wid & 3) : wid;
    const int ROWS = (NS == 2) ? 128 : 256;
    const int cw = (q0 + 32 * j) >> 6, qi = ((32 * j) & 63) + r32;
    const int t1 = (q0 + ROWS - 1) >> 6;
    int t0 = 0, lo_w = 0;
    if (NS == 1) { t0 = (q0 >> 6) - 8; if (t0 < 0) t0 = 0; lo_w = cw - 8; if (lo_w < 0) lo_w = 0; }
    const unsigned lds0 = (unsigned)(uintptr_t)shm;
    LAS float* tb = (LAS float*)((LAS char*)shm + LDS_TBL);
    LAS float* wsf = (LAS float*)((LAS char*)shm + LDS_WS) + wid * 64;
    if (tid < 256) tb[tid] = tblg[tid];
    const bf16* Qs = (s == 0) ? Q0 : Q1p;
    const bf16* Qw = Qs + (rowbase + q0 + 32 * j) * QP;
    const bf16* ksrc0 = K0 + (rowbase + lane) * QP + wid * 8;
    const bf16* ksrc1 = (NS == 2) ? K1p + (rowbase + lane) * QP + wid * 8 : nullptr;
    const unsigned kdst = lds0 + LDS_K + wid * 1024, vdst = lds0 + LDS_V;
    bf16x8 qr[4];
#pragma unroll
    for (int d0 = 0; d0 < 4; ++d0) qr[d0] = *reinterpret_cast<const bf16x8*>(&Qw[(long)r32 * QP + d0 * 16 + hi * 8]);
#define ATT_DMA(t, sl) do { \
        glds16p(ksrc0 + (long)(t) * 64 * QP, (unsigned)__builtin_amdgcn_readfirstlane(kdst + (sl) * KSLOT)); \
        if (NS == 2) glds16p(ksrc1 + (long)(t) * 64 * QP, (unsigned)__builtin_amdgcn_readfirstlane(kdst + (sl) * KSLOT + 8192)); \
        _Pragma("unroll") for (int i_ = 0; i_ < NVP; ++i_) { const int p_ = wid + 8 * i_; \
            glds16p(V + (rowbase + (long)(t) * 64 + 16 * (p_ & 3) + (lane >> 2)) * VP + (p_ >> 2) * 32 + (lane & 3) * 8, (unsigned)__builtin_amdgcn_readfirstlane(vdst + (sl) * VSLOT + p_ * 1024)); } \
    } while (0)
    ATT_DMA(t0, 0);
    if (t0 + 1 <= t1) ATT_DMA(t0 + 1, 1);
    f32x16 o[ND];
#pragma unroll
    for (int d = 0; d < ND; ++d) o[d] = f32x16{};
    float l_reg = 0.f;
    LDS_WAIT();
    __builtin_amdgcn_s_barrier();
    asm volatile("" :: "v"(qr[0]), "v"(qr[1]), "v"(qr[2]), "v"(qr[3]));
    const float cfar = tb[255];
    f32x16 cinit;
#pragma unroll
    for (int r = 0; r < 16; ++r) cinit[r] = cfar;
    const lds_cptr shm3 = (lds_cptr)shm;
    const lds_cptr kp0 = shm3 + LDS_K + s * 8192 + hi * 1024 + r32 * 16;
    const lds_cptr vp0 = shm3 + LDS_V + ((lane >> 4) & 1) * 32 + (lane & 3) * 8 + (4 * hi + ((lane & 15) >> 2)) * 64;
    int sl = 0;
    for (int t = t0; t <= t1; ++t) {
        if (t < t1) { if (NS == 2) ATT_WAIT_BAR(4); else ATT_WAIT_BAR(2); } else ATT_WAIT_BAR(0);
        if (t + 2 <= t1) { const int s2 = (sl == 0) ? 2 : sl - 1; ATT_DMA(t + 2, s2); }
        if (t >= lo_w && t <= cw) {
            const lds_cptr kp = kp0 + sl * KSLOT; const lds_cptr vp = vp0 + sl * VSLOT;
            f32x16 p0, p1;
#pragma unroll
            for (int d0 = 0; d0 < 4; ++d0) {
                const bf16x8 b0 = *(const LAS bf16x8*)(kp + d0 * 2048), b1 = *(const LAS bf16x8*)(kp + d0 * 2048 + 512);
                if (d0 == 0) { p0 = __builtin_amdgcn_mfma_f32_32x32x16_bf16(b0, qr[0], cinit, 0, 0, 0); p1 = __builtin_amdgcn_mfma_f32_32x32x16_bf16(b1, qr[0], cinit, 0, 0, 0); }
                else { p0 = __builtin_amdgcn_mfma_f32_32x32x16_bf16(b0, qr[d0], p0, 0, 0, 0); p1 = __builtin_amdgcn_mfma_f32_32x32x16_bf16(b1, qr[d0], p1, 0, 0, 0); }
            }
            if (t >= cw - 2) {
                const LAS float* tp = tb + (64 * (t - cw) + 191 - qi + 4 * hi);
#pragma unroll
                for (int r = 0; r < 16; ++r) { p0[r] += tp[(r & 3) + 8 * (r >> 2)]; p1[r] += tp[32 + (r & 3) + 8 * (r >> 2)]; }
            }
            float sacc = 0.f;
#pragma unroll
            for (int r = 0; r < 16; ++r) { p0[r] = __builtin_amdgcn_exp2f(p0[r]); p1[r] = __builtin_amdgcn_exp2f(p1[r]); sacc += p0[r] + p1[r]; }
            l_reg += sacc;
            u32x4 pw[4];
#pragma unroll
            for (int q = 0; q < 4; ++q) { pw[0][q] = cvtpk(p0[2 * q], p0[2 * q + 1]); pw[1][q] = cvtpk(p0[8 + 2 * q], p0[9 + 2 * q]);
                pw[2][q] = cvtpk(p1[2 * q], p1[2 * q + 1]); pw[3][q] = cvtpk(p1[8 + 2 * q], p1[9 + 2 * q]); }
#pragma unroll
            for (int d0 = 0; d0 < ND; ++d0)
#pragma unroll
                for (int ks = 0; ks < 4; ++ks) {
                    const s16x4 vlo = vtr(vp + d0 * 4096 + ks * 1024), vhi = vtr(vp + d0 * 4096 + ks * 1024 + 512);
                    const bf16x8 vf = (bf16x8){vlo[0], vlo[1], vlo[2], vlo[3], vhi[0], vhi[1], vhi[2], vhi[3]};
                    o[d0] = __builtin_amdgcn_mfma_f32_32x32x16_bf16(__builtin_bit_cast(bf16x8, pw[ks]), vf, o[d0], 0, 0, 0);
                }
        }
        sl = (sl == 2) ? 0 : sl + 1;
    }
#undef ATT_DMA
    { auto rr = __builtin_amdgcn_permlane32_swap(__float_as_uint(l_reg), __float_as_uint(l_reg), false, false); l_reg = __uint_as_float(rr[0]) + __uint_as_float(rr[1]); }
    if (hi == 0) wsf[r32] = l_reg;
    LDS_WAIT();
    float rli[16];
#pragma unroll
    for (int r = 0; r < 16; ++r) rli[r] = __builtin_amdgcn_rcpf(wsf[crow(r, hi)]);
    const long orow0 = rowbase + q0 + 32 * j;
    if (NS == 2) {
        LAS float* X = (LAS float*)((LAS char*)shm + LDS_X);
        asm volatile("s_waitcnt lgkmcnt(0)\n\ts_barrier" ::: "memory");
        if (s == 1) {
#pragma unroll
            for (int d0 = 0; d0 < ND; ++d0)
#pragma unroll
                for (int r = 0; r < 16; ++r) X[((j * ND + d0) * 16 + r) * 64 + lane] = lam * o[d0][r] * rli[r];
        }
        asm volatile("s_waitcnt lgkmcnt(0)\n\ts_barrier" ::: "memory");
        if (s == 0) {
            float gs[ND];
#pragma unroll
            for (int d0 = 0; d0 < ND; ++d0) gs[d0] = gsub[32 * d0 + r32] * 0.8f;
#pragma unroll
            for (int r = 0; r < 16; ++r) {
                float ss = 0.f;
#pragma unroll
                for (int d0 = 0; d0 < ND; ++d0) { o[d0][r] = o[d0][r] * rli[r] - X[((j * ND + d0) * 16 + r) * 64 + lane]; ss += o[d0][r] * o[d0][r]; }
#pragma unroll
                for (int m = 1; m < 32; m <<= 1) ss += __shfl_xor(ss, m);
                const float rs = __builtin_amdgcn_rsqf(ss * (1.f / DV) + EPS);
                bf16* op = OUT + (orow0 + crow(r, hi)) * 1024 + r32;
#pragma unroll
                for (int d0 = 0; d0 < ND; ++d0) op[32 * d0] = (bf16)(cvtpk(o[d0][r] * rs * gs[d0], 0.f) & 0xffffu);
            }
        }
    } else {
#pragma unroll
        for (int r = 0; r < 16; ++r) {
            bf16* op = OUT + (orow0 + crow(r, hi)) * 1024 + r32;
#pragma unroll
            for (int d0 = 0; d0 < ND; ++d0) op[32 * d0] = (bf16)(cvtpk(o[d0][r] * rli[r], 0.f) & 0xffffu);
        }
    }
    asm volatile("s_waitcnt vmcnt(0) lgkmcnt(0)\n\ts_barrier" ::: "memory");
}

template <int NS, int DV, int QP, int VP>
__device__ __forceinline__ void attn_unit_pipe(const bf16* Q0, const bf16* Q1p, const bf16* K0, const bf16* K1p, const bf16* V, long rowbase, int q0,
                                          const float* tblg, const float* gsub, float lam, bf16* OUT  , char* shm) {
    constexpr int KSLOT = NS * 8192, VSLOT = DV * 128, ND = DV / 32, NVP = DV / 64, NG = 4 * ND, EPG = 32 / NG, CPG = EPG / 2, LAG = NG / 4;
    const int tid = threadIdx.x, lane = tid & 63, r32 = lane & 31, hi = lane >> 5; const int wid = __builtin_amdgcn_readfirstlane(tid >> 6);
    const int s = (NS == 2) ? (wid >> 2) : 0, j = (NS == 2) ? (wid & 3) : wid;
    const int ROWS = (NS == 2) ? 128 : 256;
    const int cw = (q0 + 32 * j) >> 6, qi = ((32 * j) & 63) + r32;
    const int t1 = (q0 + ROWS - 1) >> 6;
    int t0 = 0, lo_w = 0;
    if (NS == 1) { t0 = (q0 >> 6) - 8; if (t0 < 0) t0 = 0; lo_w = cw - 8; if (lo_w < 0) lo_w = 0; }
    const unsigned lds0 = (unsigned)(uintptr_t)shm;
    LAS float* tb = (LAS float*)((LAS char*)shm + LDS_TBL);
    LAS float* wsf = (LAS float*)((LAS char*)shm + LDS_WS) + wid * 64;
    if (tid < 256) tb[tid] = tblg[tid];
    const bf16* Qs = (s == 0) ? Q0 : Q1p;
    const bf16* Qw = Qs + (rowbase + q0 + 32 * j) * QP;
    const unsigned koff = (unsigned)(lane * QP + wid * 8) * 2u;
    unsigned voffv[NVP];
#pragma unroll
    for (int i_ = 0; i_ < NVP; ++i_) { const int p_ = wid + 8 * i_; voffv[i_] = (unsigned)((16 * (p_ & 3) + (lane >> 2)) * VP + (p_ >> 2) * 32 + (lane & 3) * 8) * 2u; }
    const bf16* kb0 = K0 + rowbase * QP; const bf16* kb1 = (NS == 2) ? K1p + rowbase * QP : nullptr; const bf16* vb = V + rowbase * VP;
    const unsigned kdst = lds0 + LDS_K + wid * 1024, vdst = lds0 + LDS_V;
    bf16x8 qr[4];
#pragma unroll
    for (int d0 = 0; d0 < 4; ++d0) qr[d0] = *reinterpret_cast<const bf16x8*>(&Qw[(long)r32 * QP + d0 * 16 + hi * 8]);
#define ATT_DMA_K(t, sl) do { \
        glds16(kb0 + (long)(t) * 64 * QP, koff, (unsigned)__builtin_amdgcn_readfirstlane(kdst + (sl) * KSLOT)); \
        if (NS == 2) glds16(kb1 + (long)(t) * 64 * QP, koff, (unsigned)__builtin_amdgcn_readfirstlane(kdst + (sl) * KSLOT + 8192)); } while (0)
#define ATT_DMA_V(t, sl) do { \
        _Pragma("unroll") for (int i_ = 0; i_ < NVP; ++i_) { const int p_ = wid + 8 * i_; \
            glds16(vb + (long)(t) * 64 * VP, voffv[i_], (unsigned)__builtin_amdgcn_readfirstlane(vdst + (sl) * VSLOT + p_ * 1024)); } } while (0)
    ATT_DMA_K(t0, 0); ATT_DMA_V(t0, 0);
    if (t0 + 1 <= t1) ATT_DMA_K(t0 + 1, 1);
    if (t0 + 2 <= t1) ATT_DMA_K(t0 + 2, 2);
    f32x16 o[ND];
#pragma unroll
    for (int d = 0; d < ND; ++d) o[d] = f32x16{};
    float l_reg = 0.f;
    ATT_WAIT_BAR(0);
    asm volatile("" :: "v"(qr[0]), "v"(qr[1]), "v"(qr[2]), "v"(qr[3]));
    const lds_cptr shm3 = (lds_cptr)shm;
    const lds_cptr kp0 = shm3 + LDS_K + s * 8192 + hi * 1024 + r32 * 16;
    const lds_cptr vp0 = shm3 + LDS_V + ((lane >> 4) & 1) * 32 + (lane & 3) * 8 + (4 * hi + ((lane & 15) >> 2)) * 64;
    bf16x8 kf[8];
#define ATT_KRD(i, kp) do { kf[i] = *(const LAS bf16x8*)((kp) + ((i) >> 1) * 2048 + ((i) & 1) * 512); } while (0)
#pragma unroll
    for (int i = 0; i < 8; ++i) ATT_KRD(i, kp0);
    ATT_WAIT_BAR(0);
    f32x16 S0, S1;
    const f32x16 z16 = f32x16{};
    u32x4 pw[4];
#define ATT_VRD(g) do { vlo[g] = vtr(vp + ((g) % ND) * 4096 + ((g) / ND) * 1024); vhi[g] = vtr(vp + ((g) % ND) * 4096 + ((g) / ND) * 1024 + 512); } while (0)
#define ATT_VF(g) (bf16x8){vlo[g][0], vlo[g][1], vlo[g][2], vlo[g][3], vhi[g][0], vhi[g][1], vhi[g][2], vhi[g][3]}
#define ATT_NEAR(t) do { if ((t) >= cw - 2) { const LAS float* tp = tb + (64 * ((t) - cw) + 191 - qi + 4 * hi); \
            _Pragma("unroll") for (int r = 0; r < 16; ++r) { S0[r] += tp[(r & 3) + 8 * (r >> 2)]; S1[r] += tp[32 + (r & 3) + 8 * (r >> 2)]; } } } while (0)
#define ATT_ENDW(t) do { if ((t) + 3 <= t1) { ATT_WAIT_BAR(4); } else if ((t) + 1 <= t1) { ATT_WAIT_BAR(2); } else { ATT_WAIT_BAR(0); } } while (0)
    static_assert(NS == 2 && DV == 128, "pipelined unit: differential attention only");
    if (t0 + 3 <= t1) ATT_DMA_K(t0 + 3, 0);
    if (t0 + 1 <= t1) ATT_DMA_V(t0 + 1, 1);
    {
        S0 = ATT_MFMA(kf[0], qr[0], z16); S1 = ATT_MFMA(kf[1], qr[0], z16);
#pragma unroll
        for (int d0 = 1; d0 < 4; ++d0) { S0 = ATT_MFMA(kf[2 * d0], qr[d0], S0); S1 = ATT_MFMA(kf[2 * d0 + 1], qr[d0], S1); }
        ATT_NEAR(t0);
#pragma unroll
        for (int r = 0; r < 16; ++r) { S0[r] = __builtin_amdgcn_exp2f(S0[r]); S1[r] = __builtin_amdgcn_exp2f(S1[r]); l_reg += S0[r] + S1[r]; }
#pragma unroll
        for (int q = 0; q < 4; ++q) { pw[0][q] = cvtpk(S0[2 * q], S0[2 * q + 1]); pw[1][q] = cvtpk(S0[8 + 2 * q], S0[9 + 2 * q]); pw[2][q] = cvtpk(S1[2 * q], S1[2 * q + 1]); pw[3][q] = 0u; }
        const lds_cptr kpn = kp0 + 1 * KSLOT;
#pragma unroll
        for (int i = 0; i < 8; ++i) ATT_KRD(i, kpn);
    }
    ATT_ENDW(t0);
    int sl = 1;
    for (int t = t0 + 1; t <= t1 + 1; ++t) {
        const int slp = (sl == 0) ? 2 : sl - 1, sln = (sl == 2) ? 0 : sl + 1;
        if (t + 3 <= t1) ATT_DMA_K(t + 3, sl);
        if (t + 1 <= t1) ATT_DMA_V(t + 1, sln);
        if (t - 1 <= cw) {
            const lds_cptr vp = vp0 + slp * VSLOT;
            const lds_cptr kpn = kp0 + sln * KSLOT;
            const float l_keep = l_reg;
            s16x4 vlo[NG], vhi[NG];
            ATT_SB();
            {   const f32x16 So = S1;
                S0 = ATT_MFMA(kf[0], qr[0], z16);
                pw[3][0] = cvtpk(So[8], So[9]); pw[3][1] = cvtpk(So[10], So[11]); pw[3][2] = cvtpk(So[12], So[13]); pw[3][3] = cvtpk(So[14], So[15]); ATT_PIN(pw[3]); ATT_SB(); }
            S1 = ATT_MFMA(kf[1], qr[0], z16); ATT_SB();
            S0 = ATT_MFMA(kf[2], qr[1], S0); ATT_SB();
            S1 = ATT_MFMA(kf[3], qr[1], S1); ATT_SB();
            S0 = ATT_MFMA(kf[4], qr[2], S0); ATT_SB();
            S1 = ATT_MFMA(kf[5], qr[2], S1); ATT_VRD(0); ATT_SB();
            S0 = ATT_MFMA(kf[6], qr[3], S0); ATT_VRD(1); ATT_SB();
            S1 = ATT_MFMA(kf[7], qr[3], S1); ATT_SB();
            if (t <= cw) ATT_NEAR(t);
            ATT_SB();
#pragma unroll
            for (int g = 0; g < NG; ++g) {
                o[g % ND] = ATT_MFMA(__builtin_bit_cast(bf16x8, pw[g / ND]), ATT_VF(g), o[g % ND]);
#pragma unroll
                for (int e = g * EPG; e < (g + 1) * EPG; ++e) { if (e < 16) { S0[e] = __builtin_amdgcn_exp2f(S0[e]); } else { S1[e - 16] = __builtin_amdgcn_exp2f(S1[e - 16]); } }
#pragma unroll
                for (int e = g * EPG; e < (g + 1) * EPG; ++e) { if (e < 16) l_reg += S0[e]; else l_reg += S1[e - 16]; }
                if (g >= LAG) {
#pragma unroll
                    for (int q = (g - LAG) * CPG; q < (g - LAG + 1) * CPG; ++q) { if (q < 8) pw[q >> 2][q & 3] = cvtpk(S0[2 * q], S0[2 * q + 1]); else pw[q >> 2][q & 3] = cvtpk(S1[2 * q - 16], S1[2 * q - 15]); }
                }
                if (g + 2 < NG) ATT_VRD(g + 2);
                if (g >= 2 && g < 10) ATT_KRD(g - 2, kpn);
                ATT_PIN(S0); ATT_PIN(S1); ATT_PIN(l_reg);
                if (g >= LAG) { ATT_PIN(pw[(((g - LAG) * CPG) >> 2)]); }
                ATT_SB();
            }
            if (t > cw) l_reg = l_keep;
        }
        ATT_ENDW(t);
        sl = sln;
    }
#undef ATT_ENDW
#undef ATT_DMA_K
#undef ATT_DMA_V
#undef ATT_VRD
#undef ATT_VF
#undef ATT_NEAR
#undef ATT_KRD
    { auto rr = __builtin_amdgcn_permlane32_swap(__float_as_uint(l_reg), __float_as_uint(l_reg), false, false); l_reg = __uint_as_float(rr[0]) + __uint_as_float(rr[1]); }
    if (hi == 0) wsf[r32] = l_reg;
    LDS_WAIT();
    float rli[16];
#pragma unroll
    for (int r = 0; r < 16; ++r) rli[r] = __builtin_amdgcn_rcpf(wsf[crow(r, hi)]);
    int lane_e = lane; asm volatile("" : "+v"(lane_e));
    const int r32e = lane_e & 31, hie = lane_e >> 5;
    bf16* obase = OUT + (rowbase + q0 + 32 * j + 4 * hie) * 1024 + r32e;
    if (NS == 2) {
        LAS float* X = (LAS float*)((LAS char*)shm + LDS_X);
        if (s == 1) {
#pragma unroll
            for (int d0 = 0; d0 < ND; ++d0)
#pragma unroll
                for (int r = 0; r < 16; ++r) X[((j * ND + d0) * 16 + r) * 64 + lane_e] = lam * o[d0][r] * rli[r];
        }
        asm volatile("s_waitcnt lgkmcnt(0)\n\ts_barrier" ::: "memory");
        if (s == 0) {
            float gs[ND];
#pragma unroll
            for (int d0 = 0; d0 < ND; ++d0) gs[d0] = gsub[32 * d0 + r32e] * 0.8f;
#pragma unroll
            for (int r = 0; r < 16; ++r) {
                float ss = 0.f;
#pragma unroll
                for (int d0 = 0; d0 < ND; ++d0) { o[d0][r] = o[d0][r] * rli[r] - X[((j * ND + d0) * 16 + r) * 64 + lane_e]; ss += o[d0][r] * o[d0][r]; }
#pragma unroll
                for (int m = 1; m < 32; m <<= 1) ss += __shfl_xor(ss, m);
                const float rs = __builtin_amdgcn_rsqf(ss * (1.f / DV) + EPS);
                bf16* op = obase + ((r & 3) + 8 * (r >> 2)) * 1024;
#pragma unroll
                for (int d0 = 0; d0 < ND; ++d0) op[32 * d0] = (bf16)(cvtpk(o[d0][r] * rs * gs[d0], 0.f) & 0xffffu);
            }
        }
    } else {
#pragma unroll
        for (int r = 0; r < 16; ++r) {
            bf16* op = obase + ((r & 3) + 8 * (r >> 2)) * 1024;
#pragma unroll
            for (int d0 = 0; d0 < ND; ++d0) op[32 * d0] = (bf16)(cvtpk(o[d0][r] * rli[r], 0.f) & 0xffffu);
        }
    }
    asm volatile("s_waitcnt vmcnt(0) lgkmcnt(0)\n\ts_barrier" ::: "memory");
}
}

__device__ __forceinline__ unsigned f2bf(float f) { unsigned u = __builtin_bit_cast(unsigned, f); return (u + 0x7fffu + ((u >> 16) & 1u)) >> 16; }
__device__ __forceinline__ unsigned pk2(float lo, float hi) { return f2bf(lo) | (f2bf(hi) << 16); }
__device__ __forceinline__ void p0_tr_item(const float* W, int ldw, int k0, int n0, bf16* dst, int ldd, int drow0, int kd0, LAS float* scr, int lane) {
#pragma unroll 8
    for (int i = 0; i < 32; ++i) { const int kk = 2 * i + (lane >> 5); scr[kk * 33 + (lane & 31)] = W[(size_t)(k0 + kk) * ldw + n0 + (lane & 31)]; }
    LDS_WAIT(); asm volatile("" ::: "memory");
    const int c = lane & 7;
#pragma unroll
    for (int j = 0; j < 4; ++j) { const int n = (lane >> 3) + 8 * j; const LAS float* sp = scr + (8 * c) * 33 + n;
        u32x4 o; o.x = pk2(sp[0 * 33], sp[1 * 33]); o.y = pk2(sp[2 * 33], sp[3 * 33]); o.z = pk2(sp[4 * 33], sp[5 * 33]); o.w = pk2(sp[6 * 33], sp[7 * 33]);
        *(GAS u32x4*)(dst + (size_t)(drow0 + n) * ldd + kd0 + 8 * c) = o; }
    LDS_WAIT(); asm volatile("" ::: "memory");
}
__device__ __forceinline__ int t5_bucket(int rel) {
    const int side = rel > 0 ? 16 : 0; const int n = rel < 0 ? -rel : rel;
    int b;
    if (n < 8) b = n; else if (n < 12) b = 8; else if (n < 16) b = 9; else if (n < 23) b = 10; else if (n < 32) b = 11; else if (n < 46) b = 12; else if (n < 64) b = 13; else if (n < 91) b = 14; else b = 15;
    return side + b;
}

struct Args { const float* in[22]; float* out; unsigned char* ws; int ph_lo, ph_hi; };

__global__ void __launch_bounds__(512, 2) mk_fwd(Args args) {
    extern __shared__ __attribute__((aligned(16))) unsigned char lds_raw[];
    LAS unsigned char* lds = (LAS unsigned char*)lds_raw;
    volatile LAS unsigned* MISC = (volatile LAS unsigned*)(lds + MISC_OFF);
    const int tid = threadIdx.x, lane = tid & 63, wave = __builtin_amdgcn_readfirstlane(tid >> 6);
    const int G = gridDim.x; const int bx = blockIdx.x; const int vcu = (G % 8 == 0) ? (bx % 8) * (G / 8) + bx / 8 : bx;
    unsigned char* ws = args.ws;
    unsigned* ctl = (unsigned*)(ws + WS_CTL);
    for (int u = tid; u < 64; u += 512) ((LAS unsigned*)(lds + MISC_OFF))[u] = 0u;
    __syncthreads();
    XcdBarrier bar; bar.bar = ctl + CW_BAR; bar.x = 0; bar.st = nullptr;
    if (MK_N_LAUNCHES == 1) bar = xcd_barrier_post(ctl + CW_BAR, MISC + 8);
    const int lo = args.ph_lo, hi = args.ph_hi;
#define IN(k) (lo <= (k) && (k) < hi)
#define SEAM(k) do { if (MK_N_LAUNCHES == 1 && IN(k) && IN((k) + 1)) xcd_barrier(bar); } while (0)

    const float* x = args.in[0];
    float* out = args.out;
    bf16* WINT = (bf16*)(ws + WS_WINT); bf16* WABT = (bf16*)(ws + WS_WABT); bf16* WOT = (bf16*)(ws + WS_WOT); bf16* WGUT = (bf16*)(ws + WS_WGUT); bf16* WDT = (bf16*)(ws + WS_WDT);
    bf16* XB = (bf16*)(ws + WS_XB); bf16* OAB = (bf16*)(ws + WS_OAB); bf16* QK = (bf16*)(ws + WS_QK); bf16* MIXED = (bf16*)(ws + WS_MIXED);
    bf16* VA = (bf16*)(ws + WS_VA); bf16* QBb = (bf16*)(ws + WS_QB); bf16* KBb = (bf16*)(ws + WS_KB); bf16* VBb = (bf16*)(ws + WS_VB);
    bf16* HN = (bf16*)(ws + WS_HN); bf16* HB = (bf16*)(ws + WS_H); bf16* YB = (bf16*)(ws + WS_Y);
    bf16* GATES = (bf16*)out;
    float* TBLA = (float*)(ws + WS_TBLA); float* TBLB = (float*)(ws + WS_TBLB); float* LAMV = (float*)(ws + WS_LAM);
    float* WR = (float*)(ws + WS_WR);
    int* TOKPOS = (int*)(ws + WS_TOKPOS); int* LISTTOK = (int*)(ws + WS_LISTTOK); float* LISTW = (float*)(ws + WS_LISTW); unsigned* CURSOR = ctl + CW_CURSOR;

    if (IN(0)) for (int rep = 0; rep < REP0; ++rep) {
        LAS float* scr = (LAS float*)(lds + wave * 16384);
        const int gw = vcu * 8 + wave, NGW = G * 8;
        constexpr int I_IN = 16 * 160, I_A = 8 * 32, I_B = 8 * 32, I_O = 16 * 32, I_G = 32 * 256, I_U = 32 * 256, I_D = 32 * 256;
        constexpr int NITEMS = I_IN + I_A + I_B + I_O + I_G + I_U + I_D;
        for (int it = gw; it < NITEMS; it += NGW) {
            int r = it;
            if (r < I_IN) { const int kb = r / 160, nb = r % 160, n0 = 32 * nb, pn = n0 >> 8, cg = (n0 & 255) >> 5, wcc = cg >> 1, bjj = cg & 1;
                p0_tr_item(args.in[2], PROJ, 64 * kb, n0, WINT, 1024, pn * 256 + 128 * bjj + 32 * wcc, 64 * kb, scr, lane); continue; } r -= I_IN;
            if (r < I_A) { const int kb = r / 32, nb = r % 32; p0_tr_item(args.in[11], 1024, 64 * kb, 32 * nb, WABT, 1024, 32 * nb, 64 * kb, scr, lane); continue; } r -= I_A;
            if (r < I_B) { const int kb = r / 32, nb = r % 32; p0_tr_item(args.in[12], 1024, 64 * kb, 32 * nb, WABT, 1024, 32 * nb, 512 + 64 * kb, scr, lane); continue; } r -= I_B;
            if (r < I_O) { const int kb = r / 32, nb = r % 32; p0_tr_item(args.in[13], 1024, 64 * kb, 32 * nb, WOT, 1024, 32 * nb, 64 * kb, scr, lane); continue; } r -= I_O;
            if (r < I_G + I_U) { const int up = r >= I_G; if (up) r -= I_G; const int e = r >> 8, q = r & 255, kb = q / 16, nb = q % 16, n0 = 32 * nb;
                p0_tr_item((up ? args.in[20] : args.in[19]) + (size_t)e * 1024 * 512, 512, 64 * kb, n0, WGUT, 1024, e * 1024 + (n0 >> 7) * 256 + (n0 & 127) + (up ? 128 : 0), 64 * kb, scr, lane); continue; } r -= I_G + I_U;
            { const int e = r >> 8, q = r & 255, kb = q / 32, nb = q % 32; p0_tr_item(args.in[21] + (size_t)e * 512 * 1024, 1024, 64 * kb, 32 * nb, WDT, 512, e * 1024 + 32 * nb, 64 * kb, scr, lane); }
        }
        for (int m = gw; m < T; m += NGW) {
            const GAS f32x4* xr = (const GAS f32x4*)(x + (size_t)m * D) + lane; const GAS f32x4* gr = (const GAS f32x4*)args.in[1] + lane;
            f32x4 v[4]; float ssq = 0.f;
#pragma unroll
            for (int j = 0; j < 4; ++j) { v[j] = xr[64 * j]; ssq += (v[j].x * v[j].x + v[j].y * v[j].y) + (v[j].z * v[j].z + v[j].w * v[j].w); }
            const float rstd = __builtin_amdgcn_rsqf(wave_sum(ssq) * (1.f / D) + EPS);
            GAS u32x2* o8 = (GAS u32x2*)(XB + (size_t)m * D) + lane;
#pragma unroll
            for (int j = 0; j < 4; ++j) { const f32x4 g = gr[64 * j]; u32x2 w; w.x = pk2(v[j].x * rstd * g.x, v[j].y * rstd * g.y); w.y = pk2(v[j].z * rstd * g.z, v[j].w * rstd * g.w); o8[64 * j] = w; }
        }
        for (int idx = gw * 64 + lane; idx < 48 * 1024; idx += NGW * 64) { const int n = idx >> 10, k = idx & 1023; float w = 0.f;
            if (n < 32) w = args.in[17][k * 32 + n]; else if (n < 36) w = args.in[15][k * 4 + (n - 32)];
            WR[idx] = w * args.in[14][k]; }
        for (int idx = gw * 64 + lane; idx < 12 * 256; idx += NGW * 64) {
            const int hh = idx >> 8, i = idx & 255; const bool isA = hh < 4; const int h = isA ? hh : hh - 4;
            const float farv = isA ? args.in[7][15 * 4 + h] : args.in[10][0 * 8 + h];
            float v;
            if (i == 255) v = farv * LOG2E;
            else { const int rel = i - 191; float b;
                if (isA) b = args.in[7][t5_bucket(rel) * 4 + h];
                else { int ri = rel < -128 ? -128 : (rel > 128 ? 128 : rel); b = args.in[10][(ri + 128) * 8 + h]; }
                v = (b - farv) * LOG2E; }
            (isA ? TBLA : TBLB)[h * 256 + i] = v;
        }
        if (gw == 0) { const float* lp = args.in[5]; const float a = wave_sum(lp[lane] * lp[64 + lane]), b = wave_sum(lp[128 + lane] * lp[192 + lane]);
            if (lane == 0) LAMV[0] = expf(a) - expf(b) + 0.2f; }
    }
    SEAM(0);

    if (IN(1)) for (int rep = 0; rep < REP1; ++rep) {
        pg8::DenseSched S{(const char*)XB, (const char*)WINT, 1024, 1024, T / 256, PROJ / 256, G, bx, 1, 1024};
        EpiProj E{QK, VA, QBb, KBb, VBb, GATES, args.in[3], args.in[4], args.in[8], args.in[9]};
        pg8::gemm_phase<EpiProj, pg8::DenseSched, true>(lds, 1024, S, E);
    }
    SEAM(1);

    if (IN(2)) {
        const float lam = LAMV[0];
        for (int i = 0; i < 2 * REP2A; ++i) {
            const int uidx = vcu; const int bh = uidx >> 5, sidx = uidx & 31; const int qb = ((i & 1) == 0) ? sidx : 63 - sidx;
            const int b = bh >> 2, h = bh & 3;
            if (vcu < 256)
            att::attn_unit_pipe<2, 128, 256, 512>(QK + h * 64, QK + (size_t)T * 256 + h * 64, QK + (size_t)2 * T * 256 + h * 64, QK + (size_t)3 * T * 256 + h * 64, VA + h * 128,
                                              (long)b * SEQ, qb * 128, TBLA + h * 256, args.in[6], lam, OAB + h * 128, (char*)lds_raw);
        }
        for (int i = 0; i < 2 * REP2B; ++i) {
            const int uidx = vcu * 2 + (i & 1); const int bh = uidx >> 5, grp = uidx & 31; const int b = bh >> 3, h = bh & 7;
            if (vcu < 256)
            att::attn_unit_simple<1, 64, 512, 512>(QBb + h * 64, nullptr, KBb + h * 64, nullptr, VBb + h * 64, (long)b * SEQ, grp * 256, TBLB + h * 256, nullptr, 0.f, OAB + 512 + h * 64, (char*)lds_raw);
        }
    }
    SEAM(2);

    if (IN(3)) for (int rep = 0; rep < REP3; ++rep) {
        pg8::DenseSched S{(const char*)OAB, (const char*)WABT, 1024, 1024, T / 256, D / 256, G, bx, 2, 512};
        EpiAB E{GATES, MIXED};
        pg8::gemm_phase<EpiAB, pg8::DenseSched, false>(lds, 512, S, E);
    }
    SEAM(3);

    if (IN(4)) for (int rep = 0; rep < REP4; ++rep) {
        pg8::DenseSched S{(const char*)MIXED, (const char*)WOT, 1024, 1024, T / 256, D / 256, G, bx, 1, 1024};
        EpiRes E{x, out};
        pg8::gemm_phase<EpiRes, pg8::DenseSched, false>(lds, 1024, S, E);
    }
    SEAM(4);

    if (IN(5)) for (int rep = 0; rep < REP5; ++rep) {
        LAS float* LG = (LAS float*)lds;
        LAS float* RS = LG + 64 * 48;
        for (int task = vcu; task < T / 64; task += G) {
            if (wave < 4) {
                const int rl = lane & 15, q = lane >> 4; const int row = task * 64 + wave * 16 + rl;
                const float* xr = out + (size_t)row * D + 4 * q; const float* w0p = WR + (size_t)rl * 1024 + 4 * q;
                f32x4 a0 = {0.f, 0.f, 0.f, 0.f}, a1 = a0, a2 = a0; float ssq = 0.f;
#pragma unroll 4
                for (int c = 0; c < 64; ++c) {
                    const f32x4 xa = *(const f32x4*)(xr + 16 * c);
                    const f32x4 w0 = *(const f32x4*)(w0p + 16 * c), w1 = *(const f32x4*)(w0p + 16 * 1024 + 16 * c), w2 = *(const f32x4*)(w0p + 32 * 1024 + 16 * c);
#pragma unroll
                    for (int s = 0; s < 4; ++s) { a0 = __builtin_amdgcn_mfma_f32_16x16x4f32(xa[s], w0[s], a0, 0, 0, 0); a1 = __builtin_amdgcn_mfma_f32_16x16x4f32(xa[s], w1[s], a1, 0, 0, 0);
                        a2 = __builtin_amdgcn_mfma_f32_16x16x4f32(xa[s], w2[s], a2, 0, 0, 0); }
                    ssq += (xa.x * xa.x + xa.y * xa.y) + (xa.z * xa.z + xa.w * xa.w);
                }
                ssq += __shfl_xor(ssq, 16); ssq += __shfl_xor(ssq, 32);
                const float rstd = __builtin_amdgcn_rsqf(ssq * (1.f / D) + EPS);
#pragma unroll
                for (int r = 0; r < 4; ++r) { LAS float* lp = LG + (wave * 16 + 4 * q + r) * 48 + rl; lp[0] = a0[r]; lp[16] = a1[r]; lp[32] = a2[r]; }
                if (q == 0) RS[wave * 16 + rl] = rstd;
            }
            __syncthreads();
            if (wave == 0) {
                const int row = task * 64 + lane; const float rs = RS[lane]; const LAS float* lg = LG + lane * 48;
                float gl[4]; float gmax = -3.0e38f; int gi = 0;
#pragma unroll
                for (int jj = 0; jj < 4; ++jj) { gl[jj] = lg[32 + jj] * rs + args.in[16][jj]; if (gl[jj] > gmax) { gmax = gl[jj]; gi = jj; } }
                float gsum = 0.f;
#pragma unroll
                for (int jj = 0; jj < 4; ++jj) gsum += __expf(gl[jj] - gmax);
                const float pg = 1.f / gsum;
                float el[8]; float b1 = -3.0e38f, b2 = -3.0e38f; int i1 = 0, i2 = 0;
#pragma unroll
                for (int jj = 0; jj < 8; ++jj) { el[jj] = lg[8 * gi + jj] * rs + args.in[18][8 * gi + jj]; if (el[jj] > b1) { b1 = el[jj]; i1 = jj; } }
#pragma unroll
                for (int jj = 0; jj < 8; ++jj) { if (jj != i1 && el[jj] > b2) { b2 = el[jj]; i2 = jj; } }
                const float wa = pg / (1.f + __expf(b2 - b1)), wb = pg - wa;
                const int e1 = 8 * gi + i1, e2 = 8 * gi + i2;
                int mycnt = 0;
                for (int ee = 0; ee < 32; ++ee) { const int c = __popcll(__ballot(e1 == ee)) + __popcll(__ballot(e2 == ee)); if (lane == ee) mycnt = c; }
                int mybase = 0;
                if (lane < 32 && mycnt > 0) mybase = (int)__hip_atomic_fetch_add(CURSOR + lane, (unsigned)mycnt, __ATOMIC_RELAXED, __HIP_MEMORY_SCOPE_AGENT);
                int p1 = 0, p2 = 0; const unsigned long long lt = (1ull << lane) - 1ull;
                for (int ee = 0; ee < 32; ++ee) {
                    const unsigned long long m1 = __ballot(e1 == ee), m2 = __ballot(e2 == ee); const int be = __shfl(mybase, ee);
                    if (e1 == ee) p1 = be + __popcll(m1 & lt);
                    if (e2 == ee) p2 = be + __popcll(m1) + __popcll(m2 & lt);
                }
                LISTTOK[e1 * CAP + p1] = row; LISTW[e1 * CAP + p1] = wa; LISTTOK[e2 * CAP + p2] = row; LISTW[e2 * CAP + p2] = wb;
                TOKPOS[2 * row] = (e1 << 16) | p1; TOKPOS[2 * row + 1] = (e2 << 16) | p2;
            }
            for (int rr = 0; rr < 8; ++rr) {
                const int r = wave * 8 + rr; const int row = task * 64 + r; const float rs = RS[r];
                const GAS f32x4* xr = (const GAS f32x4*)(out + (size_t)row * D) + lane; const GAS f32x4* gr = (const GAS f32x4*)args.in[14] + lane;
                GAS u32x2* o8 = (GAS u32x2*)(HN + (size_t)row * D) + lane;
#pragma unroll
                for (int j = 0; j < 4; ++j) { const f32x4 v = xr[64 * j], g = gr[64 * j]; u32x2 w; w.x = pk2(v.x * rs * g.x, v.y * rs * g.y); w.y = pk2(v.z * rs * g.z, v.w * rs * g.w); o8[64 * j] = w; }
            }
            __syncthreads();
        }
    }
    SEAM(5);

    LAS int* MOE_CNT = (LAS int*)(lds + MISC_OFF + 256); LAS int* MOE_TB = MOE_CNT + 32;
    if (hi > 6) {
        if (wave == 0) {
            const int e = lane & 31; const int cnt = (int)__hip_atomic_load(CURSOR + e, __ATOMIC_RELAXED, __HIP_MEMORY_SCOPE_AGENT); const int nt = (cnt + 255) >> 8;
            int incl = nt;
#pragma unroll
            for (int o = 1; o < 32; o <<= 1) { const int v = __shfl_up(incl, o); if ((lane & 31) >= o) incl += v; }
            if (lane < 32) { MOE_CNT[e] = cnt; MOE_TB[e] = incl - nt; if (e == 31) MOE_TB[32] = incl; }
        }
        __syncthreads();
    }
#define MOE_LOOKUP(mu, nunits) do { nunits = MOE_TB[32] * 4; \
        _Pragma("unroll") for (int i_ = 0; i_ < 3; ++i_) { const int L_ = i_ * G + vcu; int e_ = 0, p_ = 0, n_ = 1; \
            if (L_ < nunits) { const int rt_ = L_ >> 2; for (int q_ = 0; q_ < 32; ++q_) { if (MOE_TB[q_] <= rt_ && rt_ < MOE_TB[q_ + 1]) e_ = q_; } p_ = (rt_ - MOE_TB[e_]) * 256; n_ = MOE_CNT[e_]; } \
            mu.e[i_] = __builtin_amdgcn_readfirstlane(e_); mu.pos0[i_] = __builtin_amdgcn_readfirstlane(p_); mu.n[i_] = __builtin_amdgcn_readfirstlane(n_); } } while (0)

    if (IN(6)) for (int rep = 0; rep < REP6; ++rep) {
        pg8::MoeUnits mu; int nunits; MOE_LOOKUP(mu, nunits);
        pg8::MoeSched<true> S{(const char*)HN, (const char*)WGUT, LISTTOK, 1024, 1024, G, vcu, nunits, mu, (size_t)1024 * 1024 * 2};
        EpiGU E{HB};
        pg8::gemm_phase<EpiGU, pg8::MoeSched<true>, true>(lds, 1024, S, E);
    }
    SEAM(6);

    if (IN(7)) for (int rep = 0; rep < REP7; ++rep) {
        pg8::MoeUnits mu; int nunits; MOE_LOOKUP(mu, nunits);
        pg8::MoeSched<false> S{(const char*)HB, (const char*)WDT, LISTTOK, 512, 512, G, vcu, nunits, mu, (size_t)1024 * 512 * 2};
        EpiDown E{YB, LISTW};
        pg8::gemm_phase<EpiDown, pg8::MoeSched<false>, true>(lds, 512, S, E);
    }
    SEAM(7);

    if (IN(8)) {
        const int gw = vcu * 8 + wave, NGW = G * 8;
        for (int m = gw; m < T; m += NGW) {
            const int c1 = TOKPOS[2 * m], c2 = TOKPOS[2 * m + 1];
            const int s1 = MOE_TB[c1 >> 16] * 256 + (c1 & 0xffff), s2 = MOE_TB[c2 >> 16] * 256 + (c2 & 0xffff);
            GAS f32x4* xr = (GAS f32x4*)(out + (size_t)m * D) + lane;
            const GAS u32x2* y1 = (const GAS u32x2*)(YB + (size_t)s1 * D) + lane; const GAS u32x2* y2 = (const GAS u32x2*)(YB + (size_t)s2 * D) + lane;
#pragma unroll
            for (int j = 0; j < 4; ++j) { f32x4 v = xr[64 * j]; const u32x2 a = y1[64 * j], b = y2[64 * j];
                v.x += __uint_as_float(a.x << 16) + __uint_as_float(b.x << 16); v.y += __uint_as_float(a.x & 0xffff0000u) + __uint_as_float(b.x & 0xffff0000u);
                v.z += __uint_as_float(a.y << 16) + __uint_as_float(b.y << 16); v.w += __uint_as_float(a.y & 0xffff0000u) + __uint_as_float(b.y & 0xffff0000u);
                xr[64 * j] = v; }
        }
    }
#undef IN
#undef SEAM
}

extern "C" void kernel_launch(void* const* d_in, const int* in_sizes, int n_in, void* d_out, int out_size, void* d_ws, size_t ws_size, hipStream_t stream) {
    static int grid = 0;
    if (grid == 0) {
        if (n_in != 22 || out_size != T * D || ws_size < WS_END) { fprintf(stderr, "kernel_launch: unexpected shapes (n_in %d out %d ws %zu)\n", n_in, out_size, ws_size); grid = -1; return; }
        if (hipFuncSetAttribute((const void*)mk_fwd, hipFuncAttributeMaxDynamicSharedMemorySize, LDS_BYTES) != hipSuccess) { fprintf(stderr, "kernel_launch: hipFuncSetAttribute failed\n"); grid = -1; return; }
        int dev = 0, cus = 0, per_cu = 0;
        (void)hipGetDevice(&dev); (void)hipDeviceGetAttribute(&cus, hipDeviceAttributeMultiprocessorCount, dev);
        (void)hipOccupancyMaxActiveBlocksPerMultiprocessor(&per_cu, (const void*)mk_fwd, 512, LDS_BYTES);
        (void)hipGetLastError();
        if (cus != 256 || per_cu < 1) fprintf(stderr, "kernel_launch: note: %d CUs, occupancy query %d\n", cus, per_cu);
        grid = 256;
    }
    if (grid < 0) return;
    (void)hipMemsetAsync((char*)d_ws + WS_CTL, 0, CTL_ZERO_BYTES, stream);
    Args a{};
    for (int i = 0; i < 22; ++i) a.in[i] = (const float*)d_in[i];
    a.out = (float*)d_out; a.ws = (unsigned char*)d_ws;
    if (MK_N_LAUNCHES == 1) { a.ph_lo = 0; a.ph_hi = NPHASE; hipLaunchKernelGGL(mk_fwd, dim3(grid), dim3(512), LDS_BYTES, stream, a); }
    else { for (int p = 0; p < NPHASE; ++p) { a.ph_lo = p; a.ph_hi = p + 1; hipLaunchKernelGGL(mk_fwd, dim3(grid), dim3(512), LDS_BYTES, stream, a); } }
}
```

```cpp
#include <hip/hip_runtime.h>
#include <cstdio>
#include <cstdint>

#ifndef MK_N_LAUNCHES
#define MK_N_LAUNCHES 1
#endif
constexpr int NPHASE = 9;
#ifndef TS_PHASE
#define TS_PHASE -1
#endif
#ifndef REP0
#define REP0 1
#endif
#ifndef REP1
#define REP1 1
#endif
#ifndef REP2A
#define REP2A 1
#endif
#ifndef REP2B
#define REP2B 1
#endif
#ifndef REP3
#define REP3 1
#endif
#ifndef REP4
#define REP4 1
#endif
#ifndef REP5
#define REP5 1
#endif
#ifndef REP6
#define REP6 1
#endif
#ifndef REP7
#define REP7 1
#endif
#ifndef REP8
#define REP8 1
#endif

#define GAS __attribute__((address_space(1)))
#define LAS __attribute__((address_space(3)))
typedef unsigned short bf16;
typedef short bf16x8 __attribute__((ext_vector_type(8)));
typedef short s16x4 __attribute__((ext_vector_type(4)));
typedef float f32x4 __attribute__((ext_vector_type(4)));
typedef float f32x16 __attribute__((ext_vector_type(16)));
typedef unsigned u32x4 __attribute__((ext_vector_type(4)));
typedef unsigned u32x2 __attribute__((ext_vector_type(2)));

constexpr int T = 16384, SEQ = 8192, D = 1024, PROJ = 5120;
constexpr int NEXP = 32, DEXP = 512;
constexpr int MAXSLOT = 40960, MAXTILES = MAXSLOT / 256;
constexpr float EPS = 1e-6f;
constexpr float LOG2E = 1.4426950408889634f;
constexpr float C2 = 0.125f * LOG2E;

constexpr size_t MiB = 1u << 20;
constexpr size_t WS_CTL = 0, CTL_ZERO_BYTES = 192 * 1024;
constexpr size_t WS_TBLA = 1 * MiB;
constexpr size_t WS_TBLB = WS_TBLA + 4096;
constexpr size_t WS_LAM = WS_TBLB + 8192;
constexpr size_t WS_WR = 1 * MiB + 64 * 1024;
constexpr size_t WS_TOKPOS = 1 * MiB + 512 * 1024;
constexpr size_t WS_LISTTOK = 2 * MiB;
constexpr size_t WS_LISTW = 226 * MiB;
constexpr size_t WS_WINT = 4 * MiB;
constexpr size_t WS_WABT = 14 * MiB;
constexpr size_t WS_WOT = 16 * MiB;
constexpr size_t WS_WGUT = 18 * MiB;
constexpr size_t WS_WDT = 82 * MiB;
constexpr size_t WS_XB = 114 * MiB;
constexpr size_t WS_OAB = 114 * MiB;
constexpr size_t WS_QK = 146 * MiB;
constexpr size_t WS_MIXED = 146 * MiB;
constexpr size_t WS_VA = 178 * MiB;
constexpr size_t WS_QB = 194 * MiB, WS_KB = 210 * MiB, WS_VB = 226 * MiB;
constexpr size_t WS_AO = 114 * MiB;
constexpr size_t WS_H = 242 * MiB;
constexpr size_t WS_Y = 146 * MiB;
constexpr size_t WS_LISTR = 228 * MiB;
constexpr size_t WS_END = 282 * MiB;
constexpr int CW_BAR = 1024;
constexpr int CW_CONV = 8448;
constexpr int CW_MIXCTR = 32768, CW_AOCTR = 36864;
constexpr int CW_TILECTR = 16384;
constexpr int CW_CURSOR = 8192;
constexpr int CAP = 16384;

constexpr int RING_BYTES = 131072;
constexpr int MISC_OFF = RING_BYTES;
constexpr int LDS_BYTES = 147456;

#define LDS_WAIT() asm volatile("s_waitcnt lgkmcnt(0)" ::: "memory")
#define VM_WAIT() asm volatile("s_waitcnt vmcnt(0)" ::: "memory")
__device__ __forceinline__ unsigned cvt_pk_bf16(float lo, float hi) { unsigned r; asm volatile("v_cvt_pk_bf16_f32 %0, %1, %2" : "=v"(r) : "v"(lo), "v"(hi)); return r; }
__device__ __forceinline__ float bf2f(unsigned short b) { return __uint_as_float((unsigned)b << 16); }
__device__ __forceinline__ float wave_sum(float v) {
#pragma unroll
    for (int o = 1; o < 64; o <<= 1) v += __shfl_xor(v, o);
    return v;
}

#define XB_TMO      128
#define XB_XCNT(j)  (256  + 64 * (j))
#define XB_XSUB(j)  (1280 + 64 * (j))
#define XB_XGEN(j)  (2304 + 64 * (j))
#define XB_TOP      3328
#define XB_TOPGEN   3392
#define XCD_BAR_WORDS 3456
#define XB_SPIN_CAP (1u << 18)
__device__ __forceinline__ unsigned xb_ld(unsigned* p)              { return __hip_atomic_load(p, __ATOMIC_RELAXED, __HIP_MEMORY_SCOPE_AGENT); }
__device__ __forceinline__ unsigned xb_add(unsigned* p, unsigned v) { return __hip_atomic_fetch_add(p, v, __ATOMIC_RELAXED, __HIP_MEMORY_SCOPE_AGENT); }
__device__ __forceinline__ unsigned xb_xcc_id() { return (unsigned)__builtin_amdgcn_s_getreg((3 << 11) | 20) & 0xFu; }
#define XB_SPIN(cond, bar) do { unsigned _sp = 0; while (cond) { __builtin_amdgcn_s_sleep(1); \
    if ((++_sp & 255u) == 0u) { if (xb_ld(&(bar)[XB_TMO])) break; if (_sp > XB_SPIN_CAP) { atomicAdd(&(bar)[XB_TMO], 1u); break; } } } } while (0)
struct XcdBarrier { unsigned* bar; unsigned x; volatile LAS unsigned* st; };
__device__ __forceinline__ XcdBarrier xcd_barrier_post(unsigned* bar, volatile LAS unsigned* st) {
    XcdBarrier b; b.bar = bar; b.x = xb_xcc_id(); b.st = st;
    if (threadIdx.x == 0) (void)xb_add(&bar[XB_XCNT(b.x)], 1u);
    return b;
}
__device__ __forceinline__ void xcd_barrier_complete(unsigned* bar, unsigned x, unsigned& nloc, unsigned& nx) {
    const unsigned G = gridDim.x * gridDim.y * gridDim.z;
    unsigned sum, cnt, mine, sp = 0u;
    for (;;) {
        sum = 0u; cnt = 0u; mine = 0u;
#pragma unroll
        for (unsigned j = 0; j < 16; ++j) { const unsigned c = xb_ld(&bar[XB_XCNT(j)]); sum += c; cnt += (c > 0u) ? 1u : 0u; mine = (j == x) ? c : mine; }
        if (sum == G) break;
        __builtin_amdgcn_s_sleep(1);
        if ((++sp & 255u) == 0u) { if (xb_ld(&bar[XB_TMO])) break; if (sp > XB_SPIN_CAP) { atomicAdd(&bar[XB_TMO], 1u); break; } }
    }
    nloc = mine > 0u ? mine : 1u; nx = cnt > 0u ? cnt : 1u;
}
__device__ __forceinline__ void xcd_barrier(const XcdBarrier& b) {
    asm volatile("s_waitcnt vmcnt(0)" ::: "memory");
    __syncthreads();
    if (threadIdx.x == 0) {
        unsigned* bar = b.bar;
        __builtin_amdgcn_s_waitcnt(0);
        unsigned nloc = b.st[0], nx = b.st[1];
        if (nloc == 0u) { xcd_barrier_complete(bar, b.x, nloc, nx); b.st[0] = nloc; b.st[1] = nx; }
        const unsigned old = xb_add(&bar[XB_XSUB(b.x)], 1u);
        const unsigned gen = old / nloc;
        if (old + 1u == (gen + 1u) * nloc) {
            __builtin_amdgcn_fence(__ATOMIC_RELEASE, "agent");
            asm volatile("s_waitcnt vmcnt(0)" ::: "memory");
            const unsigned og = xb_add(&bar[XB_TOP], 1u);
            const unsigned tg = og / nx;
            if (og + 1u == (tg + 1u) * nx) xb_add(&bar[XB_TOPGEN], 1u);
            else XB_SPIN(xb_ld(&bar[XB_TOPGEN]) == tg, bar);
            __builtin_amdgcn_fence(__ATOMIC_ACQUIRE, "agent");
            xb_add(&bar[XB_XGEN(b.x)], 1u);
            asm volatile("s_waitcnt vmcnt(0)" ::: "memory");
        } else {
            XB_SPIN(xb_ld(&bar[XB_XGEN(b.x)]) == gen, bar);
            __builtin_amdgcn_fence(__ATOMIC_ACQUIRE, "agent");
            asm volatile("s_waitcnt vmcnt(0)" ::: "memory");
        }
    }
    __syncthreads();
}

namespace pg8 {
constexpr int BM = 256, BK = 64, HALF = 128, HTB = HALF * BK * 2, NXCD = 8, WGM = 8;
__host__ __device__ __forceinline__ int lds_byte(int r, int c) { const int st = (r >> 4) * 2 + (c >> 5), rr = r & 15, cc = c & 31, ob = rr * 64 + cc * 2; return st * 1024 + (ob ^ (((ob >> 9) & 1) << 5)); }
__host__ __device__ __forceinline__ void stage_rc(int b, int& R, int& C) { const int st = b / 1024, sb = b % 1024, swz = sb ^ (((sb >> 9) & 1) << 5); R = (st >> 1) * 16 + swz / 64; C = (st & 1) * 32 + (swz % 64) / 2; }
__host__ __device__ __forceinline__ int perm32(int rho) { const int n = rho >> 4, i = rho & 15; return 8 * (i >> 2) + 4 * n + (i & 3); }

struct Unit { int pm, pn, e, part, pos0, n; };

__device__ __forceinline__ void tile_of(int L, int nM, int nN, int& pm, int& pn) {
    const int nwg = nM * nN; int wgid = L;
    { const int q = nwg / NXCD, r = nwg % NXCD, xcd = wgid % NXCD, off = wgid / NXCD; wgid = (xcd < r ? xcd * (q + 1) : r * (q + 1) + (xcd - r) * q) + off; }
    const int nig = WGM * nN, gid = wgid / nig, fm = gid * WGM, gsz = (nM - fm) < WGM ? (nM - fm) : WGM;
    pm = fm + ((wgid % nig) % gsz); pn = (wgid % nig) / gsz;
}

template <class Epi, class Sched, bool ALIGN_EPI>
__device__ __forceinline__ void gemm_phase(LAS unsigned char* lds, const int K, const Sched& S, const Epi& E) {
    const int tid = threadIdx.x, wid = __builtin_amdgcn_readfirstlane(tid >> 6), lane = tid & 63, wr = wid >> 2, wc = wid & 3, fr = lane & 15, fq = lane >> 4;
    const int nt = K / BK;
    int Rr[2], Cc[2]; unsigned voffB[2];
#pragma unroll
    for (int i = 0; i < 2; ++i) { int R, C; stage_rc(tid * 16 + i * 8192, R, C); Rr[i] = R; Cc[i] = C; const int Rb = Epi::PERM ? ((R & ~31) + perm32(R & 31)) : R; voffB[i] = (unsigned)(Rb * S.ldb + C) * 2u; }
    const size_t kstep = (size_t)(BK * 2);
    const size_t hstepB = (size_t)HALF * S.ldb * 2;
    const unsigned ldsw = (unsigned)wid * 1024u;
    const int aoff = lds_byte(wr * 64 + fr, fq * 8), boff = lds_byte(wc * 32 + fr, fq * 8);
#define PG8_SA(b, h) (((b) * 2 + (h)) * HTB)
#define PG8_SB(b, h) ((4 + (b) * 2 + (h)) * HTB)
#define PG8_STAGE_A(bufoff, gbase, offh) do { _Pragma("unroll") for (int _i = 0; _i < 2; ++_i) \
        __builtin_amdgcn_global_load_lds((const unsigned*)((const char*)(gbase) + (offh)[_i]), (LAS unsigned*)(lds + (bufoff) + ldsw + _i * 8192), 16, 0, 0); } while (0)
#define PG8_STAGE_B(bufoff, gbase) do { _Pragma("unroll") for (int _i = 0; _i < 2; ++_i) \
        __builtin_amdgcn_global_load_lds((const unsigned*)((const char*)(gbase) + voffB[_i]), (LAS unsigned*)(lds + (bufoff) + ldsw + _i * 8192), 16, 0, 0); } while (0)
#define PG8_LDA(dst, b, h) do { _Pragma("unroll") for (int m = 0; m < 4; ++m) _Pragma("unroll") for (int k = 0; k < 2; ++k) dst[m][k] = *(const LAS bf16x8*)(lds + PG8_SA(b, h) + aoff + m * 2048 + k * 1024); } while (0)
#define PG8_LDB(dst, b, h) do { _Pragma("unroll") for (int n = 0; n < 2; ++n) _Pragma("unroll") for (int k = 0; k < 2; ++k) dst[n][k] = *(const LAS bf16x8*)(lds + PG8_SB(b, h) + boff + n * 2048 + k * 1024); } while (0)
#define PG8_MMA(ai, bj, At, Bt) do { __builtin_amdgcn_s_setprio(1); _Pragma("unroll") for (int m = 0; m < 4; ++m) _Pragma("unroll") for (int n = 0; n < 2; ++n) _Pragma("unroll") for (int k = 0; k < 2; ++k) \
        acc[ai][bj][m][n] = __builtin_amdgcn_mfma_f32_16x16x32_bf16(Bt[n][k], At[m][k], acc[ai][bj][m][n], 0, 0, 0); __builtin_amdgcn_s_setprio(0); } while (0)
#define PG8_WAIT_V(n) asm volatile("s_waitcnt vmcnt(" #n ")" ::: "memory")
#define PG8_WAIT_L(n) asm volatile("s_waitcnt lgkmcnt(" #n ")" ::: "memory")
#define PG8_BAR __builtin_amdgcn_s_barrier()
#define PG8_SCHED __builtin_amdgcn_sched_barrier(0)
    Unit cur, nxt; int ui = 0;
    if (!S.next(0, cur)) return;
    f32x4 acc[2][2][4][2];
#pragma unroll
    for (int a = 0; a < 2; ++a)
#pragma unroll
        for (int b = 0; b < 2; ++b)
#pragma unroll
            for (int m = 0; m < 4; ++m)
#pragma unroll
                for (int n = 0; n < 2; ++n) acc[a][b][m][n] = (f32x4){0.f, 0.f, 0.f, 0.f};
    bf16x8 At[4][2], B0[2][2], B1[2][2];
    const char* cA = S.a_base(cur); const char* cB = S.b_base(cur);
    unsigned oA[2][2], nraw[2][2];
    {
        unsigned raw[2][2];
#pragma unroll
        for (int h = 0; h < 2; ++h)
#pragma unroll
            for (int i = 0; i < 2; ++i) raw[h][i] = S.a_raw(cur, h, Rr[i]);
        if (Sched::GATHER) PG8_WAIT_V(0);
#pragma unroll
        for (int h = 0; h < 2; ++h)
#pragma unroll
            for (int i = 0; i < 2; ++i) oA[h][i] = S.a_conv(raw[h][i], Cc[i]);
    }
    PG8_STAGE_B(PG8_SB(0, 0), cB); PG8_STAGE_B(PG8_SB(0, 1), cB + hstepB); PG8_STAGE_A(PG8_SA(0, 0), cA, oA[0]); PG8_STAGE_A(PG8_SA(0, 1), cA, oA[1]);
    if (wr == 1) PG8_BAR;
    PG8_WAIT_V(2); PG8_BAR;
    PG8_STAGE_B(PG8_SB(1, 0), cB + kstep); PG8_STAGE_A(PG8_SA(1, 0), cA + kstep, oA[0]); PG8_STAGE_B(PG8_SB(1, 1), cB + hstepB + kstep);
    PG8_WAIT_V(6); PG8_BAR;
    for (;;) {
        const bool has_next = S.next(ui + 1, nxt);
        const char* nA = has_next ? S.a_base(nxt) : cA; const char* nB = has_next ? S.b_base(nxt) : cB;
        if (has_next) {
#pragma unroll
            for (int h = 0; h < 2; ++h)
#pragma unroll
                for (int i = 0; i < 2; ++i) nraw[h][i] = S.a_raw(nxt, h, Rr[i]);
        }
        for (int t = 0; t < nt; t += 2) {
            const bool last = (t == nt - 2);
            const char* a1 = cA + (size_t)(t + 1) * kstep;
            const char* a2 = last ? nA : cA + (size_t)(t + 2) * kstep; const char* b2 = last ? nB : cB + (size_t)(t + 2) * kstep;
            const char* a3 = a2 + kstep; const char* b3 = b2 + kstep;
            PG8_LDB(B0, 0, 0); PG8_LDB(B1, 0, 1); PG8_SCHED; PG8_LDA(At, 0, 0); PG8_STAGE_A(PG8_SA(1, 1), a1, oA[1]);
            PG8_WAIT_V(8); PG8_WAIT_L(0); PG8_BAR; PG8_MMA(0, 0, At, B0); PG8_MMA(0, 1, At, B1); PG8_BAR; PG8_SCHED;
            if (last && has_next) {
#pragma unroll
                for (int h = 0; h < 2; ++h)
#pragma unroll
                    for (int i = 0; i < 2; ++i) oA[h][i] = S.a_conv(nraw[h][i], Cc[i]);
            }
            PG8_LDA(At, 0, 1); PG8_STAGE_B(PG8_SB(0, 0), b2); PG8_STAGE_B(PG8_SB(0, 1), b2 + hstepB); PG8_STAGE_A(PG8_SA(0, 0), a2, oA[0]);
            PG8_WAIT_V(8); PG8_WAIT_L(0); PG8_BAR; PG8_MMA(1, 0, At, B0); PG8_MMA(1, 1, At, B1); PG8_BAR; PG8_SCHED;
            PG8_LDB(B0, 1, 0); PG8_LDB(B1, 1, 1); PG8_SCHED; PG8_LDA(At, 1, 0); PG8_STAGE_A(PG8_SA(0, 1), a2, oA[1]);
            PG8_WAIT_V(8); PG8_WAIT_L(0); PG8_BAR; PG8_MMA(0, 0, At, B0); PG8_MMA(0, 1, At, B1); PG8_BAR; PG8_SCHED;
            PG8_LDA(At, 1, 1); PG8_STAGE_B(PG8_SB(1, 0), b3); PG8_STAGE_B(PG8_SB(1, 1), b3 + hstepB); PG8_STAGE_A(PG8_SA(1, 0), a3, oA[0]);
            PG8_WAIT_V(8); PG8_WAIT_L(0); PG8_BAR; PG8_MMA(1, 0, At, B0); PG8_MMA(1, 1, At, B1); PG8_BAR; PG8_SCHED;
        }
        if constexpr (ALIGN_EPI) { if (wr == 0) PG8_BAR; }
        E(acc, cur, wr, wc, fr, fq);
        if (!has_next) break;
        if (!E.keep(cur)) {
#pragma unroll
            for (int a = 0; a < 2; ++a)
#pragma unroll
                for (int b = 0; b < 2; ++b)
#pragma unroll
                    for (int m = 0; m < 4; ++m)
#pragma unroll
                        for (int n = 0; n < 2; ++n) acc[a][b][m][n] = (f32x4){0.f, 0.f, 0.f, 0.f};
        }
        cur = nxt; cA = nA; cB = nB; ++ui;
        if constexpr (ALIGN_EPI) { if (wr == 1) PG8_BAR; }
    }
    PG8_WAIT_V(0);
    if constexpr (!ALIGN_EPI) { if (wr == 0) PG8_BAR; }
    PG8_BAR;
#undef PG8_SA
#undef PG8_SB
#undef PG8_STAGE_A
#undef PG8_STAGE_B
#undef PG8_LDA
#undef PG8_LDB
#undef PG8_MMA
#undef PG8_WAIT_V
#undef PG8_WAIT_L
#undef PG8_BAR
#undef PG8_SCHED
}

struct DenseSched {
    static constexpr bool GATHER = false;
    const char* A; const char* Bt; int lda, ldb, nM, nN, G, c, nparts, K;
    __device__ __forceinline__ bool next(int i, Unit& u) const {
        const int ti = i / nparts; const long L = (long)ti * G + c; if (L >= (long)nM * nN) return false;
        tile_of((int)L, nM, nN, u.pm, u.pn); u.part = i - ti * nparts; u.e = 0; return true;
    }
    __device__ __forceinline__ const char* a_base(const Unit& u) const { return A + (size_t)u.part * K * 2; }
    __device__ __forceinline__ const char* b_base(const Unit& u) const { return Bt + ((size_t)u.pn * BM * ldb + (size_t)u.part * K) * 2; }
    __device__ __forceinline__ unsigned a_raw(const Unit& u, int h, int R) const { return (unsigned)(u.pm * BM + h * HALF + R); }
    __device__ __forceinline__ unsigned a_conv(unsigned raw, int C) const { return (raw * (unsigned)lda + (unsigned)C) * 2u; }
};
struct MoeUnits { int e[3], pos0[3], n[3]; };
template <bool GATHER_>
struct MoeSched {
    static constexpr bool GATHER = GATHER_;
    const char* A; const char* Bt; const int* list_tok; int lda, ldb, G, c, nunits; MoeUnits mu; size_t bstride; int ibase, icount;
    __device__ __forceinline__ bool next(int i_, Unit& u) const {
        const int i = i_ + ibase; const int L = i * G + c; if (i_ >= icount || i > 2 || L >= nunits) return false;
        u.pm = L >> 2; u.pn = L & 3; u.part = 0;
        u.e = (i == 0) ? mu.e[0] : (i == 1 ? mu.e[1] : mu.e[2]); u.pos0 = (i == 0) ? mu.pos0[0] : (i == 1 ? mu.pos0[1] : mu.pos0[2]); u.n = (i == 0) ? mu.n[0] : (i == 1 ? mu.n[1] : mu.n[2]);
        return true;
    }
    __device__ __forceinline__ const char* a_base(const Unit&) const { return A; }
    __device__ __forceinline__ const char* b_base(const Unit& u) const { return Bt + (size_t)u.e * bstride + (size_t)u.pn * BM * ldb * 2; }
    __device__ __forceinline__ unsigned a_raw(const Unit& u, int h, int R) const {
        if (GATHER_) { int pos = u.pos0 + h * HALF + R; pos = pos < u.n ? pos : u.n - 1;
            unsigned v; const int* p = list_tok + u.e * CAP + pos; asm volatile("global_load_dword %0, %1, off" : "=v"(v) : "v"(p) : "memory"); return v; }
        return (unsigned)(u.pm * BM + h * HALF + R);
    }
    __device__ __forceinline__ unsigned a_conv(unsigned raw, int C) const {
        if (GATHER_) { unsigned o; const unsigned c2 = (unsigned)C * 2u; asm volatile("v_mad_u32_u24 %0, %1, %2, %3" : "=v"(o) : "v"(raw), "v"((unsigned)lda * 2u), "v"(c2)); return o; }
        return (raw * (unsigned)lda + (unsigned)C) * 2u;
    }
};
}

struct EpiProj {
    static constexpr bool PERM = true;
    bf16* QK; bf16* VA; bf16* QB; bf16* KB; bf16* VB; bf16* GATES;
    const float *aq, *ak, *bq, *bk;
    __device__ __forceinline__ bool keep(const pg8::Unit&) const { return false; }
    __device__ __forceinline__ void operator()(f32x4 (&acc)[2][2][4][2], const pg8::Unit& u, int wr, int wc, int fr, int fq) const {
        const int pn = u.pn; int mode, ld, colbase; bf16* dst; const float* gain = nullptr; float scale = 1.f;
        if (pn < 4) { mode = 1; dst = QK + (size_t)pn * T * 256; ld = 256; colbase = 0; gain = pn < 2 ? aq : ak; scale = pn < 2 ? C2 : 1.f; }
        else if (pn < 6) { mode = 0; dst = VA; ld = 512; colbase = (pn - 4) * 256; }
        else if (pn < 8) { mode = 1; dst = QB; ld = 512; colbase = (pn - 6) * 256; gain = bq; scale = C2; }
        else if (pn < 10) { mode = 1; dst = KB; ld = 512; colbase = (pn - 8) * 256; gain = bk; }
        else if (pn < 12) { mode = 0; dst = VB; ld = 512; colbase = (pn - 10) * 256; }
        else { mode = 2; dst = GATES; ld = 2048; colbase = (pn - 12) * 256; }
        const int row0 = u.pm * 256 + wr * 64 + fr;
        float g[2][8];
        if (mode == 1) {
#pragma unroll
            for (int bj = 0; bj < 2; ++bj) { const f32x4 a = *(const f32x4*)(gain + 32 * bj + 8 * fq), b = *(const f32x4*)(gain + 32 * bj + 8 * fq + 4);
                g[bj][0] = a[0] * scale; g[bj][1] = a[1] * scale; g[bj][2] = a[2] * scale; g[bj][3] = a[3] * scale; g[bj][4] = b[0] * scale; g[bj][5] = b[1] * scale; g[bj][6] = b[2] * scale; g[bj][7] = b[3] * scale; }
        }
#pragma unroll
        for (int ai = 0; ai < 2; ++ai)
#pragma unroll
            for (int m = 0; m < 4; ++m) {
                float v[2][8];
#pragma unroll
                for (int bj = 0; bj < 2; ++bj)
#pragma unroll
                    for (int n = 0; n < 2; ++n)
#pragma unroll
                        for (int j = 0; j < 4; ++j) v[bj][4 * n + j] = acc[ai][bj][m][n][j];
                if (mode == 1) {
                    float ss = 0.f;
#pragma unroll
                    for (int bj = 0; bj < 2; ++bj)
#pragma unroll
                        for (int j = 0; j < 8; ++j) ss += v[bj][j] * v[bj][j];
                    ss += __shfl_xor(ss, 16); ss += __shfl_xor(ss, 32);
                    const float rs = __builtin_amdgcn_rsqf(ss * (1.f / 64.f) + EPS);
#pragma unroll
                    for (int bj = 0; bj < 2; ++bj)
#pragma unroll
                        for (int j = 0; j < 8; ++j) v[bj][j] = v[bj][j] * rs * g[bj][j];
                } else if (mode == 2) {
#pragma unroll
                    for (int bj = 0; bj < 2; ++bj)
#pragma unroll
                        for (int j = 0; j < 8; ++j) v[bj][j] = __builtin_amdgcn_rcpf(1.f + __builtin_amdgcn_exp2f(-LOG2E * v[bj][j]));
                }
                const int row = row0 + ai * 128 + m * 16;
                unsigned eo, es;
                { const unsigned bq = (unsigned)row >> 13, tile = ((unsigned)row & 8191u) >> 6, key = (unsigned)row & 63u;
                  if (pn == 2 || pn == 3) { eo = ((((bq * 4 + wc) * 128 + tile) * 8 + fq) * 64 + key) * 8; es = 4 * 64 * 8; }
                  else if (pn == 4 || pn == 5) { const unsigned head = (pn - 4) * 2 + (wc >> 1); eo = ((((bq * 4 + head) * 128 + tile) * 4 + 2 * (wc & 1)) * 64 + key) * 32 + 8 * fq; es = 64 * 32; }
                  else if (pn == 8 || pn == 9) { const unsigned head = (pn - 8) * 4 + wc; eo = ((((bq * 8 + head) * 128 + tile) * 8 + fq) * 64 + key) * 8; es = 4 * 64 * 8; }
                  else if (pn == 10 || pn == 11) { const unsigned head = (pn - 10) * 4 + wc; eo = ((((bq * 8 + head) * 128 + tile) * 2) * 64 + key) * 32 + 8 * fq; es = 64 * 32; }
                  else if (pn >= 12) { eo = ((((((unsigned)u.pm * 8 + (pn - 12)) * 2 + ai) * 4 + m) * 2) * 8 + (wr * 4 + wc)) * 512 + (fq * 16 + fr) * 8; es = 8 * 512; }
                  else { eo = (unsigned)row * (unsigned)ld + colbase + 64 * wc + 8 * fq; es = 32; } }
#pragma unroll
                for (int bj = 0; bj < 2; ++bj) { u32x4 w; w.x = cvt_pk_bf16(v[bj][0], v[bj][1]); w.y = cvt_pk_bf16(v[bj][2], v[bj][3]); w.z = cvt_pk_bf16(v[bj][4], v[bj][5]); w.w = cvt_pk_bf16(v[bj][6], v[bj][7]);
                    *(u32x4*)(dst + eo + bj * es) = w; }
            }
    }
};
struct EpiAB {
    static constexpr bool PERM = true;
    const bf16* __restrict__ GATES; bf16* __restrict__ MIXED; unsigned* ctr;
    __device__ __forceinline__ bool keep(const pg8::Unit& u) const { return u.part == 0; }
    __device__ __forceinline__ void operator()(f32x4 (&acc)[2][2][4][2], const pg8::Unit& u, int wr, int wc, int fr, int fq) const {
        const int row0 = u.pm * 256 + wr * 64 + fr, col0 = u.pn * 256 + wc * 32 + 8 * fq;
        const unsigned lo = (unsigned)((wr * 4 + wc) * 512 + (fq * 16 + fr) * 8);
        const GAS u32x4* gp = (const GAS u32x4*)(GATES + ((size_t)((u.pm * 8 + u.pn) * 2) * 4 * 2 * 8) * 512 + lo);
        constexpr int GSTR = 8 * 512 * 2 / 16, GB = 4 * 2 * 4 * 2 * GSTR;
        if (u.part == 0) {
#pragma unroll
            for (int g = 0; g < 8; g += 2) {
                u32x4 sa[2][2], sb[2][2];
#pragma unroll
                for (int gg = 0; gg < 2; ++gg)
#pragma unroll
                    for (int bj = 0; bj < 2; ++bj) { sa[gg][bj] = gp[((g + gg) * 2 + bj) * GSTR]; sb[gg][bj] = gp[((g + gg) * 2 + bj) * GSTR + GB]; }
#pragma unroll
                for (int gg = 0; gg < 2; ++gg)
#pragma unroll
                    for (int bj = 0; bj < 2; ++bj)
#pragma unroll
                        for (int q = 0; q < 4; ++q) { const int ai = (g + gg) >> 2, m = (g + gg) & 3, n = q >> 1, j = (q & 1) * 2;
                            const float sa0 = __uint_as_float(sa[gg][bj][q] << 16), sa1 = __uint_as_float(sa[gg][bj][q] & 0xffff0000u), sb0 = __uint_as_float(sb[gg][bj][q] << 16), sb1 = __uint_as_float(sb[gg][bj][q] & 0xffff0000u);
                            acc[ai][bj][m][n][j] *= sa0 * __builtin_amdgcn_rcpf(sb0); acc[ai][bj][m][n][j + 1] *= sa1 * __builtin_amdgcn_rcpf(sb1); }
            }
        } else {
            const __amdgpu_buffer_rsrc_t mrs = __builtin_amdgcn_make_buffer_rsrc(MIXED, 0, T * D * 2, 0x00020000);
#pragma unroll
            for (int g = 0; g < 8; g += 4) {
                u32x4 sb[4][2];
#pragma unroll
                for (int gg = 0; gg < 4; ++gg)
#pragma unroll
                    for (int bj = 0; bj < 2; ++bj) sb[gg][bj] = gp[((g + gg) * 2 + bj) * GSTR + GB];
#pragma unroll
                for (int gg = 0; gg < 4; ++gg) { const int ai = (g + gg) >> 2, m = (g + gg) & 3; bf16* rp = MIXED + (size_t)(row0 + ai * 128 + m * 16) * 1024 + col0;
#pragma unroll
                    for (int bj = 0; bj < 2; ++bj) { u32x4 w;
#pragma unroll
                        for (int q = 0; q < 4; ++q) { const int n = q >> 1, j = (q & 1) * 2;
                            w[q] = cvt_pk_bf16(acc[ai][bj][m][n][j] * __uint_as_float(sb[gg][bj][q] << 16), acc[ai][bj][m][n][j + 1] * __uint_as_float(sb[gg][bj][q] & 0xffff0000u)); }
                        __builtin_amdgcn_raw_buffer_store_b128(w, mrs, (unsigned)((size_t)(rp + bj * 128 - MIXED) * 2), 0, 16); } }
            }
            asm volatile("s_waitcnt vmcnt(0)" ::: "memory");
            if ((threadIdx.x & 63) == 0) __hip_atomic_fetch_add(ctr + 64 * u.pm, 1u, __ATOMIC_RELAXED, __HIP_MEMORY_SCOPE_AGENT);
        }
    }
};
struct EpiAO {
    static constexpr bool PERM = true;
    bf16* AO; unsigned* ctr;
    __device__ __forceinline__ bool keep(const pg8::Unit&) const { return false; }
    __device__ __forceinline__ void operator()(f32x4 (&acc)[2][2][4][2], const pg8::Unit& u, int wr, int wc, int fr, int fq) const {
        const int row0 = u.pm * 256 + wr * 64 + fr, col0 = u.pn * 256 + wc * 32 + 8 * fq;
        const __amdgpu_buffer_rsrc_t ars = __builtin_amdgcn_make_buffer_rsrc(AO, 0, T * D * 2, 0x00020000);
#pragma unroll
        for (int ai = 0; ai < 2; ++ai)
#pragma unroll
            for (int m = 0; m < 4; ++m) { const unsigned ro = (unsigned)((row0 + ai * 128 + m * 16) * D + col0) * 2u;
#pragma unroll
                for (int bj = 0; bj < 2; ++bj) { u32x4 o; o.x = cvt_pk_bf16(acc[ai][bj][m][0][0], acc[ai][bj][m][0][1]); o.y = cvt_pk_bf16(acc[ai][bj][m][0][2], acc[ai][bj][m][0][3]);
                    o.z = cvt_pk_bf16(acc[ai][bj][m][1][0], acc[ai][bj][m][1][1]); o.w = cvt_pk_bf16(acc[ai][bj][m][1][2], acc[ai][bj][m][1][3]);
                    __builtin_amdgcn_raw_buffer_store_b128(o, ars, ro + bj * 256, 0, 16); } }
        asm volatile("s_waitcnt vmcnt(0)" ::: "memory");
        if ((threadIdx.x & 63) == 0) __hip_atomic_fetch_add(ctr + 64 * u.pm, 1u, __ATOMIC_RELAXED, __HIP_MEMORY_SCOPE_AGENT);
    }
};
struct EpiGU {
    static constexpr bool PERM = true;
    bf16* H; const float* list_r; unsigned* tilectr;
    __device__ __forceinline__ bool keep(const pg8::Unit&) const { return false; }
    __device__ __forceinline__ void operator()(f32x4 (&acc)[2][2][4][2], const pg8::Unit& u, int wr, int wc, int fr, int fq) const {
        const int r0 = wr * 64 + fr, col0 = u.pn * 128 + wc * 32 + 8 * fq;
        const __amdgpu_buffer_rsrc_t hrs = __builtin_amdgcn_make_buffer_rsrc(H, 0, MAXSLOT * DEXP * 2, 0x00020000);
        float rsv[8];
#pragma unroll
        for (int g = 0; g < 8; ++g) { const int r = r0 + (g >> 2) * 128 + (g & 3) * 16; int pos = u.pos0 + r; pos = pos < u.n ? pos : u.n - 1; rsv[g] = list_r[u.e * CAP + pos]; }
#pragma unroll
        for (int ai = 0; ai < 2; ++ai)
#pragma unroll
            for (int m = 0; m < 4; ++m) {
                const int r = r0 + ai * 128 + m * 16; const float rs = rsv[ai * 4 + m];
                float h[8];
#pragma unroll
                for (int n = 0; n < 2; ++n)
#pragma unroll
                    for (int j = 0; j < 4; ++j) { const float gt = acc[ai][0][m][n][j] * rs, up = acc[ai][1][m][n][j] * rs;
                        h[4 * n + j] = gt * __builtin_amdgcn_rcpf(1.f + __builtin_amdgcn_exp2f(-LOG2E * gt)) * up; }
                u32x4 w; w.x = cvt_pk_bf16(h[0], h[1]); w.y = cvt_pk_bf16(h[2], h[3]); w.z = cvt_pk_bf16(h[4], h[5]); w.w = cvt_pk_bf16(h[6], h[7]);
                __builtin_amdgcn_raw_buffer_store_b128(w, hrs, (unsigned)(((u.pm * 256 + r) * DEXP + col0) * 2), 0, 16);
            }
        asm volatile("s_waitcnt vmcnt(0)" ::: "memory");
        if ((threadIdx.x & 63) == 0) __hip_atomic_fetch_add(tilectr + 64 * u.pm, 1u, __ATOMIC_RELAXED, __HIP_MEMORY_SCOPE_AGENT);
    }
};
struct EpiDown {
    static constexpr bool PERM = true;
    bf16* Y; const float* list_w;
    __device__ __forceinline__ bool keep(const pg8::Unit&) const { return false; }
    __device__ __forceinline__ void operator()(f32x4 (&acc)[2][2][4][2], const pg8::Unit& u, int wr, int wc, int fr, int fq) const {
        const int r0 = wr * 64 + fr, col0 = u.pn * 256 + wc * 32 + 8 * fq;
        float wv[8];
#pragma unroll
        for (int g = 0; g < 8; ++g) { const int r = r0 + (g >> 2) * 128 + (g & 3) * 16; int pos = u.pos0 + r; pos = pos < u.n ? pos : u.n - 1; wv[g] = list_w[u.e * CAP + pos]; }
#pragma unroll
        for (int ai = 0; ai < 2; ++ai)
#pragma unroll
            for (int m = 0; m < 4; ++m) { const int r = r0 + ai * 128 + m * 16; const float w = wv[ai * 4 + m]; const int row = u.pm * 256 + r;
#pragma unroll
                for (int bj = 0; bj < 2; ++bj) { u32x4 o; o.x = cvt_pk_bf16(acc[ai][bj][m][0][0] * w, acc[ai][bj][m][0][1] * w); o.y = cvt_pk_bf16(acc[ai][bj][m][0][2] * w, acc[ai][bj][m][0][3] * w);
                    o.z = cvt_pk_bf16(acc[ai][bj][m][1][0] * w, acc[ai][bj][m][1][1] * w); o.w = cvt_pk_bf16(acc[ai][bj][m][1][2] * w, acc[ai][bj][m][1][3] * w);
                    *(u32x4*)(Y + (size_t)row * D + col0 + bj * 128) = o; } }
    }
};

namespace att {
__device__ __forceinline__ int crow(int r, int hi) { return (r & 3) + 8 * (r >> 2) + 4 * hi; }
__device__ __forceinline__ void glds16(const void* sbase_, unsigned voff, unsigned lds_dst) { unsigned keep;
    const unsigned long long a_ = (unsigned long long)(uintptr_t)sbase_;
    const unsigned long long sbase = ((unsigned long long)(unsigned)__builtin_amdgcn_readfirstlane((int)(a_ >> 32)) << 32) | (unsigned)__builtin_amdgcn_readfirstlane((int)a_);
    asm volatile("s_mov_b32 %0, m0\n\ts_mov_b32 m0, %3\n\ts_nop 0\n\tglobal_load_lds_dwordx4 %1, %2\n\ts_mov_b32 m0, %0" : "=&s"(keep) : "v"(voff), "s"(sbase), "s"(lds_dst) : "memory"); }
__device__ __forceinline__ void glds16p(const void* gsrc, unsigned lds_dst) { unsigned keep;
    asm volatile("s_mov_b32 %0, m0\n\ts_mov_b32 m0, %2\n\ts_nop 0\n\tglobal_load_lds_dwordx4 %1, off\n\ts_mov_b32 m0, %0" : "=&s"(keep) : "v"(gsrc), "s"(lds_dst) : "memory"); }
typedef LAS const char* lds_cptr;
typedef short v4i16_t __attribute__((ext_vector_type(4)));
typedef float f32x2_t __attribute__((ext_vector_type(2))); typedef __bf16 bf16x2_t __attribute__((ext_vector_type(2)));
__device__ __forceinline__ s16x4 vtr(lds_cptr p) { return __builtin_bit_cast(s16x4, __builtin_amdgcn_ds_read_tr16_b64_v4i16((LAS v4i16_t*)p)); }
__device__ __forceinline__ unsigned cvtpk(float lo, float hi) { f32x2_t v = {lo, hi}; bf16x2_t b = __builtin_convertvector(v, bf16x2_t); return __builtin_bit_cast(unsigned, b); }
#define ATT_WAIT_BAR(N) asm volatile("s_waitcnt vmcnt(" #N ") lgkmcnt(0)\n\ts_barrier" ::: "memory")
#define ATT_SB() __builtin_amdgcn_sched_barrier(0)
#define ATT_PIN(x) asm volatile("" : "+v"(x))
#define ATT_MFMA(a, b, c) __builtin_amdgcn_mfma_f32_32x32x16_bf16(a, b, c, 0, 0, 0)

constexpr int LDS_K = 0, LDS_V = 49152, LDS_TBL = 98304, LDS_WS = 99328, LDS_X = 0;

template <int NS, int DV, int QP, int VP> struct attn_dummy {};
template <int NS, int DV, int QP, int VP>
__device__ __forceinline__ void attn_unit_simple(const bf16* Q0, const bf16* Q1p, const bf16* K0, const bf16* K1p, const bf16* V, long rowbase, int q0,
                                          const float* tblg, const float* gsub, float lam, bf16* OUT  , char* shm) {
    constexpr int KSLOT = NS * 8192, VSLOT = DV * 128, ND = DV / 32, NVP = DV / 64;
    const int tid = threadIdx.x, lane = tid & 63, r32 = lane & 31, hi = lane >> 5; const int wid = __builtin_amdgcn_readfirstlane(tid >> 6);
    const int s = (NS == 2) ? (wid >> 2) : 0, j = (NS == 2) ? (wid & 3) : wid;
    const int ROWS = (NS == 2) ? 128 : 256;
    const int cw = (q0 + 32 * j) >> 6, qi = ((32 * j) & 63) + r32;
    const int t1 = (q0 + ROWS - 1) >> 6;
    int t0 = 0, lo_w = 0;
    if (NS == 1) { t0 = (q0 >> 6) - 8; if (t0 < 0) t0 = 0; lo_w = cw - 8; if (lo_w < 0) lo_w = 0; }
    const unsigned lds0 = (unsigned)(uintptr_t)shm;
    LAS float* tb = (LAS float*)((LAS char*)shm + LDS_TBL);
    LAS float* wsf = (LAS float*)((LAS char*)shm + LDS_WS) + wid * 64;
    if (tid < 256) tb[tid] = tblg[tid];
    const bf16* Qs = (s == 0) ? Q0 : Q1p;
    const bf16* Qw = Qs + (rowbase + q0 + 32 * j) * QP;
    const char* ksrc0 = (const char*)K0 + wid * 1024 + lane * 16;
    const char* ksrc1 = (NS == 2) ? (const char*)K1p + wid * 1024 + lane * 16 : nullptr;
    const char* vsrc = (const char*)V + lane * 16;
    const unsigned kdst = lds0 + LDS_K + wid * 1024, vdst = lds0 + LDS_V;
    bf16x8 qr[4];
#pragma unroll
    for (int d0 = 0; d0 < 4; ++d0) qr[d0] = *reinterpret_cast<const bf16x8*>(&Qw[(long)r32 * QP + d0 * 16 + hi * 8]);
#define ATT_DMA(t, sl) do { \
        glds16p(ksrc0 + (long)(t) * 8192, (unsigned)__builtin_amdgcn_readfirstlane(kdst + (sl) * KSLOT)); \
        if (NS == 2) glds16p(ksrc1 + (long)(t) * 8192, (unsigned)__builtin_amdgcn_readfirstlane(kdst + (sl) * KSLOT + 8192)); \
        _Pragma("unroll") for (int i_ = 0; i_ < NVP; ++i_) { const int p_ = wid + 8 * i_; \
            glds16p(vsrc + (long)(t) * (DV * 128) + p_ * 1024, (unsigned)__builtin_amdgcn_readfirstlane(vdst + (sl) * VSLOT + p_ * 1024)); } \
    } while (0)
    ATT_DMA(t0, 0);
    if (t0 + 1 <= t1) ATT_DMA(t0 + 1, 1);
    f32x16 o[ND];
#pragma unroll
    for (int d = 0; d < ND; ++d) o[d] = f32x16{};
    float l_reg = 0.f;
    LDS_WAIT();
    __builtin_amdgcn_s_barrier();
    asm volatile("" :: "v"(qr[0]), "v"(qr[1]), "v"(qr[2]), "v"(qr[3]));
    const float cfar = tb[255];
    f32x16 cinit;
#pragma unroll
    for (int r = 0; r < 16; ++r) cinit[r] = cfar;
    const lds_cptr shm3 = (lds_cptr)shm;
    const lds_cptr kp0 = shm3 + LDS_K + s * 8192 + hi * 1024 + r32 * 16;
    const lds_cptr vp0 = shm3 + LDS_V + ((lane >> 4) & 1) * 32 + (lane & 3) * 8 + (4 * hi + ((lane & 15) >> 2)) * 64;
    int sl = 0;
    for (int t = t0; t <= t1; ++t) {
        if (t < t1) { if (NS == 2) ATT_WAIT_BAR(4); else ATT_WAIT_BAR(2); } else ATT_WAIT_BAR(0);
        if (t + 2 <= t1) { const int s2 = (sl == 0) ? 2 : sl - 1; ATT_DMA(t + 2, s2); }
        if (t >= lo_w && t <= cw) {
            const lds_cptr kp = kp0 + sl * KSLOT; const lds_cptr vp = vp0 + sl * VSLOT;
            f32x16 p0, p1;
#pragma unroll
            for (int d0 = 0; d0 < 4; ++d0) {
                const bf16x8 b0 = *(const LAS bf16x8*)(kp + d0 * 2048), b1 = *(const LAS bf16x8*)(kp + d0 * 2048 + 512);
                if (d0 == 0) { p0 = __builtin_amdgcn_mfma_f32_32x32x16_bf16(b0, qr[0], cinit, 0, 0, 0); p1 = __builtin_amdgcn_mfma_f32_32x32x16_bf16(b1, qr[0], cinit, 0, 0, 0); }
                else { p0 = __builtin_amdgcn_mfma_f32_32x32x16_bf16(b0, qr[d0], p0, 0, 0, 0); p1 = __builtin_amdgcn_mfma_f32_32x32x16_bf16(b1, qr[d0], p1, 0, 0, 0); }
            }
            if (t >= cw - 2) {
                const LAS float* tp = tb + (64 * (t - cw) + 191 - qi + 4 * hi);
#pragma unroll
                for (int r = 0; r < 16; ++r) { p0[r] += tp[(r & 3) + 8 * (r >> 2)]; p1[r] += tp[32 + (r & 3) + 8 * (r >> 2)]; }
            }
            float sacc = 0.f;
#pragma unroll
            for (int r = 0; r < 16; ++r) { p0[r] = __builtin_amdgcn_exp2f(p0[r]); p1[r] = __builtin_amdgcn_exp2f(p1[r]); sacc += p0[r] + p1[r]; }
            l_reg += sacc;
            u32x4 pw[4];
#pragma unroll
            for (int q = 0; q < 4; ++q) { pw[0][q] = cvtpk(p0[2 * q], p0[2 * q + 1]); pw[1][q] = cvtpk(p0[8 + 2 * q], p0[9 + 2 * q]);
                pw[2][q] = cvtpk(p1[2 * q], p1[2 * q + 1]); pw[3][q] = cvtpk(p1[8 + 2 * q], p1[9 + 2 * q]); }
#pragma unroll
            for (int d0 = 0; d0 < ND; ++d0)
#pragma unroll
                for (int ks = 0; ks < 4; ++ks) {
                    const s16x4 vlo = vtr(vp + d0 * 4096 + ks * 1024), vhi = vtr(vp + d0 * 4096 + ks * 1024 + 512);
                    const bf16x8 vf = (bf16x8){vlo[0], vlo[1], vlo[2], vlo[3], vhi[0], vhi[1], vhi[2], vhi[3]};
                    o[d0] = __builtin_amdgcn_mfma_f32_32x32x16_bf16(__builtin_bit_cast(bf16x8, pw[ks]), vf, o[d0], 0, 0, 0);
                }
        }
        sl = (sl == 2) ? 0 : sl + 1;
    }
#undef ATT_DMA
    { auto rr = __builtin_amdgcn_permlane32_swap(__float_as_uint(l_reg), __float_as_uint(l_reg), false, false); l_reg = __uint_as_float(rr[0]) + __uint_as_float(rr[1]); }
    if (hi == 0) wsf[r32] = l_reg;
    LDS_WAIT();
    float rli[16];
#pragma unroll
    for (int r = 0; r < 16; ++r) rli[r] = __builtin_amdgcn_rcpf(wsf[crow(r, hi)]);
    const long orow0 = rowbase + q0 + 32 * j;
    if (NS == 2) {
        LAS float* X = (LAS float*)((LAS char*)shm + LDS_X);
        asm volatile("s_waitcnt lgkmcnt(0)\n\ts_barrier" ::: "memory");
        if (s == 1) {
#pragma unroll
            for (int d0 = 0; d0 < ND; ++d0)
#pragma unroll
                for (int r = 0; r < 16; ++r) X[((j * ND + d0) * 16 + r) * 64 + lane] = lam * o[d0][r] * rli[r];
        }
        asm volatile("s_waitcnt lgkmcnt(0)\n\ts_barrier" ::: "memory");
        if (s == 0) {
            float gs[ND];
#pragma unroll
            for (int d0 = 0; d0 < ND; ++d0) gs[d0] = gsub[32 * d0 + r32] * 0.8f;
#pragma unroll
            for (int r = 0; r < 16; ++r) {
                float ss = 0.f;
#pragma unroll
                for (int d0 = 0; d0 < ND; ++d0) { o[d0][r] = o[d0][r] * rli[r] - X[((j * ND + d0) * 16 + r) * 64 + lane]; ss += o[d0][r] * o[d0][r]; }
#pragma unroll
                for (int m = 1; m < 32; m <<= 1) ss += __shfl_xor(ss, m);
                const float rs = __builtin_amdgcn_rsqf(ss * (1.f / DV) + EPS);
                bf16* op = OUT + (orow0 + crow(r, hi)) * 1024 + r32;
#pragma unroll
                for (int d0 = 0; d0 < ND; ++d0) op[32 * d0] = (bf16)(cvtpk(o[d0][r] * rs * gs[d0], 0.f) & 0xffffu);
            }
        }
    } else {
#pragma unroll
        for (int r = 0; r < 16; ++r) {
            bf16* op = OUT + (orow0 + crow(r, hi)) * 1024 + r32;
#pragma unroll
            for (int d0 = 0; d0 < ND; ++d0) op[32 * d0] = (bf16)(cvtpk(o[d0][r] * rli[r], 0.f) & 0xffffu);
        }
    }
    asm volatile("s_waitcnt vmcnt(0) lgkmcnt(0)\n\ts_barrier" ::: "memory");
}


constexpr int LDS_CONV = 101376, CONV_PITCH = 1040, CONV_BUF = 8 * CONV_PITCH, CONV_N = 96;
struct ConvState { int jd, jc, bd, bc, sgu, sd, dgu, dd; unsigned long long wg, d1, d2, WGUT, WDT; };
__device__ __forceinline__ void conv_init(ConvState& cv, int c, int wid, const float* wg, const float* wu, const float* wd, bf16* WGUT, bf16* WDT) {
    cv.jd = 0; cv.jc = 0; cv.bd = 0; cv.bc = 0; cv.wg = (unsigned long long)(uintptr_t)wg; cv.d1 = (unsigned long long)(uintptr_t)wu - cv.wg; cv.d2 = (unsigned long long)(uintptr_t)wd - (unsigned long long)(uintptr_t)wu;
    cv.WGUT = (unsigned long long)(uintptr_t)WGUT; cv.WDT = (unsigned long long)(uintptr_t)WDT;
    cv.sgu = (64 * (c >> 4) + 8 * wid) * 512 + 32 * (c & 15); cv.sd = (64 * (c >> 5) + 8 * wid) * 1024 + 32 * (c & 31);
    { const int n0 = 32 * (c & 15); cv.dgu = ((n0 >> 7) * 256 + (n0 & 127)) * 1024 + 64 * (c >> 4); } cv.dd = (32 * (c & 31)) * 512 + 64 * (c >> 5);
}
__device__ __forceinline__ void conv_dma(ConvState& cv, int wid, int lane, unsigned lds0) {
    const int j = cv.jd; const bool gu = j < 64;
    unsigned long long a = cv.wg + ((unsigned long long)(j & 31) * 524288ull + (unsigned long long)(gu ? cv.sgu : cv.sd)) * 4ull;
    a += (j >= 32) ? cv.d1 : 0ull; a += (j >= 64) ? cv.d2 : 0ull;
    glds16((const void*)(uintptr_t)a, (unsigned)((lane >> 3) * (gu ? 2048 : 4096) + (lane & 7) * 16), (unsigned)__builtin_amdgcn_readfirstlane(lds0 + LDS_CONV + cv.bd + wid * CONV_PITCH));
    cv.jd = j + 1; cv.bd = (cv.bd == 2 * CONV_BUF) ? 0 : cv.bd + CONV_BUF;
}
__device__ __forceinline__ void conv_convert(ConvState& cv, bool mine, int wsel, int lane, char* shm) {
    const int j = cv.jc;
    if (mine) {
        const bool gu = j < 64;
        const int nl = 8 * wsel + (lane >> 3), kc = lane & 7;
        const LAS char* p = (const LAS char*)shm + LDS_CONV + cv.bc + kc * CONV_PITCH + (nl >> 2) * 16 + (nl & 3) * 4;
        float f[8];
#pragma unroll
        for (int i = 0; i < 8; ++i) f[i] = *(const LAS float*)(p + 128 * i);
        u32x4 o; o.x = cvtpk(f[0], f[1]); o.y = cvtpk(f[2], f[3]); o.z = cvtpk(f[4], f[5]); o.w = cvtpk(f[6], f[7]);
        const unsigned long long eoff = gu ? ((unsigned long long)(j & 31) * 1048576ull + (unsigned long long)(j >> 5) * 131072ull + (unsigned long long)cv.dgu) : ((unsigned long long)(j & 31) * 524288ull + (unsigned long long)cv.dd);
        const unsigned long long pa = (gu ? cv.WGUT : cv.WDT) + eoff * 2ull;
        *(GAS u32x4*)(uintptr_t)(pa + (unsigned long long)(nl * (gu ? 2048 : 1024) + kc * 16)) = o;
    }
    cv.jc = j + 1; cv.bc = (cv.bc == 2 * CONV_BUF) ? 0 : cv.bc + CONV_BUF;
}
template <int NS, int DV, int QP, int VP>
__device__ __forceinline__ void attn_unit_pipe(const bf16* Q0, const bf16* Q1p, const bf16* K0, const bf16* K1p, const bf16* V, long rowbase, int q0,
                                          const float* tblg, const float* gsub, float lam, bf16* OUT  , char* shm, ConvState& cv) {
    constexpr int KSLOT = NS * 8192, VSLOT = DV * 128, ND = DV / 32, NVP = DV / 64, NG = 4 * ND, EPG = 32 / NG, CPG = EPG / 2, LAG = NG / 4;
    const int tid = threadIdx.x, lane = tid & 63, r32 = lane & 31, hi = lane >> 5; const int wid = __builtin_amdgcn_readfirstlane(tid >> 6);
    const int s = (NS == 2) ? (wid >> 2) : 0, j = (NS == 2) ? (wid & 3) : wid;
    const int ROWS = (NS == 2) ? 128 : 256;
    const int cw = (q0 + 32 * j) >> 6, qi = ((32 * j) & 63) + r32;
    const int t1 = (q0 + ROWS - 1) >> 6;
    int t0 = 0, lo_w = 0;
    if (NS == 1) { t0 = (q0 >> 6) - 8; if (t0 < 0) t0 = 0; lo_w = cw - 8; if (lo_w < 0) lo_w = 0; }
    const unsigned lds0 = (unsigned)(uintptr_t)shm;
    LAS float* tb = (LAS float*)((LAS char*)shm + LDS_TBL);
    LAS float* wsf = (LAS float*)((LAS char*)shm + LDS_WS) + wid * 64;
    if (tid < 256) tb[tid] = tblg[tid];
    const bf16* Qs = (s == 0) ? Q0 : Q1p;
    const bf16* Qw = Qs + (rowbase + q0 + 32 * j) * QP;
    const unsigned koff = (unsigned)(wid * 1024 + lane * 16);
    unsigned voffv[NVP];
#pragma unroll
    for (int i_ = 0; i_ < NVP; ++i_) voffv[i_] = (unsigned)((wid + 8 * i_) * 1024 + lane * 16);
    const char* kb0 = (const char*)K0; const char* kb1 = (const char*)K1p; const char* vb = (const char*)V;
    const unsigned kdst = lds0 + LDS_K + wid * 1024, vdst = lds0 + LDS_V;
    bf16x8 qr[4];
#pragma unroll
    for (int d0 = 0; d0 < 4; ++d0) qr[d0] = *reinterpret_cast<const bf16x8*>(&Qw[(long)r32 * QP + d0 * 16 + hi * 8]);
#define ATT_DMA_K(t, sl) do { \
        glds16(kb0 + (long)(t) * 8192, koff, (unsigned)__builtin_amdgcn_readfirstlane(kdst + (sl) * KSLOT)); \
        if (NS == 2) glds16(kb1 + (long)(t) * 8192, koff, (unsigned)__builtin_amdgcn_readfirstlane(kdst + (sl) * KSLOT + 8192)); } while (0)
#define ATT_DMA_V(t, sl) do { \
        _Pragma("unroll") for (int i_ = 0; i_ < NVP; ++i_) { const int p_ = wid + 8 * i_; \
            glds16(vb + (long)(t) * (DV * 128), voffv[i_], (unsigned)__builtin_amdgcn_readfirstlane(vdst + (sl) * VSLOT + p_ * 1024)); } } while (0)
    ATT_DMA_K(t0, 0); ATT_DMA_V(t0, 0);
    if (t0 + 1 <= t1) ATT_DMA_K(t0 + 1, 1);
    if (t0 + 2 <= t1) ATT_DMA_K(t0 + 2, 2);
    f32x16 o[ND];
#pragma unroll
    for (int d = 0; d < ND; ++d) o[d] = f32x16{};
    float l_reg = 0.f;
    ATT_WAIT_BAR(0);
    asm volatile("" :: "v"(qr[0]), "v"(qr[1]), "v"(qr[2]), "v"(qr[3]));
    const lds_cptr shm3 = (lds_cptr)shm;
    const lds_cptr kp0 = shm3 + LDS_K + s * 8192 + hi * 1024 + r32 * 16;
    const lds_cptr vp0 = shm3 + LDS_V + ((lane >> 4) & 1) * 32 + (lane & 3) * 8 + (4 * hi + ((lane & 15) >> 2)) * 64;
    bf16x8 kf[8];
#define ATT_KRD(i, kp) do { kf[i] = *(const LAS bf16x8*)((kp) + ((i) >> 1) * 2048 + ((i) & 1) * 512); } while (0)
#pragma unroll
    for (int i = 0; i < 8; ++i) ATT_KRD(i, kp0);
    ATT_WAIT_BAR(0);
    f32x16 S0, S1;
    const f32x16 z16 = f32x16{};
    u32x4 pw[4];
#define ATT_VRD(g) do { vlo[g] = vtr(vp + ((g) % ND) * 4096 + ((g) / ND) * 1024); vhi[g] = vtr(vp + ((g) % ND) * 4096 + ((g) / ND) * 1024 + 512); } while (0)
#define ATT_VF(g) (bf16x8){vlo[g][0], vlo[g][1], vlo[g][2], vlo[g][3], vhi[g][0], vhi[g][1], vhi[g][2], vhi[g][3]}
#define ATT_NEAR(t) do { if ((t) >= cw - 2) { const LAS float* tp = tb + (64 * ((t) - cw) + 191 - qi + 4 * hi); \
            _Pragma("unroll") for (int r = 0; r < 16; ++r) { S0[r] += tp[(r & 3) + 8 * (r >> 2)]; S1[r] += tp[32 + (r & 3) + 8 * (r >> 2)]; } } } while (0)
#define ATT_ENDW(t) do { if ((t) + 3 <= t1) { ATT_WAIT_BAR(4); } else if ((t) + 1 <= t1) { ATT_WAIT_BAR(2); } else { ATT_WAIT_BAR(0); } } while (0)
    static_assert(NS == 2 && DV == 128, "pipelined unit: differential attention only");
    { const int tk_ = (t0 + 3 <= t1) ? t0 + 3 : t1, tv_ = (t0 + 1 <= t1) ? t0 + 1 : t1; ATT_DMA_K(tk_, 0); ATT_DMA_V(tv_, 1); }
    {
        S0 = ATT_MFMA(kf[0], qr[0], z16); S1 = ATT_MFMA(kf[1], qr[0], z16);
#pragma unroll
        for (int d0 = 1; d0 < 4; ++d0) { S0 = ATT_MFMA(kf[2 * d0], qr[d0], S0); S1 = ATT_MFMA(kf[2 * d0 + 1], qr[d0], S1); }
        ATT_NEAR(t0);
#pragma unroll
        for (int r = 0; r < 16; ++r) { S0[r] = __builtin_amdgcn_exp2f(S0[r]); S1[r] = __builtin_amdgcn_exp2f(S1[r]); l_reg += S0[r] + S1[r]; }
#pragma unroll
        for (int q = 0; q < 4; ++q) { pw[0][q] = cvtpk(S0[2 * q], S0[2 * q + 1]); pw[1][q] = cvtpk(S0[8 + 2 * q], S0[9 + 2 * q]); pw[2][q] = cvtpk(S1[2 * q], S1[2 * q + 1]); pw[3][q] = 0u; }
        const lds_cptr kpn = kp0 + 1 * KSLOT;
#pragma unroll
        for (int i = 0; i < 8; ++i) ATT_KRD(i, kpn);
    }
    ATT_WAIT_BAR(4);
    int sl = 1;
    for (int t = t0 + 1; t <= t1 + 1; ++t) {
        const int slp = (sl == 0) ? 2 : sl - 1, sln = (sl == 2) ? 0 : sl + 1;
        if (cv.jc < CONV_N && cv.jc + 2 <= cv.jd) conv_convert(cv, (wid >> 2) == (cv.jc & 1), wid & 3, lane, shm);
        { const int tk = (t + 3 <= t1) ? t + 3 : t1, tv = (t + 1 <= t1) ? t + 1 : t1; ATT_DMA_K(tk, sl); ATT_DMA_V(tv, sln); }
        const bool cd = cv.jd < CONV_N;
        if (cd) conv_dma(cv, wid, lane, lds0); else if (cv.jd < CONV_N + 2) cv.jd += 1;
        if (t - 1 <= cw) {
            const lds_cptr vp = vp0 + slp * VSLOT;
            const lds_cptr kpn = kp0 + sln * KSLOT;
            const float l_keep = l_reg;
            s16x4 vlo[NG], vhi[NG];
            ATT_SB();
            {   const f32x16 So = S1;
                S0 = ATT_MFMA(kf[0], qr[0], z16);
                pw[3][0] = cvtpk(So[8], So[9]); pw[3][1] = cvtpk(So[10], So[11]); pw[3][2] = cvtpk(So[12], So[13]); pw[3][3] = cvtpk(So[14], So[15]); ATT_PIN(pw[3]); ATT_SB(); }
            S1 = ATT_MFMA(kf[1], qr[0], z16); ATT_SB();
            S0 = ATT_MFMA(kf[2], qr[1], S0); ATT_SB();
            S1 = ATT_MFMA(kf[3], qr[1], S1); ATT_SB();
            S0 = ATT_MFMA(kf[4], qr[2], S0); ATT_SB();
            S1 = ATT_MFMA(kf[5], qr[2], S1); ATT_VRD(0); ATT_SB();
            S0 = ATT_MFMA(kf[6], qr[3], S0); ATT_VRD(1); ATT_SB();
            S1 = ATT_MFMA(kf[7], qr[3], S1); ATT_SB();
            if (t <= cw) ATT_NEAR(t);
            ATT_SB();
#pragma unroll
            for (int g = 0; g < NG; ++g) {
                o[g % ND] = ATT_MFMA(__builtin_bit_cast(bf16x8, pw[g / ND]), ATT_VF(g), o[g % ND]);
#pragma unroll
                for (int e = g * EPG; e < (g + 1) * EPG; ++e) { if (e < 16) { S0[e] = __builtin_amdgcn_exp2f(S0[e]); } else { S1[e - 16] = __builtin_amdgcn_exp2f(S1[e - 16]); } }
#pragma unroll
                for (int e = g * EPG; e < (g + 1) * EPG; ++e) { if (e < 16) l_reg += S0[e]; else l_reg += S1[e - 16]; }
                if (g >= LAG) {
#pragma unroll
                    for (int q = (g - LAG) * CPG; q < (g - LAG + 1) * CPG; ++q) { if (q < 8) pw[q >> 2][q & 3] = cvtpk(S0[2 * q], S0[2 * q + 1]); else pw[q >> 2][q & 3] = cvtpk(S1[2 * q - 16], S1[2 * q - 15]); }
                }
                if (g + 2 < NG) ATT_VRD(g + 2);
                if (g >= 2 && g < 10) ATT_KRD(g - 2, kpn);
                ATT_PIN(S0); ATT_PIN(S1); ATT_PIN(l_reg);
                if (g >= LAG) { ATT_PIN(pw[(((g - LAG) * CPG) >> 2)]); }
                ATT_SB();
            }
            if (t > cw) l_reg = l_keep;
        }
        if (cd) { ATT_WAIT_BAR(5); } else { ATT_WAIT_BAR(4); }
        sl = sln;
    }
#undef ATT_ENDW
    ATT_WAIT_BAR(0);
#undef ATT_DMA_K
#undef ATT_DMA_V
#undef ATT_VRD
#undef ATT_VF
#undef ATT_NEAR
#undef ATT_KRD
    { auto rr = __builtin_amdgcn_permlane32_swap(__float_as_uint(l_reg), __float_as_uint(l_reg), false, false); l_reg = __uint_as_float(rr[0]) + __uint_as_float(rr[1]); }
    if (hi == 0) wsf[r32] = l_reg;
    LDS_WAIT();
    float rli[16];
#pragma unroll
    for (int r = 0; r < 16; ++r) rli[r] = __builtin_amdgcn_rcpf(wsf[crow(r, hi)]);
    int lane_e = lane; asm volatile("" : "+v"(lane_e));
    const int r32e = lane_e & 31, hie = lane_e >> 5;
    bf16* obase = OUT + (rowbase + q0 + 32 * j + 4 * hie) * 1024 + r32e;
    if (NS == 2) {
        LAS float* X = (LAS float*)((LAS char*)shm + LDS_X);
        if (s == 1) {
#pragma unroll
            for (int d0 = 0; d0 < ND; ++d0)
#pragma unroll
                for (int r = 0; r < 16; ++r) X[((j * ND + d0) * 16 + r) * 64 + lane_e] = lam * o[d0][r] * rli[r];
        }
        asm volatile("s_waitcnt lgkmcnt(0)\n\ts_barrier" ::: "memory");
        if (s == 0) {
            float gs[ND];
#pragma unroll
            for (int d0 = 0; d0 < ND; ++d0) gs[d0] = gsub[32 * d0 + r32e] * 0.8f;
#pragma unroll
            for (int r = 0; r < 16; ++r) {
                float ss = 0.f;
#pragma unroll
                for (int d0 = 0; d0 < ND; ++d0) { o[d0][r] = o[d0][r] * rli[r] - X[((j * ND + d0) * 16 + r) * 64 + lane_e]; ss += o[d0][r] * o[d0][r]; }
#pragma unroll
                for (int m = 1; m < 32; m <<= 1) ss += __shfl_xor(ss, m);
                const float rs = __builtin_amdgcn_rsqf(ss * (1.f / DV) + EPS);
                bf16* op = obase + ((r & 3) + 8 * (r >> 2)) * 1024;
#pragma unroll
                for (int d0 = 0; d0 < ND; ++d0) op[32 * d0] = (bf16)(cvtpk(o[d0][r] * rs * gs[d0], 0.f) & 0xffffu);
            }
        }
    } else {
#pragma unroll
        for (int r = 0; r < 16; ++r) {
            bf16* op = obase + ((r & 3) + 8 * (r >> 2)) * 1024;
#pragma unroll
            for (int d0 = 0; d0 < ND; ++d0) op[32 * d0] = (bf16)(cvtpk(o[d0][r] * rli[r], 0.f) & 0xffffu);
        }
    }
    asm volatile("s_waitcnt vmcnt(0) lgkmcnt(0)\n\ts_barrier" ::: "memory");
}
}

__device__ __forceinline__ unsigned f2bf(float f) { unsigned u = __builtin_bit_cast(unsigned, f); return (u + 0x7fffu + ((u >> 16) & 1u)) >> 16; }
__device__ __forceinline__ unsigned pk2(float lo, float hi) { return f2bf(lo) | (f2bf(hi) << 16); }
struct TrItem { const GAS f32x4* src; GAS u32x4* d; int ls, ds; };
__device__ __forceinline__ TrItem tr_item(const float* W, int ldw, int k0, int n0, bf16* dst, int ldd, int drow0, int kd0, int lane) {
    const int kc = lane >> 3, nq = lane & 7; TrItem t;
    t.src = (const GAS f32x4*)(W + (size_t)(k0 + 8 * kc) * ldw + n0 + 4 * nq); t.ls = ldw / 4;
    t.d = (GAS u32x4*)(dst + (size_t)(drow0 + 4 * nq) * ldd + kd0 + 8 * kc); t.ds = ldd / 8; return t;
}
__device__ __forceinline__ void tr_load(const TrItem& t, f32x4 (&v)[8]) {
#pragma unroll
    for (int i = 0; i < 8; ++i) v[i] = t.src[(size_t)i * t.ls];
}
__device__ __forceinline__ void tr_store(const TrItem& t, const f32x4 (&v)[8]) {
#pragma unroll
    for (int j = 0; j < 4; ++j) { u32x4 o; o.x = cvt_pk_bf16(v[0][j], v[1][j]); o.y = cvt_pk_bf16(v[2][j], v[3][j]); o.z = cvt_pk_bf16(v[4][j], v[5][j]); o.w = cvt_pk_bf16(v[6][j], v[7][j]);
        t.d[(size_t)j * t.ds] = o; }
}
__device__ __forceinline__ int t5_bucket(int rel) {
    const int side = rel > 0 ? 16 : 0; const int n = rel < 0 ? -rel : rel;
    int b;
    if (n < 8) b = n; else if (n < 12) b = 8; else if (n < 16) b = 9; else if (n < 23) b = 10; else if (n < 32) b = 11; else if (n < 46) b = 12; else if (n < 64) b = 13; else if (n < 91) b = 14; else b = 15;
    return side + b;
}

struct Args { const float* in[22]; float* out; unsigned char* ws; int ph_lo, ph_hi; };

__global__ void __launch_bounds__(512, 2) mk_fwd(Args args) {
    extern __shared__ __attribute__((aligned(16))) unsigned char lds_raw[];
    LAS unsigned char* lds = (LAS unsigned char*)lds_raw;
    volatile LAS unsigned* MISC = (volatile LAS unsigned*)(lds + MISC_OFF);
    const int tid = threadIdx.x, lane = tid & 63, wave = __builtin_amdgcn_readfirstlane(tid >> 6);
    const int G = gridDim.x; const int bx = blockIdx.x; const int vcu = (G % 8 == 0) ? (bx % 8) * (G / 8) + bx / 8 : bx;
    unsigned char* ws = args.ws;
    unsigned* ctl = (unsigned*)(ws + WS_CTL);
    for (int u = tid; u < 64; u += 512) ((LAS unsigned*)(lds + MISC_OFF))[u] = 0u;
    __syncthreads();
    XcdBarrier bar; bar.bar = ctl + CW_BAR; bar.x = 0; bar.st = nullptr;
    if (MK_N_LAUNCHES == 1) bar = xcd_barrier_post(ctl + CW_BAR, MISC + 8);
    const int lo = args.ph_lo, hi = args.ph_hi;
    unsigned long long ts_a = 0, ts_b = 0;
#define IN(k) (lo <= (k) && (k) < hi)
#define SEAM(k) do { if (MK_N_LAUNCHES == 1 && IN(k) && IN((k) + 1)) xcd_barrier(bar); } while (0)

    const float* x = args.in[0];
    float* out = args.out;
    bf16* WINT = (bf16*)(ws + WS_WINT); bf16* WABT = (bf16*)(ws + WS_WABT); bf16* WOT = (bf16*)(ws + WS_WOT); bf16* WGUT = (bf16*)(ws + WS_WGUT); bf16* WDT = (bf16*)(ws + WS_WDT);
    bf16* XB = (bf16*)(ws + WS_XB); bf16* OAB = (bf16*)(ws + WS_OAB); bf16* QK = (bf16*)(ws + WS_QK); bf16* MIXED = (bf16*)(ws + WS_MIXED);
    bf16* VA = (bf16*)(ws + WS_VA); bf16* QBb = (bf16*)(ws + WS_QB); bf16* KBb = (bf16*)(ws + WS_KB); bf16* VBb = (bf16*)(ws + WS_VB);
    bf16* HN = (bf16*)out;
    bf16* HB = (bf16*)(ws + WS_H); bf16* YB = (bf16*)(ws + WS_Y); bf16* AO = (bf16*)(ws + WS_AO);
    bf16* GATES = (bf16*)out;
    float* TBLA = (float*)(ws + WS_TBLA); float* TBLB = (float*)(ws + WS_TBLB); float* LAMV = (float*)(ws + WS_LAM);
    bf16* WRH = (bf16*)(ws + WS_WR); bf16* WRL = WRH + 48 * 1024; float* LISTR = (float*)(ws + WS_LISTR);
    int* TOKPOS = (int*)(ws + WS_TOKPOS); int* LISTTOK = (int*)(ws + WS_LISTTOK); float* LISTW = (float*)(ws + WS_LISTW); unsigned* CURSOR = ctl + CW_CURSOR;

    if (TS_PHASE == 0) ts_a = __builtin_amdgcn_s_memrealtime();
    if (IN(0)) for (int rep = 0; rep < REP0; ++rep) {
        const int gw = vcu * 8 + wave, NGW = G * 8;
        constexpr int I_IN = 16 * 160, I_A = 8 * 32, I_B = 8 * 32, I_O = 16 * 32;
        constexpr int NITEMS = I_IN + I_A + I_B + I_O;
        static_assert(I_IN % 2 == 0 && I_A % 2 == 0 && I_B % 2 == 0 && I_O % 2 == 0, "batches of 2 items never straddle two matrices");
        for (int bt = gw; bt < NITEMS / 2; bt += NGW) {
            TrItem ti[2];
#pragma unroll
            for (int u = 0; u < 2; ++u) {
                int r = bt * 2 + u;
                if (r < I_IN) { const int kb = r / 160, nb = r % 160, n0 = 32 * nb, pn = n0 >> 8, cg = (n0 & 255) >> 5, wcc = cg >> 1, bjj = cg & 1;
                    ti[u] = tr_item(args.in[2], PROJ, 64 * kb, n0, WINT, 1024, pn * 256 + (pn >= 12 ? 32 * cg : 128 * bjj + 32 * wcc), 64 * kb, lane); }
                else if ((r -= I_IN) < I_A) { const int kb = r / 32, nb = r % 32; ti[u] = tr_item(args.in[11], 1024, 64 * kb, 32 * nb, WABT, 1024, 32 * nb, 64 * kb, lane); }
                else if ((r -= I_A) < I_B) { const int kb = r / 32, nb = r % 32; ti[u] = tr_item(args.in[12], 1024, 64 * kb, 32 * nb, WABT, 1024, 32 * nb, 512 + 64 * kb, lane); }
                else { r -= I_B; const int kb = r / 32, nb = r % 32; ti[u] = tr_item(args.in[13], 1024, 64 * kb, 32 * nb, WOT, 1024, 32 * nb, 64 * kb, lane); }
            }
            f32x4 v[2][8];
#pragma unroll
            for (int u = 0; u < 2; ++u) tr_load(ti[u], v[u]);
#pragma unroll
            for (int u = 0; u < 2; ++u) tr_store(ti[u], v[u]);
        }
        {   const GAS f32x4* gr = (const GAS f32x4*)args.in[1] + lane; f32x4 gg[4];
#pragma unroll
            for (int j = 0; j < 4; ++j) gg[j] = gr[64 * j];
            for (int m0 = gw * 4; m0 < T; m0 += NGW * 4) {
                f32x4 v[4][4];
#pragma unroll
                for (int u = 0; u < 4; ++u) { const GAS f32x4* xr = (const GAS f32x4*)(x + (size_t)(m0 + u) * D) + lane;
#pragma unroll
                    for (int j = 0; j < 4; ++j) v[u][j] = xr[64 * j]; }
#pragma unroll
                for (int u = 0; u < 4; ++u) { float ssq = 0.f;
#pragma unroll
                    for (int j = 0; j < 4; ++j) ssq += (v[u][j].x * v[u][j].x + v[u][j].y * v[u][j].y) + (v[u][j].z * v[u][j].z + v[u][j].w * v[u][j].w);
                    const float rstd = __builtin_amdgcn_rsqf(wave_sum(ssq) * (1.f / D) + EPS);
                    GAS u32x2* o8 = (GAS u32x2*)(XB + (size_t)(m0 + u) * D) + lane;
#pragma unroll
                    for (int j = 0; j < 4; ++j) { u32x2 w; w.x = cvt_pk_bf16(v[u][j].x * rstd * gg[j].x, v[u][j].y * rstd * gg[j].y); w.y = cvt_pk_bf16(v[u][j].z * rstd * gg[j].z, v[u][j].w * rstd * gg[j].w); o8[64 * j] = w; } }
            }
        }
        for (int idx = gw * 64 + lane; idx < 48 * 1024; idx += NGW * 64) { const int n = idx >> 10, k = idx & 1023; float w = 0.f;
            if (n < 32) w = args.in[17][k * 32 + n]; else if (n < 36) w = args.in[15][k * 4 + (n - 32)];
            w *= args.in[14][k]; const unsigned hb = cvt_pk_bf16(w, 0.f) & 0xffffu; WRH[idx] = (bf16)hb; WRL[idx] = (bf16)(cvt_pk_bf16(w - __uint_as_float(hb << 16), 0.f) & 0xffffu); }
        for (int idx = gw * 64 + lane; idx < 12 * 256; idx += NGW * 64) {
            const int hh = idx >> 8, i = idx & 255; const bool isA = hh < 4; const int h = isA ? hh : hh - 4;
            const float farv = isA ? args.in[7][15 * 4 + h] : args.in[10][0 * 8 + h];
            float v;
            if (i == 255) v = farv * LOG2E;
            else { const int rel = i - 191; float b;
                if (isA) b = args.in[7][t5_bucket(rel) * 4 + h];
                else { int ri = rel < -128 ? -128 : (rel > 128 ? 128 : rel); b = args.in[10][(ri + 128) * 8 + h]; }
                v = (b - farv) * LOG2E; }
            (isA ? TBLA : TBLB)[h * 256 + i] = v;
        }
        if (gw == 0) { const float* lp = args.in[5]; const float a = wave_sum(lp[lane] * lp[64 + lane]), b = wave_sum(lp[128 + lane] * lp[192 + lane]);
            if (lane == 0) LAMV[0] = expf(a) - expf(b) + 0.2f; }
    }
    SEAM(0);
    if (TS_PHASE == 0) ts_b = __builtin_amdgcn_s_memrealtime();

    if (TS_PHASE == 1) ts_a = __builtin_amdgcn_s_memrealtime();
    if (IN(1)) for (int rep = 0; rep < REP1; ++rep) {
        pg8::DenseSched S{(const char*)XB, (const char*)WINT, 1024, 1024, T / 256, PROJ / 256, G, bx, 1, 1024};
        EpiProj E{QK, VA, QBb, KBb, VBb, GATES, args.in[3], args.in[4], args.in[8], args.in[9]};
        pg8::gemm_phase<EpiProj, pg8::DenseSched, true>(lds, 1024, S, E);
    }
    SEAM(1);
    if (TS_PHASE == 1) ts_b = __builtin_amdgcn_s_memrealtime();

    if (TS_PHASE == 2) ts_a = __builtin_amdgcn_s_memrealtime();
    if (IN(2)) {
        const float lam = LAMV[0];
        att::ConvState cv; att::conv_init(cv, vcu, wave, args.in[19], args.in[20], args.in[21], WGUT, WDT);
        for (int i = 0; i < 2 * REP2A; ++i) {
            const int uidx = vcu; const int bh = uidx >> 5, sidx = uidx & 31; const int qb = ((i & 1) == 0) ? sidx : 63 - sidx;
            const int b = bh >> 2, h = bh & 3;
            if (vcu < 256)
            att::attn_unit_pipe<2, 128, 256, 512>(QK + h * 64, QK + (size_t)T * 256 + h * 64, QK + (size_t)2 * T * 256 + (size_t)(b * 4 + h) * 128 * 4096, QK + (size_t)3 * T * 256 + (size_t)(b * 4 + h) * 128 * 4096, VA + (size_t)(b * 4 + h) * 128 * 8192,
                                              (long)b * SEQ, qb * 128, TBLA + h * 256, args.in[6], lam, OAB + h * 128, (char*)lds_raw, cv);
        }
        while (cv.jc < att::CONV_N) {
            asm volatile("s_waitcnt vmcnt(0) lgkmcnt(0)\n\ts_barrier" ::: "memory");
            if (cv.jc + 2 <= cv.jd) att::conv_convert(cv, wave < 4, wave & 3, lane, (char*)lds_raw);
            if (cv.jd < att::CONV_N) att::conv_dma(cv, wave, lane, (unsigned)(uintptr_t)(char*)lds_raw); else if (cv.jd < att::CONV_N + 2) cv.jd += 1;
        }
        asm volatile("s_waitcnt vmcnt(0) lgkmcnt(0)\n\ts_barrier" ::: "memory");
        for (int i = 0; i < 2 * REP2B; ++i) {
            const int uidx = vcu * 2 + (i & 1); const int bh = uidx >> 5, grp = uidx & 31; const int b = bh >> 3, h = bh & 7;
            if (vcu < 256)
            att::attn_unit_simple<1, 64, 512, 512>(QBb + h * 64, nullptr, KBb + (size_t)(b * 8 + h) * 128 * 4096, nullptr, VBb + (size_t)(b * 8 + h) * 128 * 4096, (long)b * SEQ, grp * 256, TBLB + h * 256, nullptr, 0.f, OAB + 512 + h * 64, (char*)lds_raw);
        }
    }
    SEAM(2);
    if (TS_PHASE == 2) ts_b = __builtin_amdgcn_s_memrealtime();

    if (TS_PHASE == 3 || TS_PHASE == 107) ts_a = __builtin_amdgcn_s_memrealtime();
    if (IN(3)) for (int rep = 0; rep < REP3; ++rep) {
        pg8::DenseSched S{(const char*)OAB, (const char*)WABT, 1024, 1024, T / 256, D / 256, G, bx, 2, 512};
        EpiAB E{GATES, MIXED, ctl + CW_MIXCTR};
        pg8::gemm_phase<EpiAB, pg8::DenseSched, true>(lds, 512, S, E);
        if (TS_PHASE == 107) { __syncthreads(); ts_b = __builtin_amdgcn_s_memrealtime(); }
    }
    if (TS_PHASE == 3) ts_b = __builtin_amdgcn_s_memrealtime();

#define TILE_WAIT2(p0, p1) do { if (wave == 0) { unsigned* cps_[2] = {(p0), (p1)}; \
            _Pragma("unroll") for (int w_ = 0; w_ < 2; ++w_) { unsigned spins_ = 0; \
                while ((unsigned)__builtin_amdgcn_readfirstlane(__hip_atomic_load(cps_[w_], __ATOMIC_RELAXED, __HIP_MEMORY_SCOPE_AGENT)) < 32u) { __builtin_amdgcn_s_sleep(2); if (++spins_ > (1u << 22)) break; } } \
            __builtin_amdgcn_fence(__ATOMIC_ACQUIRE, "agent"); asm volatile("s_waitcnt vmcnt(0)" ::: "memory"); } \
        __syncthreads(); } while (0)
    if (TS_PHASE == 4 || TS_PHASE == 108) ts_a = __builtin_amdgcn_s_memrealtime();
    if (IN(4)) for (int rep = 0; rep < REP4; ++rep) {
        pg8::DenseSched S{(const char*)MIXED, (const char*)WOT, 1024, 1024, T / 256, D / 256, G, bx, 1, 1024};
        { pg8::Unit u0; if (S.next(0, u0)) { unsigned* cp = ctl + CW_MIXCTR + 64 * u0.pm; TILE_WAIT2(cp, cp); } else { __syncthreads(); } }
        EpiAO E{AO, ctl + CW_AOCTR};
        pg8::gemm_phase<EpiAO, pg8::DenseSched, true>(lds, 1024, S, E);
        if (TS_PHASE == 108) { __syncthreads(); ts_b = __builtin_amdgcn_s_memrealtime(); }
    }
    if (TS_PHASE == 4) ts_b = __builtin_amdgcn_s_memrealtime();

    if (TS_PHASE == 5 || TS_PHASE == 105 || TS_PHASE == 106) ts_a = __builtin_amdgcn_s_memrealtime();
    if (IN(5)) for (int rep = 0; rep < REP5; ++rep) {
        LAS float* LG = (LAS float*)lds;
        LAS float* SQ = LG + 2 * 64 * 48;
        LAS int* CNT = (LAS int*)(SQ + 128); LAS int* BASE = CNT + 32;
        if (tid < 32) CNT[tid] = 0;
        __syncthreads();
        for (int task = vcu; task < T / 64; task += G) {
            TILE_WAIT2(ctl + CW_AOCTR + 64 * (task >> 2), ctl + CW_MIXCTR + 64 * (task >> 3));
            {
                const int rl = lane & 15, q = lane >> 4, rb = (wave & 3) * 16, kh = wave >> 2; const int row = task * 64 + rb + rl;
                const float* xr = x + (size_t)row * D + 512 * kh + 8 * q; const bf16* aop = AO + (size_t)row * D + 512 * kh + 8 * q; const bf16* whp = WRH + (size_t)rl * 1024 + 512 * kh + 8 * q; const bf16* wlp = WRL + (size_t)rl * 1024 + 512 * kh + 8 * q;
                const float* g2p = args.in[14] + 512 * kh + 8 * q; bf16* hp = HN + (size_t)row * D + 512 * kh + 8 * q;
                f32x4 a0 = {0.f, 0.f, 0.f, 0.f}, a1 = a0, a2 = a0; float ssq = 0.f;
#pragma unroll 4
                for (int c = 0; c < 16; ++c) {
                    f32x4 x0 = *(const f32x4*)(xr + 32 * c), x1v = *(const f32x4*)(xr + 32 * c + 4);
                    { const u32x4 aw = *(const u32x4*)(aop + 32 * c);
                      x0[0] += __uint_as_float(aw.x << 16); x0[1] += __uint_as_float(aw.x & 0xffff0000u); x0[2] += __uint_as_float(aw.y << 16); x0[3] += __uint_as_float(aw.y & 0xffff0000u);
                      x1v[0] += __uint_as_float(aw.z << 16); x1v[1] += __uint_as_float(aw.z & 0xffff0000u); x1v[2] += __uint_as_float(aw.w << 16); x1v[3] += __uint_as_float(aw.w & 0xffff0000u); }
                    const f32x4 g0 = *(const f32x4*)(g2p + 32 * c), g1 = *(const f32x4*)(g2p + 32 * c + 4);
                    const bf16x8 h0 = *(const bf16x8*)(whp + 32 * c), h1 = *(const bf16x8*)(whp + 16 * 1024 + 32 * c), h2 = *(const bf16x8*)(whp + 32 * 1024 + 32 * c);
                    const bf16x8 l0 = *(const bf16x8*)(wlp + 32 * c), l1 = *(const bf16x8*)(wlp + 16 * 1024 + 32 * c), l2 = *(const bf16x8*)(wlp + 32 * 1024 + 32 * c);
                    u32x4 xh, xl;
                    { const float f[8] = {x0[0], x0[1], x0[2], x0[3], x1v[0], x1v[1], x1v[2], x1v[3]};
#pragma unroll
                      for (int p = 0; p < 4; ++p) { const unsigned hw = cvt_pk_bf16(f[2 * p], f[2 * p + 1]); xh[p] = hw;
                          xl[p] = cvt_pk_bf16(f[2 * p] - __uint_as_float(hw << 16), f[2 * p + 1] - __uint_as_float(hw & 0xffff0000u)); } }
                    { u32x4 hw; hw.x = cvt_pk_bf16(x0[0] * g0[0], x0[1] * g0[1]); hw.y = cvt_pk_bf16(x0[2] * g0[2], x0[3] * g0[3]); hw.z = cvt_pk_bf16(x1v[0] * g1[0], x1v[1] * g1[1]); hw.w = cvt_pk_bf16(x1v[2] * g1[2], x1v[3] * g1[3]);
                      *(u32x4*)(hp + 32 * c) = hw; }
                    const bf16x8 ah = __builtin_bit_cast(bf16x8, xh), al = __builtin_bit_cast(bf16x8, xl);
                    a0 = __builtin_amdgcn_mfma_f32_16x16x32_bf16(ah, h0, a0, 0, 0, 0); a1 = __builtin_amdgcn_mfma_f32_16x16x32_bf16(ah, h1, a1, 0, 0, 0); a2 = __builtin_amdgcn_mfma_f32_16x16x32_bf16(ah, h2, a2, 0, 0, 0);
                    a0 = __builtin_amdgcn_mfma_f32_16x16x32_bf16(ah, l0, a0, 0, 0, 0); a1 = __builtin_amdgcn_mfma_f32_16x16x32_bf16(ah, l1, a1, 0, 0, 0); a2 = __builtin_amdgcn_mfma_f32_16x16x32_bf16(ah, l2, a2, 0, 0, 0);
                    a0 = __builtin_amdgcn_mfma_f32_16x16x32_bf16(al, h0, a0, 0, 0, 0); a1 = __builtin_amdgcn_mfma_f32_16x16x32_bf16(al, h1, a1, 0, 0, 0); a2 = __builtin_amdgcn_mfma_f32_16x16x32_bf16(al, h2, a2, 0, 0, 0);
                    ssq += (x0.x * x0.x + x0.y * x0.y) + (x0.z * x0.z + x0.w * x0.w) + (x1v.x * x1v.x + x1v.y * x1v.y) + (x1v.z * x1v.z + x1v.w * x1v.w);
                }
                ssq += __shfl_xor(ssq, 16); ssq += __shfl_xor(ssq, 32);
#pragma unroll
                for (int r = 0; r < 4; ++r) { LAS float* lp = LG + (kh * 64 + rb + 4 * q + r) * 48 + rl; lp[0] = a0[r]; lp[16] = a1[r]; lp[32] = a2[r]; }
                if (q == 0) SQ[kh * 64 + rb + rl] = ssq;
            }
            __syncthreads();
            if (TS_PHASE == 105) ts_b = __builtin_amdgcn_s_memrealtime();
            if (wave == 0) {
                const int row = task * 64 + lane; const float rs = __builtin_amdgcn_rsqf((SQ[lane] + SQ[64 + lane]) * (1.f / D) + EPS); const LAS float* lg = LG + lane * 48; const LAS float* lg2 = lg + 64 * 48;
                float gl[4]; float gmax = -3.0e38f; int gi = 0;
#pragma unroll
                for (int jj = 0; jj < 4; ++jj) { gl[jj] = (lg[32 + jj] + lg2[32 + jj]) * rs + args.in[16][jj]; if (gl[jj] > gmax) { gmax = gl[jj]; gi = jj; } }
                float gsum = 0.f;
#pragma unroll
                for (int jj = 0; jj < 4; ++jj) gsum += __expf(gl[jj] - gmax);
                const float pg = 1.f / gsum;
                float el[8]; float b1 = -3.0e38f, b2 = -3.0e38f; int i1 = 0, i2 = 0;
#pragma unroll
                for (int jj = 0; jj < 8; ++jj) { el[jj] = (lg[8 * gi + jj] + lg2[8 * gi + jj]) * rs + args.in[18][8 * gi + jj]; if (el[jj] > b1) { b1 = el[jj]; i1 = jj; } }
#pragma unroll
                for (int jj = 0; jj < 8; ++jj) { if (jj != i1 && el[jj] > b2) { b2 = el[jj]; i2 = jj; } }
                const float wa = pg / (1.f + __expf(b2 - b1)), wb = pg - wa;
                const int e1 = 8 * gi + i1, e2 = 8 * gi + i2;
                const int r1 = __hip_atomic_fetch_add(&CNT[e1], 1, __ATOMIC_RELAXED, __HIP_MEMORY_SCOPE_WORKGROUP), r2 = __hip_atomic_fetch_add(&CNT[e2], 1, __ATOMIC_RELAXED, __HIP_MEMORY_SCOPE_WORKGROUP);
                LDS_WAIT();
                if (lane < 32) { const int c = CNT[lane]; CNT[lane] = 0; BASE[lane] = c > 0 ? (int)__hip_atomic_fetch_add(CURSOR + 64 * lane, (unsigned)c, __ATOMIC_RELAXED, __HIP_MEMORY_SCOPE_AGENT) : 0; }
                LDS_WAIT();
                const int p1 = BASE[e1] + r1, p2 = BASE[e2] + r2;
                LISTTOK[e1 * CAP + p1] = row; LISTW[e1 * CAP + p1] = wa; LISTR[e1 * CAP + p1] = rs; LISTTOK[e2 * CAP + p2] = row; LISTW[e2 * CAP + p2] = wb; LISTR[e2 * CAP + p2] = rs;
                TOKPOS[2 * row] = (e1 << 16) | p1; TOKPOS[2 * row + 1] = (e2 << 16) | p2;
            }
            __syncthreads();
            if (TS_PHASE == 106) ts_b = __builtin_amdgcn_s_memrealtime();
        }
    }
    SEAM(5);
    if (TS_PHASE == 5) ts_b = __builtin_amdgcn_s_memrealtime();

    LAS int* MOE_CNT = (LAS int*)(lds + MISC_OFF + 256); LAS int* MOE_TB = MOE_CNT + 32;
    if (hi > 6) {
        if (wave == 0) {
            const int e = lane & 31; const int cnt = (int)__hip_atomic_load(CURSOR + 64 * e, __ATOMIC_RELAXED, __HIP_MEMORY_SCOPE_AGENT); const int nt = (cnt + 255) >> 8;
            int incl = nt;
#pragma unroll
            for (int o = 1; o < 32; o <<= 1) { const int v = __shfl_up(incl, o); if ((lane & 31) >= o) incl += v; }
            if (lane < 32) { MOE_CNT[e] = cnt; MOE_TB[e] = incl - nt; if (e == 31) MOE_TB[32] = incl; }
        }
        __syncthreads();
    }
    const int cmoe = (G == 256) ? 4 * (((vcu & 31) >> 2) * 8 + (vcu >> 5)) + (vcu & 3) : vcu;
#define MOE_LOOKUP(mu, nunits, cc) do { nunits = MOE_TB[32] * 4; \
        _Pragma("unroll") for (int i_ = 0; i_ < 3; ++i_) { const int L_ = i_ * G + (cc); int e_ = 0, p_ = 0, n_ = 1; \
            if (L_ < nunits) { const int rt_ = L_ >> 2; for (int q_ = 0; q_ < 32; ++q_) { if (MOE_TB[q_] <= rt_ && rt_ < MOE_TB[q_ + 1]) e_ = q_; } p_ = (rt_ - MOE_TB[e_]) * 256; n_ = MOE_CNT[e_]; } \
            mu.e[i_] = __builtin_amdgcn_readfirstlane(e_); mu.pos0[i_] = __builtin_amdgcn_readfirstlane(p_); mu.n[i_] = __builtin_amdgcn_readfirstlane(n_); } } while (0)

    if (TS_PHASE == 6) ts_a = __builtin_amdgcn_s_memrealtime();
    if (IN(6)) for (int rep = 0; rep < REP6; ++rep) {
        pg8::MoeUnits mu; int nunits; MOE_LOOKUP(mu, nunits, cmoe);
        pg8::MoeSched<true> S{(const char*)HN, (const char*)WGUT, LISTTOK, 1024, 1024, G, cmoe, nunits, mu, (size_t)1024 * 1024 * 2, 0, 3};
        EpiGU E{HB, LISTR, ctl + CW_TILECTR};
        pg8::gemm_phase<EpiGU, pg8::MoeSched<true>, true>(lds, 1024, S, E);
    }
    if (TS_PHASE == 6) ts_b = __builtin_amdgcn_s_memrealtime();

    if (TS_PHASE == 7) ts_a = __builtin_amdgcn_s_memrealtime();
    if (IN(7)) for (int rep = 0; rep < REP7; ++rep) {
        const int cc = G - 1 - cmoe;
        pg8::MoeUnits mu; int nunits; MOE_LOOKUP(mu, nunits, cc);
        EpiDown E{YB, LISTW};
#pragma unroll
        for (int part = 0; part < 2; ++part) {
            const int i0 = part * 2, i1 = part == 0 ? 2 : 3;
            if (wave == 0) {
                for (int i = i0; i < i1; ++i) { const int L = i * G + cc; if (L >= nunits) break;
                    unsigned* cp = ctl + CW_TILECTR + 64 * (L >> 2); unsigned spins = 0;
                    while ((unsigned)__builtin_amdgcn_readfirstlane(__hip_atomic_load(cp, __ATOMIC_RELAXED, __HIP_MEMORY_SCOPE_AGENT)) < 32u) { __builtin_amdgcn_s_sleep(2); if (++spins > (1u << 22)) break; } }
                __builtin_amdgcn_fence(__ATOMIC_ACQUIRE, "agent");
                asm volatile("s_waitcnt vmcnt(0)" ::: "memory");
            }
            __syncthreads();
            pg8::MoeSched<false> S{(const char*)HB, (const char*)WDT, LISTTOK, 512, 512, G, cc, nunits, mu, (size_t)1024 * 512 * 2, i0, i1 - i0};
            pg8::gemm_phase<EpiDown, pg8::MoeSched<false>, true>(lds, 512, S, E);
        }
    }
    SEAM(7);
    if (TS_PHASE == 7) ts_b = __builtin_amdgcn_s_memrealtime();

    if (TS_PHASE == 8) ts_a = __builtin_amdgcn_s_memrealtime();
    if (IN(8)) {
        const int gw = vcu * 8 + wave, NGW = G * 8;
        for (int m = gw; m < T; m += NGW) {
            const int c1 = TOKPOS[2 * m], c2 = TOKPOS[2 * m + 1];
            const int s1 = MOE_TB[c1 >> 16] * 256 + (c1 & 0xffff), s2 = MOE_TB[c2 >> 16] * 256 + (c2 & 0xffff);
            const GAS f32x4* xr = (const GAS f32x4*)(x + (size_t)m * D) + lane; GAS f32x4* orow = (GAS f32x4*)(out + (size_t)m * D) + lane;
            const GAS u32x2* y1 = (const GAS u32x2*)(YB + (size_t)s1 * D) + lane; const GAS u32x2* y2 = (const GAS u32x2*)(YB + (size_t)s2 * D) + lane; const GAS u32x2* ar = (const GAS u32x2*)(AO + (size_t)m * D) + lane;
#pragma unroll
            for (int j = 0; j < 4; ++j) { f32x4 v = xr[64 * j]; const u32x2 a = y1[64 * j], b = y2[64 * j], c = ar[64 * j];
                v.x += __uint_as_float(c.x << 16) + (__uint_as_float(a.x << 16) + __uint_as_float(b.x << 16)); v.y += __uint_as_float(c.x & 0xffff0000u) + (__uint_as_float(a.x & 0xffff0000u) + __uint_as_float(b.x & 0xffff0000u));
                v.z += __uint_as_float(c.y << 16) + (__uint_as_float(a.y << 16) + __uint_as_float(b.y << 16)); v.w += __uint_as_float(c.y & 0xffff0000u) + (__uint_as_float(a.y & 0xffff0000u) + __uint_as_float(b.y & 0xffff0000u));
                orow[64 * j] = v; }
        }
    }
    if (TS_PHASE >= 0 && blockIdx.x == 0) { if (TS_PHASE == 8) ts_b = __builtin_amdgcn_s_memrealtime(); const unsigned long long t_end = __builtin_amdgcn_s_memrealtime(), dt = ts_b - ts_a;
        while (__builtin_amdgcn_s_memrealtime() - t_end < dt) __builtin_amdgcn_s_sleep(8); }
#undef IN
#undef SEAM
}

extern "C" void kernel_launch(void* const* d_in, const int* in_sizes, int n_in, void* d_out, int out_size, void* d_ws, size_t ws_size, hipStream_t stream) {
    static int grid = 0;
    if (grid == 0) {
        if (n_in != 22 || out_size != T * D || ws_size < WS_END) { fprintf(stderr, "kernel_launch: unexpected shapes (n_in %d out %d ws %zu)\n", n_in, out_size, ws_size); grid = -1; return; }
        if (hipFuncSetAttribute((const void*)mk_fwd, hipFuncAttributeMaxDynamicSharedMemorySize, LDS_BYTES) != hipSuccess) { fprintf(stderr, "kernel_launch: hipFuncSetAttribute failed\n"); grid = -1; return; }
        int dev = 0, cus = 0, per_cu = 0;
        (void)hipGetDevice(&dev); (void)hipDeviceGetAttribute(&cus, hipDeviceAttributeMultiprocessorCount, dev);
        (void)hipOccupancyMaxActiveBlocksPerMultiprocessor(&per_cu, (const void*)mk_fwd, 512, LDS_BYTES);
        (void)hipGetLastError();
        if (cus != 256 || per_cu < 1) fprintf(stderr, "kernel_launch: note: %d CUs, occupancy query %d\n", cus, per_cu);
        grid = 256;
    }
    if (grid < 0) return;
    (void)hipMemsetAsync((char*)d_ws + WS_CTL, 0, CTL_ZERO_BYTES, stream);
    Args a{};
    for (int i = 0; i < 22; ++i) a.in[i] = (const float*)d_in[i];
    a.out = (float*)d_out; a.ws = (unsigned char*)d_ws;
    if (MK_N_LAUNCHES == 1) { a.ph_lo = 0; a.ph_hi = NPHASE; hipLaunchKernelGGL(mk_fwd, dim3(grid), dim3(512), LDS_BYTES, stream, a); }
    else { for (int p = 0; p < NPHASE; ++p) { a.ph_lo = p; a.ph_hi = p + 1; hipLaunchKernelGGL(mk_fwd, dim3(grid), dim3(512), LDS_BYTES, stream, a); } }
}
```

```cpp
#include <hip/hip_runtime.h>
#include <cstdio>
#include <cstdint>

#ifndef MK_N_LAUNCHES
#define MK_N_LAUNCHES 1
#endif
constexpr int NPHASE = 9;
#ifndef TS_PHASE
#define TS_PHASE -1
#endif
#ifndef REP0
#define REP0 1
#endif
#ifndef REP1
#define REP1 1
#endif
#ifndef REP2A
#define REP2A 1
#endif
#ifndef REP2B
#define REP2B 1
#endif
#ifndef REP3
#define REP3 1
#endif
#ifndef REP4
#define REP4 1
#endif
#ifndef REP5
#define REP5 1
#endif
#ifndef REP6
#define REP6 1
#endif
#ifndef REP7
#define REP7 1
#endif
#ifndef REP8
#define REP8 1
#endif

#define GAS __attribute__((address_space(1)))
#define LAS __attribute__((address_space(3)))
typedef unsigned short bf16;
typedef short bf16x8 __attribute__((ext_vector_type(8)));
typedef short s16x4 __attribute__((ext_vector_type(4)));
typedef float f32x4 __attribute__((ext_vector_type(4)));
typedef float f32x16 __attribute__((ext_vector_type(16)));
typedef unsigned u32x4 __attribute__((ext_vector_type(4)));
typedef unsigned u32x2 __attribute__((ext_vector_type(2)));

constexpr int T = 16384, SEQ = 8192, D = 1024, PROJ = 5120;
constexpr int NEXP = 32, DEXP = 512;
constexpr int MAXSLOT = 40960, MAXTILES = MAXSLOT / 256;
constexpr float EPS = 1e-6f;
constexpr float LOG2E = 1.4426950408889634f;
constexpr float C2 = 0.125f * LOG2E;

constexpr size_t MiB = 1u << 20;
constexpr size_t WS_CTL = 0, CTL_ZERO_BYTES = 192 * 1024;
constexpr size_t WS_TBLA = 1 * MiB;
constexpr size_t WS_TBLB = WS_TBLA + 4096;
constexpr size_t WS_LAM = WS_TBLB + 8192;
constexpr size_t WS_WR = 1 * MiB + 64 * 1024;
constexpr size_t WS_TOKPOS = 1 * MiB + 512 * 1024;
constexpr size_t WS_LISTTOK = 2 * MiB;
constexpr size_t WS_LISTW = 226 * MiB;
constexpr size_t WS_WINT = 4 * MiB;
constexpr size_t WS_WABT = 14 * MiB;
constexpr size_t WS_WOT = 16 * MiB;
constexpr size_t WS_WGUT = 18 * MiB;
constexpr size_t WS_WDT = 82 * MiB;
constexpr size_t WS_XB = 114 * MiB;
constexpr size_t WS_OAB = 114 * MiB;
constexpr size_t WS_QK = 146 * MiB;
constexpr size_t WS_MIXED = 146 * MiB;
constexpr size_t WS_VA = 178 * MiB;
constexpr size_t WS_QB = 194 * MiB, WS_KB = 210 * MiB, WS_VB = 226 * MiB;
constexpr size_t WS_AO = 114 * MiB;
constexpr size_t WS_H = 242 * MiB;
constexpr size_t WS_Y = 146 * MiB;
constexpr size_t WS_LISTR = 228 * MiB;
constexpr size_t WS_END = 282 * MiB;
constexpr int CW_BAR = 1024;
constexpr int CW_CONV = 8448;
constexpr int CW_MIXCTR = 32768, CW_AOCTR = 36864;
constexpr int CW_TILECTR = 16384;
constexpr int CW_CURSOR = 8192;
constexpr int CAP = 16384;

constexpr int RING_BYTES = 131072;
constexpr int MISC_OFF = RING_BYTES;
constexpr int LDS_BYTES = 147456;

#define LDS_WAIT() asm volatile("s_waitcnt lgkmcnt(0)" ::: "memory")
#define VM_WAIT() asm volatile("s_waitcnt vmcnt(0)" ::: "memory")
__device__ __forceinline__ unsigned cvt_pk_bf16(float lo, float hi) { unsigned r; asm volatile("v_cvt_pk_bf16_f32 %0, %1, %2" : "=v"(r) : "v"(lo), "v"(hi)); return r; }
__device__ __forceinline__ float bf2f(unsigned short b) { return __uint_as_float((unsigned)b << 16); }
__device__ __forceinline__ float wave_sum(float v) {
#pragma unroll
    for (int o = 1; o < 64; o <<= 1) v += __shfl_xor(v, o);
    return v;
}

#define XB_TMO      128
#define XB_XCNT(j)  (256  + 64 * (j))
#define XB_XSUB(j)  (1280 + 64 * (j))
#define XB_XGEN(j)  (2304 + 64 * (j))
#define XB_TOP      3328
#define XB_TOPGEN   3392
#define XCD_BAR_WORDS 3456
#define XB_SPIN_CAP (1u << 18)
__device__ __forceinline__ unsigned xb_ld(unsigned* p)              { return __hip_atomic_load(p, __ATOMIC_RELAXED, __HIP_MEMORY_SCOPE_AGENT); }
__device__ __forceinline__ unsigned xb_add(unsigned* p, unsigned v) { return __hip_atomic_fetch_add(p, v, __ATOMIC_RELAXED, __HIP_MEMORY_SCOPE_AGENT); }
__device__ __forceinline__ unsigned xb_xcc_id() { return (unsigned)__builtin_amdgcn_s_getreg((3 << 11) | 20) & 0xFu; }
#define XB_SPIN(cond, bar) do { unsigned _sp = 0; while (cond) { __builtin_amdgcn_s_sleep(1); \
    if ((++_sp & 255u) == 0u) { if (xb_ld(&(bar)[XB_TMO])) break; if (_sp > XB_SPIN_CAP) { atomicAdd(&(bar)[XB_TMO], 1u); break; } } } } while (0)
struct XcdBarrier { unsigned* bar; unsigned x; volatile LAS unsigned* st; };
__device__ __forceinline__ XcdBarrier xcd_barrier_post(unsigned* bar, volatile LAS unsigned* st) {
    XcdBarrier b; b.bar = bar; b.x = xb_xcc_id(); b.st = st;
    if (threadIdx.x == 0) (void)xb_add(&bar[XB_XCNT(b.x)], 1u);
    return b;
}
__device__ __forceinline__ void xcd_barrier_complete(unsigned* bar, unsigned x, unsigned& nloc, unsigned& nx) {
    const unsigned G = gridDim.x * gridDim.y * gridDim.z;
    unsigned sum, cnt, mine, sp = 0u;
    for (;;) {
        sum = 0u; cnt = 0u; mine = 0u;
#pragma unroll
        for (unsigned j = 0; j < 16; ++j) { const unsigned c = xb_ld(&bar[XB_XCNT(j)]); sum += c; cnt += (c > 0u) ? 1u : 0u; mine = (j == x) ? c : mine; }
        if (sum == G) break;
        __builtin_amdgcn_s_sleep(1);
        if ((++sp & 255u) == 0u) { if (xb_ld(&bar[XB_TMO])) break; if (sp > XB_SPIN_CAP) { atomicAdd(&bar[XB_TMO], 1u); break; } }
    }
    nloc = mine > 0u ? mine : 1u; nx = cnt > 0u ? cnt : 1u;
}
__device__ __forceinline__ void xcd_barrier(const XcdBarrier& b) {
    asm volatile("s_waitcnt vmcnt(0)" ::: "memory");
    __syncthreads();
    if (threadIdx.x == 0) {
        unsigned* bar = b.bar;
        __builtin_amdgcn_s_waitcnt(0);
        unsigned nloc = b.st[0], nx = b.st[1];
        if (nloc == 0u) { xcd_barrier_complete(bar, b.x, nloc, nx); b.st[0] = nloc; b.st[1] = nx; }
        const unsigned old = xb_add(&bar[XB_XSUB(b.x)], 1u);
        const unsigned gen = old / nloc;
        if (old + 1u == (gen + 1u) * nloc) {
            __builtin_amdgcn_fence(__ATOMIC_RELEASE, "agent");
            asm volatile("s_waitcnt vmcnt(0)" ::: "memory");
            const unsigned og = xb_add(&bar[XB_TOP], 1u);
            const unsigned tg = og / nx;
            if (og + 1u == (tg + 1u) * nx) xb_add(&bar[XB_TOPGEN], 1u);
            else XB_SPIN(xb_ld(&bar[XB_TOPGEN]) == tg, bar);
            __builtin_amdgcn_fence(__ATOMIC_ACQUIRE, "agent");
            xb_add(&bar[XB_XGEN(b.x)], 1u);
            asm volatile("s_waitcnt vmcnt(0)" ::: "memory");
        } else {
            XB_SPIN(xb_ld(&bar[XB_XGEN(b.x)]) == gen, bar);
            __builtin_amdgcn_fence(__ATOMIC_ACQUIRE, "agent");
            asm volatile("s_waitcnt vmcnt(0)" ::: "memory");
        }
    }
    __syncthreads();
}

namespace pg8 {
constexpr int BM = 256, BK = 64, HALF = 128, HTB = HALF * BK * 2, NXCD = 8, WGM = 8;
__host__ __device__ __forceinline__ int lds_byte(int r, int c) { const int st = (r >> 4) * 2 + (c >> 5), rr = r & 15, cc = c & 31, ob = rr * 64 + cc * 2; return st * 1024 + (ob ^ (((ob >> 9) & 1) << 5)); }
__host__ __device__ __forceinline__ void stage_rc(int b, int& R, int& C) { const int st = b / 1024, sb = b % 1024, swz = sb ^ (((sb >> 9) & 1) << 5); R = (st >> 1) * 16 + swz / 64; C = (st & 1) * 32 + (swz % 64) / 2; }
__host__ __device__ __forceinline__ int perm32(int rho) { const int n = rho >> 4, i = rho & 15; return 8 * (i >> 2) + 4 * n + (i & 3); }

struct Unit { int pm, pn, e, part, pos0, n; };

__device__ __forceinline__ void tile_of(int L, int nM, int nN, int& pm, int& pn) {
    const int nwg = nM * nN; int wgid = L;
    { const int q = nwg / NXCD, r = nwg % NXCD, xcd = wgid % NXCD, off = wgid / NXCD; wgid = (xcd < r ? xcd * (q + 1) : r * (q + 1) + (xcd - r) * q) + off; }
    const int nig = WGM * nN, gid = wgid / nig, fm = gid * WGM, gsz = (nM - fm) < WGM ? (nM - fm) : WGM;
    pm = fm + ((wgid % nig) % gsz); pn = (wgid % nig) / gsz;
}

template <class Epi, class Sched, bool ALIGN_EPI>
__device__ __forceinline__ void gemm_phase(LAS unsigned char* lds, const int K, const Sched& S, const Epi& E) {
    const int tid = threadIdx.x, wid = __builtin_amdgcn_readfirstlane(tid >> 6), lane = tid & 63, wr = wid >> 2, wc = wid & 3, fr = lane & 15, fq = lane >> 4;
    const int nt = K / BK;
    int Rr[2], Cc[2]; unsigned voffB[2];
#pragma unroll
    for (int i = 0; i < 2; ++i) { int R, C; stage_rc(tid * 16 + i * 8192, R, C); Rr[i] = R; Cc[i] = C; const int Rb = Epi::PERM ? ((R & ~31) + perm32(R & 31)) : R; voffB[i] = (unsigned)(Rb * S.ldb + C) * 2u; }
    const size_t kstep = (size_t)(BK * 2);
    const size_t hstepB = (size_t)HALF * S.ldb * 2;
    const unsigned ldsw = (unsigned)wid * 1024u;
    const int aoff = lds_byte(wr * 64 + fr, fq * 8), boff = lds_byte(wc * 32 + fr, fq * 8);
#define PG8_SA(b, h) (((b) * 2 + (h)) * HTB)
#define PG8_SB(b, h) ((4 + (b) * 2 + (h)) * HTB)
#define PG8_STAGE_A(bufoff, gbase, offh) do { _Pragma("unroll") for (int _i = 0; _i < 2; ++_i) \
        __builtin_amdgcn_global_load_lds((const unsigned*)((const char*)(gbase) + (offh)[_i]), (LAS unsigned*)(lds + (bufoff) + ldsw + _i * 8192), 16, 0, 0); } while (0)
#define PG8_STAGE_B(bufoff, gbase) do { _Pragma("unroll") for (int _i = 0; _i < 2; ++_i) \
        __builtin_amdgcn_global_load_lds((const unsigned*)((const char*)(gbase) + voffB[_i]), (LAS unsigned*)(lds + (bufoff) + ldsw + _i * 8192), 16, 0, 0); } while (0)
#define PG8_LDA(dst, b, h) do { _Pragma("unroll") for (int m = 0; m < 4; ++m) _Pragma("unroll") for (int k = 0; k < 2; ++k) dst[m][k] = *(const LAS bf16x8*)(lds + PG8_SA(b, h) + aoff + m * 2048 + k * 1024); } while (0)
#define PG8_LDB(dst, b, h) do { _Pragma("unroll") for (int n = 0; n < 2; ++n) _Pragma("unroll") for (int k = 0; k < 2; ++k) dst[n][k] = *(const LAS bf16x8*)(lds + PG8_SB(b, h) + boff + n * 2048 + k * 1024); } while (0)
#define PG8_MMA(ai, bj, At, Bt) do { __builtin_amdgcn_s_setprio(1); _Pragma("unroll") for (int m = 0; m < 4; ++m) _Pragma("unroll") for (int n = 0; n < 2; ++n) _Pragma("unroll") for (int k = 0; k < 2; ++k) \
        acc[ai][bj][m][n] = __builtin_amdgcn_mfma_f32_16x16x32_bf16(Bt[n][k], At[m][k], acc[ai][bj][m][n], 0, 0, 0); __builtin_amdgcn_s_setprio(0); } while (0)
#define PG8_WAIT_V(n) asm volatile("s_waitcnt vmcnt(" #n ")" ::: "memory")
#define PG8_WAIT_L(n) asm volatile("s_waitcnt lgkmcnt(" #n ")" ::: "memory")
#define PG8_BAR __builtin_amdgcn_s_barrier()
#define PG8_SCHED __builtin_amdgcn_sched_barrier(0)
    Unit cur, nxt; int ui = 0;
    if (!S.next(0, cur)) return;
    f32x4 acc[2][2][4][2];
#pragma unroll
    for (int a = 0; a < 2; ++a)
#pragma unroll
        for (int b = 0; b < 2; ++b)
#pragma unroll
            for (int m = 0; m < 4; ++m)
#pragma unroll
                for (int n = 0; n < 2; ++n) acc[a][b][m][n] = (f32x4){0.f, 0.f, 0.f, 0.f};
    bf16x8 At[4][2], B0[2][2], B1[2][2];
    const char* cA = S.a_base(cur); const char* cB = S.b_base(cur);
    unsigned oA[2][2], nraw[2][2];
    {
        unsigned raw[2][2];
#pragma unroll
        for (int h = 0; h < 2; ++h)
#pragma unroll
            for (int i = 0; i < 2; ++i) raw[h][i] = S.a_raw(cur, h, Rr[i]);
        if (Sched::GATHER) PG8_WAIT_V(0);
#pragma unroll
        for (int h = 0; h < 2; ++h)
#pragma unroll
            for (int i = 0; i < 2; ++i) oA[h][i] = S.a_conv(raw[h][i], Cc[i]);
    }
    PG8_STAGE_B(PG8_SB(0, 0), cB); PG8_STAGE_B(PG8_SB(0, 1), cB + hstepB); PG8_STAGE_A(PG8_SA(0, 0), cA, oA[0]); PG8_STAGE_A(PG8_SA(0, 1), cA, oA[1]);
    if (wr == 1) PG8_BAR;
    PG8_WAIT_V(2); PG8_BAR;
    PG8_STAGE_B(PG8_SB(1, 0), cB + kstep); PG8_STAGE_A(PG8_SA(1, 0), cA + kstep, oA[0]); PG8_STAGE_B(PG8_SB(1, 1), cB + hstepB + kstep);
    PG8_WAIT_V(6); PG8_BAR;
    for (;;) {
        const bool has_next = S.next(ui + 1, nxt);
        const char* nA = has_next ? S.a_base(nxt) : cA; const char* nB = has_next ? S.b_base(nxt) : cB;
        if (Sched::GATHER && has_next) {
#pragma unroll
            for (int h = 0; h < 2; ++h)
#pragma unroll
                for (int i = 0; i < 2; ++i) nraw[h][i] = S.a_raw(nxt, h, Rr[i]);
        }
        for (int t = 0; t < nt; t += 2) {
            const bool last = (t == nt - 2);
            const char* a1 = cA + (size_t)(t + 1) * kstep;
            const char* a2 = last ? nA : cA + (size_t)(t + 2) * kstep; const char* b2 = last ? nB : cB + (size_t)(t + 2) * kstep;
            const char* a3 = a2 + kstep; const char* b3 = b2 + kstep;
            PG8_LDB(B0, 0, 0); PG8_LDB(B1, 0, 1); PG8_SCHED; PG8_LDA(At, 0, 0); PG8_STAGE_A(PG8_SA(1, 1), a1, oA[1]);
            PG8_WAIT_V(8); PG8_WAIT_L(0); PG8_BAR; PG8_MMA(0, 0, At, B0); PG8_MMA(0, 1, At, B1); PG8_BAR; PG8_SCHED;
            if (last && has_next) {
#pragma unroll
                for (int h = 0; h < 2; ++h)
#pragma unroll
                    for (int i = 0; i < 2; ++i) oA[h][i] = S.a_conv(Sched::GATHER ? nraw[h][i] : S.a_raw(nxt, h, Rr[i]), Cc[i]);
            }
            PG8_LDA(At, 0, 1); PG8_STAGE_B(PG8_SB(0, 0), b2); PG8_STAGE_B(PG8_SB(0, 1), b2 + hstepB); PG8_STAGE_A(PG8_SA(0, 0), a2, oA[0]);
            PG8_WAIT_V(8); PG8_WAIT_L(0); PG8_BAR; PG8_MMA(1, 0, At, B0); PG8_MMA(1, 1, At, B1); PG8_BAR; PG8_SCHED;
            PG8_LDB(B0, 1, 0); PG8_LDB(B1, 1, 1); PG8_SCHED; PG8_LDA(At, 1, 0); PG8_STAGE_A(PG8_SA(0, 1), a2, oA[1]);
            PG8_WAIT_V(8); PG8_WAIT_L(0); PG8_BAR; PG8_MMA(0, 0, At, B0); PG8_MMA(0, 1, At, B1); PG8_BAR; PG8_SCHED;
            PG8_LDA(At, 1, 1); PG8_STAGE_B(PG8_SB(1, 0), b3); PG8_STAGE_B(PG8_SB(1, 1), b3 + hstepB); PG8_STAGE_A(PG8_SA(1, 0), a3, oA[0]);
            PG8_WAIT_V(8); PG8_WAIT_L(0); PG8_BAR; PG8_MMA(1, 0, At, B0); PG8_MMA(1, 1, At, B1); PG8_BAR; PG8_SCHED;
        }
        if constexpr (ALIGN_EPI) { if (wr == 0) PG8_BAR; }
        if (TS_PHASE >= 120 && TS_PHASE <= 129 && (TS_PHASE & 1) == 0 && ui == (TS_PHASE - 120) / 2 && tid == 0) *(LAS unsigned long long*)(lds + MISC_OFF + 128) = __builtin_amdgcn_s_memrealtime();
        E(acc, cur, wr, wc, fr, fq);
        if (TS_PHASE >= 120 && TS_PHASE <= 129 && (TS_PHASE & 1) == 1 && ui == (TS_PHASE - 121) / 2 && tid == 256) *(LAS unsigned long long*)(lds + MISC_OFF + 128) = __builtin_amdgcn_s_memrealtime();
        if (!has_next) break;
        if (!E.keep(cur)) {
#pragma unroll
            for (int a = 0; a < 2; ++a)
#pragma unroll
                for (int b = 0; b < 2; ++b)
#pragma unroll
                    for (int m = 0; m < 4; ++m)
#pragma unroll
                        for (int n = 0; n < 2; ++n) acc[a][b][m][n] = (f32x4){0.f, 0.f, 0.f, 0.f};
        }
        cur = nxt; cA = nA; cB = nB; ++ui;
        if constexpr (ALIGN_EPI) { if (wr == 1) PG8_BAR; }
    }
    PG8_WAIT_V(0);
    if constexpr (!ALIGN_EPI) { if (wr == 0) PG8_BAR; }
    PG8_BAR;
#undef PG8_SA
#undef PG8_SB
#undef PG8_STAGE_A
#undef PG8_STAGE_B
#undef PG8_LDA
#undef PG8_LDB
#undef PG8_MMA
#undef PG8_WAIT_V
#undef PG8_WAIT_L
#undef PG8_BAR
#undef PG8_SCHED
}

struct DenseSched {
    static constexpr bool GATHER = false;
    const char* A; const char* Bt; int lda, ldb, nM, nN, G, c, nparts, K;
    __device__ __forceinline__ bool next(int i, Unit& u) const {
        const int ti = i / nparts; const long L = (long)ti * G + c; if (L >= (long)nM * nN) return false;
        tile_of((int)L, nM, nN, u.pm, u.pn); u.part = i - ti * nparts; u.e = 0; return true;
    }
    __device__ __forceinline__ const char* a_base(const Unit& u) const { return A + (size_t)u.part * K * 2; }
    __device__ __forceinline__ const char* b_base(const Unit& u) const { return Bt + ((size_t)u.pn * BM * ldb + (size_t)u.part * K) * 2; }
    __device__ __forceinline__ unsigned a_raw(const Unit& u, int h, int R) const { return (unsigned)(u.pm * BM + h * HALF + R); }
    __device__ __forceinline__ unsigned a_conv(unsigned raw, int C) const { return (raw * (unsigned)lda + (unsigned)C) * 2u; }
};
struct MoeUnits { int e[3], pos0[3], n[3]; };
template <bool GATHER_>
struct MoeSched {
    static constexpr bool GATHER = GATHER_;
    const char* A; const char* Bt; const int* list_tok; int lda, ldb, G, c, nunits; MoeUnits mu; size_t bstride; int ibase, icount;
    __device__ __forceinline__ bool next(int i_, Unit& u) const {
        const int i = i_ + ibase; const int L = i * G + c; if (i_ >= icount || i > 2 || L >= nunits) return false;
        u.pm = L >> 2; u.pn = L & 3; u.part = 0;
        u.e = (i == 0) ? mu.e[0] : (i == 1 ? mu.e[1] : mu.e[2]); u.pos0 = (i == 0) ? mu.pos0[0] : (i == 1 ? mu.pos0[1] : mu.pos0[2]); u.n = (i == 0) ? mu.n[0] : (i == 1 ? mu.n[1] : mu.n[2]);
        return true;
    }
    __device__ __forceinline__ const char* a_base(const Unit&) const { return A; }
    __device__ __forceinline__ const char* b_base(const Unit& u) const { return Bt + (size_t)u.e * bstride + (size_t)u.pn * BM * ldb * 2; }
    __device__ __forceinline__ unsigned a_raw(const Unit& u, int h, int R) const {
        if (GATHER_) { int pos = u.pos0 + h * HALF + R; pos = pos < u.n ? pos : u.n - 1;
            unsigned v; const int* p = list_tok + u.e * CAP + pos; asm volatile("global_load_dword %0, %1, off" : "=v"(v) : "v"(p) : "memory"); return v; }
        return (unsigned)(u.pm * BM + h * HALF + R);
    }
    __device__ __forceinline__ unsigned a_conv(unsigned raw, int C) const {
        if (GATHER_) { unsigned o; const unsigned c2 = (unsigned)C * 2u; asm volatile("v_mad_u32_u24 %0, %1, %2, %3" : "=v"(o) : "v"(raw), "v"((unsigned)lda * 2u), "v"(c2)); return o; }
        return (raw * (unsigned)lda + (unsigned)C) * 2u;
    }
};
}

struct EpiProj {
    static constexpr bool PERM = true;
    bf16* QK; bf16* VA; bf16* QB; bf16* KB; bf16* VB; bf16* GATES;
    const float *aq, *ak, *bq, *bk;
    __device__ __forceinline__ bool keep(const pg8::Unit&) const { return false; }
    __device__ __forceinline__ void operator()(f32x4 (&acc)[2][2][4][2], const pg8::Unit& u, int wr, int wc, int fr, int fq) const {
        const int pn = u.pn; int mode, ld, colbase; bf16* dst; const float* gain = nullptr; float scale = 1.f;
        if (pn < 4) { mode = 1; dst = QK + (size_t)pn * T * 256; ld = 256; colbase = 0; gain = pn < 2 ? aq : ak; scale = pn < 2 ? C2 : 1.f; }
        else if (pn < 6) { mode = 0; dst = VA; ld = 512; colbase = (pn - 4) * 256; }
        else if (pn < 8) { mode = 1; dst = QB; ld = 512; colbase = (pn - 6) * 256; gain = bq; scale = C2; }
        else if (pn < 10) { mode = 1; dst = KB; ld = 512; colbase = (pn - 8) * 256; gain = bk; }
        else if (pn < 12) { mode = 0; dst = VB; ld = 512; colbase = (pn - 10) * 256; }
        else { mode = 2; dst = GATES; ld = 2048; colbase = (pn - 12) * 256; }
        const int row0 = u.pm * 256 + wr * 64 + fr;
        float g[2][8];
        if (mode == 1) {
#pragma unroll
            for (int bj = 0; bj < 2; ++bj) { const f32x4 a = *(const f32x4*)(gain + 32 * bj + 8 * fq), b = *(const f32x4*)(gain + 32 * bj + 8 * fq + 4);
                g[bj][0] = a[0] * scale; g[bj][1] = a[1] * scale; g[bj][2] = a[2] * scale; g[bj][3] = a[3] * scale; g[bj][4] = b[0] * scale; g[bj][5] = b[1] * scale; g[bj][6] = b[2] * scale; g[bj][7] = b[3] * scale; }
        }
#pragma unroll
        for (int ai = 0; ai < 2; ++ai)
#pragma unroll
            for (int m = 0; m < 4; ++m) {
                float v[2][8];
#pragma unroll
                for (int bj = 0; bj < 2; ++bj)
#pragma unroll
                    for (int n = 0; n < 2; ++n)
#pragma unroll
                        for (int j = 0; j < 4; ++j) v[bj][4 * n + j] = acc[ai][bj][m][n][j];
                if (mode == 1) {
                    float ss = 0.f;
#pragma unroll
                    for (int bj = 0; bj < 2; ++bj)
#pragma unroll
                        for (int j = 0; j < 8; ++j) ss += v[bj][j] * v[bj][j];
                    ss += __shfl_xor(ss, 16); ss += __shfl_xor(ss, 32);
                    const float rs = __builtin_amdgcn_rsqf(ss * (1.f / 64.f) + EPS);
#pragma unroll
                    for (int bj = 0; bj < 2; ++bj)
#pragma unroll
                        for (int j = 0; j < 8; ++j) v[bj][j] = v[bj][j] * rs * g[bj][j];
                } else if (mode == 2) {
#pragma unroll
                    for (int bj = 0; bj < 2; ++bj)
#pragma unroll
                        for (int j = 0; j < 8; ++j) v[bj][j] = __builtin_amdgcn_rcpf(1.f + __builtin_amdgcn_exp2f(-LOG2E * v[bj][j]));
                }
                const int row = row0 + ai * 128 + m * 16;
                unsigned eo, es;
                { const unsigned bq = (unsigned)row >> 13, tile = ((unsigned)row & 8191u) >> 6, key = (unsigned)row & 63u;
                  if (pn == 2 || pn == 3) { eo = ((((bq * 4 + wc) * 128 + tile) * 8 + fq) * 64 + key) * 8; es = 4 * 64 * 8; }
                  else if (pn == 4 || pn == 5) { const unsigned head = (pn - 4) * 2 + (wc >> 1); eo = ((((bq * 4 + head) * 128 + tile) * 4 + 2 * (wc & 1)) * 64 + key) * 32 + 8 * fq; es = 64 * 32; }
                  else if (pn == 8 || pn == 9) { const unsigned head = (pn - 8) * 4 + wc; eo = ((((bq * 8 + head) * 128 + tile) * 8 + fq) * 64 + key) * 8; es = 4 * 64 * 8; }
                  else if (pn == 10 || pn == 11) { const unsigned head = (pn - 10) * 4 + wc; eo = ((((bq * 8 + head) * 128 + tile) * 2) * 64 + key) * 32 + 8 * fq; es = 64 * 32; }
                  else if (pn >= 12) { eo = ((((((unsigned)u.pm * 8 + (pn - 12)) * 2 + ai) * 4 + m) * 2) * 8 + (wr * 4 + wc)) * 512 + (fq * 16 + fr) * 8; es = 8 * 512; }
                  else { eo = (unsigned)row * (unsigned)ld + colbase + 64 * wc + 8 * fq; es = 32; } }
#pragma unroll
                for (int bj = 0; bj < 2; ++bj) { u32x4 w; w.x = cvt_pk_bf16(v[bj][0], v[bj][1]); w.y = cvt_pk_bf16(v[bj][2], v[bj][3]); w.z = cvt_pk_bf16(v[bj][4], v[bj][5]); w.w = cvt_pk_bf16(v[bj][6], v[bj][7]);
                    *(u32x4*)(dst + eo + bj * es) = w; }
            }
    }
};
struct EpiAB {
    static constexpr bool PERM = true;
    const bf16* __restrict__ GATES; bf16* __restrict__ MIXED; unsigned* ctr;
    __device__ __forceinline__ bool keep(const pg8::Unit& u) const { return u.part == 0; }
    __device__ __forceinline__ void operator()(f32x4 (&acc)[2][2][4][2], const pg8::Unit& u, int wr, int wc, int fr, int fq) const {
        const int row0 = u.pm * 256 + wr * 64 + fr, col0 = u.pn * 256 + wc * 32 + 8 * fq;
        const unsigned lo = (unsigned)((wr * 4 + wc) * 512 + (fq * 16 + fr) * 8);
        const GAS u32x4* gp = (const GAS u32x4*)(GATES + ((size_t)((u.pm * 8 + u.pn) * 2) * 4 * 2 * 8) * 512 + lo);
        constexpr int GSTR = 8 * 512 * 2 / 16, GB = 4 * 2 * 4 * 2 * GSTR;
        if (u.part == 0) {
#pragma unroll
            for (int g = 0; g < 8; g += 2) {
                u32x4 sa[2][2], sb[2][2];
#pragma unroll
                for (int gg = 0; gg < 2; ++gg)
#pragma unroll
                    for (int bj = 0; bj < 2; ++bj) { sa[gg][bj] = gp[((g + gg) * 2 + bj) * GSTR]; sb[gg][bj] = gp[((g + gg) * 2 + bj) * GSTR + GB]; }
#pragma unroll
                for (int gg = 0; gg < 2; ++gg)
#pragma unroll
                    for (int bj = 0; bj < 2; ++bj)
#pragma unroll
                        for (int q = 0; q < 4; ++q) { const int ai = (g + gg) >> 2, m = (g + gg) & 3, n = q >> 1, j = (q & 1) * 2;
                            const float sa0 = __uint_as_float(sa[gg][bj][q] << 16), sa1 = __uint_as_float(sa[gg][bj][q] & 0xffff0000u), sb0 = __uint_as_float(sb[gg][bj][q] << 16), sb1 = __uint_as_float(sb[gg][bj][q] & 0xffff0000u);
                            acc[ai][bj][m][n][j] *= sa0 * __builtin_amdgcn_rcpf(sb0); acc[ai][bj][m][n][j + 1] *= sa1 * __builtin_amdgcn_rcpf(sb1); }
            }
        } else {
            const __amdgpu_buffer_rsrc_t mrs = __builtin_amdgcn_make_buffer_rsrc(MIXED, 0, T * D * 2, 0x00020000);
#pragma unroll
            for (int g = 0; g < 8; g += 4) {
                u32x4 sb[4][2];
#pragma unroll
                for (int gg = 0; gg < 4; ++gg)
#pragma unroll
                    for (int bj = 0; bj < 2; ++bj) sb[gg][bj] = gp[((g + gg) * 2 + bj) * GSTR + GB];
#pragma unroll
                for (int gg = 0; gg < 4; ++gg) { const int ai = (g + gg) >> 2, m = (g + gg) & 3; bf16* rp = MIXED + (size_t)(row0 + ai * 128 + m * 16) * 1024 + col0;
#pragma unroll
                    for (int bj = 0; bj < 2; ++bj) { u32x4 w;
#pragma unroll
                        for (int q = 0; q < 4; ++q) { const int n = q >> 1, j = (q & 1) * 2;
                            w[q] = cvt_pk_bf16(acc[ai][bj][m][n][j] * __uint_as_float(sb[gg][bj][q] << 16), acc[ai][bj][m][n][j + 1] * __uint_as_float(sb[gg][bj][q] & 0xffff0000u)); }
                        __builtin_amdgcn_raw_buffer_store_b128(w, mrs, (unsigned)((size_t)(rp + bj * 128 - MIXED) * 2), 0, 16); } }
            }
            asm volatile("s_waitcnt vmcnt(0)" ::: "memory");
            if ((threadIdx.x & 63) == 0) __hip_atomic_fetch_add(ctr + 64 * u.pm, 1u, __ATOMIC_RELAXED, __HIP_MEMORY_SCOPE_AGENT);
        }
    }
};
struct EpiAO {
    static constexpr bool PERM = true;
    bf16* AO; unsigned* ctr;
    __device__ __forceinline__ bool keep(const pg8::Unit&) const { return false; }
    __device__ __forceinline__ void operator()(f32x4 (&acc)[2][2][4][2], const pg8::Unit& u, int wr, int wc, int fr, int fq) const {
        const int row0 = u.pm * 256 + wr * 64 + fr, col0 = u.pn * 256 + wc * 32 + 8 * fq;
        const __amdgpu_buffer_rsrc_t ars = __builtin_amdgcn_make_buffer_rsrc(AO, 0, T * D * 2, 0x00020000);
#pragma unroll
        for (int ai = 0; ai < 2; ++ai)
#pragma unroll
            for (int m = 0; m < 4; ++m) { const unsigned ro = (unsigned)((row0 + ai * 128 + m * 16) * D + col0) * 2u;
#pragma unroll
                for (int bj = 0; bj < 2; ++bj) { u32x4 o; o.x = cvt_pk_bf16(acc[ai][bj][m][0][0], acc[ai][bj][m][0][1]); o.y = cvt_pk_bf16(acc[ai][bj][m][0][2], acc[ai][bj][m][0][3]);
                    o.z = cvt_pk_bf16(acc[ai][bj][m][1][0], acc[ai][bj][m][1][1]); o.w = cvt_pk_bf16(acc[ai][bj][m][1][2], acc[ai][bj][m][1][3]);
                    __builtin_amdgcn_raw_buffer_store_b128(o, ars, ro + bj * 256, 0, 16); } }
        asm volatile("s_waitcnt vmcnt(0)" ::: "memory");
        if ((threadIdx.x & 63) == 0) __hip_atomic_fetch_add(ctr + 64 * u.pm, 1u, __ATOMIC_RELAXED, __HIP_MEMORY_SCOPE_AGENT);
    }
};
struct EpiGU {
    static constexpr bool PERM = true;
    bf16* H; const float* list_r; unsigned* tilectr;
    __device__ __forceinline__ bool keep(const pg8::Unit&) const { return false; }
    __device__ __forceinline__ void operator()(f32x4 (&acc)[2][2][4][2], const pg8::Unit& u, int wr, int wc, int fr, int fq) const {
        const int r0 = wr * 64 + fr, col0 = u.pn * 128 + wc * 32 + 8 * fq;
        const __amdgpu_buffer_rsrc_t hrs = __builtin_amdgcn_make_buffer_rsrc(H, 0, MAXSLOT * DEXP * 2, 0x00020000);
        float rsv[8];
#pragma unroll
        for (int g = 0; g < 8; ++g) { const int r = r0 + (g >> 2) * 128 + (g & 3) * 16; int pos = u.pos0 + r; pos = pos < u.n ? pos : u.n - 1; rsv[g] = list_r[u.e * CAP + pos]; }
#pragma unroll
        for (int ai = 0; ai < 2; ++ai)
#pragma unroll
            for (int m = 0; m < 4; ++m) {
                const int r = r0 + ai * 128 + m * 16; const float rs = rsv[ai * 4 + m];
                float h[8];
#pragma unroll
                for (int n = 0; n < 2; ++n)
#pragma unroll
                    for (int j = 0; j < 4; ++j) { const float gt = acc[ai][0][m][n][j] * rs, up = acc[ai][1][m][n][j] * rs;
                        h[4 * n + j] = gt * __builtin_amdgcn_rcpf(1.f + __builtin_amdgcn_exp2f(-LOG2E * gt)) * up; }
                u32x4 w; w.x = cvt_pk_bf16(h[0], h[1]); w.y = cvt_pk_bf16(h[2], h[3]); w.z = cvt_pk_bf16(h[4], h[5]); w.w = cvt_pk_bf16(h[6], h[7]);
                __builtin_amdgcn_raw_buffer_store_b128(w, hrs, (unsigned)(((u.pm * 256 + r) * DEXP + col0) * 2), 0, 16);
            }
        asm volatile("s_waitcnt vmcnt(0)" ::: "memory");
        if ((threadIdx.x & 63) == 0) __hip_atomic_fetch_add(tilectr + 64 * u.pm, 1u, __ATOMIC_RELAXED, __HIP_MEMORY_SCOPE_AGENT);
    }
};
struct EpiDown {
    static constexpr bool PERM = true;
    bf16* Y; const float* list_w;
    __device__ __forceinline__ bool keep(const pg8::Unit&) const { return false; }
    __device__ __forceinline__ void operator()(f32x4 (&acc)[2][2][4][2], const pg8::Unit& u, int wr, int wc, int fr, int fq) const {
        const int r0 = wr * 64 + fr, col0 = u.pn * 256 + wc * 32 + 8 * fq;
        float wv[8];
#pragma unroll
        for (int g = 0; g < 8; ++g) { const int r = r0 + (g >> 2) * 128 + (g & 3) * 16; int pos = u.pos0 + r; pos = pos < u.n ? pos : u.n - 1; wv[g] = list_w[u.e * CAP + pos]; }
#pragma unroll
        for (int ai = 0; ai < 2; ++ai)
#pragma unroll
            for (int m = 0; m < 4; ++m) { const int r = r0 + ai * 128 + m * 16; const float w = wv[ai * 4 + m]; const int row = u.pm * 256 + r;
#pragma unroll
                for (int bj = 0; bj < 2; ++bj) { u32x4 o; o.x = cvt_pk_bf16(acc[ai][bj][m][0][0] * w, acc[ai][bj][m][0][1] * w); o.y = cvt_pk_bf16(acc[ai][bj][m][0][2] * w, acc[ai][bj][m][0][3] * w);
                    o.z = cvt_pk_bf16(acc[ai][bj][m][1][0] * w, acc[ai][bj][m][1][1] * w); o.w = cvt_pk_bf16(acc[ai][bj][m][1][2] * w, acc[ai][bj][m][1][3] * w);
                    *(u32x4*)(Y + (size_t)row * D + col0 + bj * 128) = o; } }
    }
};

namespace att {
__device__ __forceinline__ int crow(int r, int hi) { return (r & 3) + 8 * (r >> 2) + 4 * hi; }
__device__ __forceinline__ void glds16(const void* sbase_, unsigned voff, unsigned lds_dst) { unsigned keep;
    const unsigned long long a_ = (unsigned long long)(uintptr_t)sbase_;
    const unsigned long long sbase = ((unsigned long long)(unsigned)__builtin_amdgcn_readfirstlane((int)(a_ >> 32)) << 32) | (unsigned)__builtin_amdgcn_readfirstlane((int)a_);
    asm volatile("s_mov_b32 %0, m0\n\ts_mov_b32 m0, %3\n\ts_nop 0\n\tglobal_load_lds_dwordx4 %1, %2\n\ts_mov_b32 m0, %0" : "=&s"(keep) : "v"(voff), "s"(sbase), "s"(lds_dst) : "memory"); }
__device__ __forceinline__ void glds16p(const void* gsrc, unsigned lds_dst) { unsigned keep;
    asm volatile("s_mov_b32 %0, m0\n\ts_mov_b32 m0, %2\n\ts_nop 0\n\tglobal_load_lds_dwordx4 %1, off\n\ts_mov_b32 m0, %0" : "=&s"(keep) : "v"(gsrc), "s"(lds_dst) : "memory"); }
typedef LAS const char* lds_cptr;
typedef short v4i16_t __attribute__((ext_vector_type(4)));
typedef float f32x2_t __attribute__((ext_vector_type(2))); typedef __bf16 bf16x2_t __attribute__((ext_vector_type(2)));
__device__ __forceinline__ s16x4 vtr(lds_cptr p) { return __builtin_bit_cast(s16x4, __builtin_amdgcn_ds_read_tr16_b64_v4i16((LAS v4i16_t*)p)); }
__device__ __forceinline__ unsigned cvtpk(float lo, float hi) { f32x2_t v = {lo, hi}; bf16x2_t b = __builtin_convertvector(v, bf16x2_t); return __builtin_bit_cast(unsigned, b); }
#define ATT_WAIT_BAR(N) asm volatile("s_waitcnt vmcnt(" #N ") lgkmcnt(0)\n\ts_barrier" ::: "memory")
#define ATT_SB() __builtin_amdgcn_sched_barrier(0)
#define ATT_PIN(x) asm volatile("" : "+v"(x))
#define ATT_MFMA(a, b, c) __builtin_amdgcn_mfma_f32_32x32x16_bf16(a, b, c, 0, 0, 0)

constexpr int LDS_K = 0, LDS_V = 49152, LDS_TBL = 98304, LDS_WS = 99328, LDS_X = 0;

template <int NS, int DV, int QP, int VP> struct attn_dummy {};
template <int NS, int DV, int QP, int VP>
__device__ __forceinline__ void attn_unit_simple(const bf16* Q0, const bf16* Q1p, const bf16* K0, const bf16* K1p, const bf16* V, long rowbase, int q0,
                                          const float* tblg, const float* gsub, float lam, bf16* OUT  , char* shm) {
    constexpr int KSLOT = NS * 8192, VSLOT = DV * 128, ND = DV / 32, NVP = DV / 64;
    const int tid = threadIdx.x, lane = tid & 63, r32 = lane & 31, hi = lane >> 5; const int wid = __builtin_amdgcn_readfirstlane(tid >> 6);
    const int s = (NS == 2) ? (wid >> 2) : 0, j = (NS == 2) ? (wid & 3) : wid;
    const int ROWS = (NS == 2) ? 128 : 256;
    const int cw = (q0 + 32 * j) >> 6, qi = ((32 * j) & 63) + r32;
    const int t1 = (q0 + ROWS - 1) >> 6;
    int t0 = 0, lo_w = 0;
    if (NS == 1) { t0 = (q0 >> 6) - 8; if (t0 < 0) t0 = 0; lo_w = cw - 8; if (lo_w < 0) lo_w = 0; }
    const unsigned lds0 = (unsigned)(uintptr_t)shm;
    LAS float* tb = (LAS float*)((LAS char*)shm + LDS_TBL);
    LAS float* wsf = (LAS float*)((LAS char*)shm + LDS_WS) + wid * 64;
    if (tid < 256) tb[tid] = tblg[tid];
    const bf16* Qs = (s == 0) ? Q0 : Q1p;
    const bf16* Qw = Qs + (rowbase + q0 + 32 * j) * QP;
    const char* ksrc0 = (const char*)K0 + wid * 1024 + lane * 16;
    const char* ksrc1 = (NS == 2) ? (const char*)K1p + wid * 1024 + lane * 16 : nullptr;
    const char* vsrc = (const char*)V + lane * 16;
    const unsigned kdst = lds0 + LDS_K + wid * 1024, vdst = lds0 + LDS_V;
    bf16x8 qr[4];
#pragma unroll
    for (int d0 = 0; d0 < 4; ++d0) qr[d0] = *reinterpret_cast<const bf16x8*>(&Qw[(long)r32 * QP + d0 * 16 + hi * 8]);
#define ATT_DMA(t, sl) do { \
        glds16p(ksrc0 + (long)(t) * 8192, (unsigned)__builtin_amdgcn_readfirstlane(kdst + (sl) * KSLOT)); \
        if (NS == 2) glds16p(ksrc1 + (long)(t) * 8192, (unsigned)__builtin_amdgcn_readfirstlane(kdst + (sl) * KSLOT + 8192)); \
        _Pragma("unroll") for (int i_ = 0; i_ < NVP; ++i_) { const int p_ = wid + 8 * i_; \
            glds16p(vsrc + (long)(t) * (DV * 128) + p_ * 1024, (unsigned)__builtin_amdgcn_readfirstlane(vdst + (sl) * VSLOT + p_ * 1024)); } \
    } while (0)
    ATT_DMA(t0, 0);
    if (t0 + 1 <= t1) ATT_DMA(t0 + 1, 1);
    f32x16 o[ND];
#pragma unroll
    for (int d = 0; d < ND; ++d) o[d] = f32x16{};
    float l_reg = 0.f;
    LDS_WAIT();
    __builtin_amdgcn_s_barrier();
    asm volatile("" :: "v"(qr[0]), "v"(qr[1]), "v"(qr[2]), "v"(qr[3]));
    const float cfar = tb[255];
    f32x16 cinit;
#pragma unroll
    for (int r = 0; r < 16; ++r) cinit[r] = cfar;
    const lds_cptr shm3 = (lds_cptr)shm;
    const lds_cptr kp0 = shm3 + LDS_K + s * 8192 + hi * 1024 + r32 * 16;
    const lds_cptr vp0 = shm3 + LDS_V + ((lane >> 4) & 1) * 32 + (lane & 3) * 8 + (4 * hi + ((lane & 15) >> 2)) * 64;
    int sl = 0;
    for (int t = t0; t <= t1; ++t) {
        if (t < t1) { if (NS == 2) ATT_WAIT_BAR(4); else ATT_WAIT_BAR(2); } else ATT_WAIT_BAR(0);
        if (t + 2 <= t1) { const int s2 = (sl == 0) ? 2 : sl - 1; ATT_DMA(t + 2, s2); }
        if (t >= lo_w && t <= cw) {
            const lds_cptr kp = kp0 + sl * KSLOT; const lds_cptr vp = vp0 + sl * VSLOT;
            f32x16 p0, p1;
#pragma unroll
            for (int d0 = 0; d0 < 4; ++d0) {
                const bf16x8 b0 = *(const LAS bf16x8*)(kp + d0 * 2048), b1 = *(const LAS bf16x8*)(kp + d0 * 2048 + 512);
                if (d0 == 0) { p0 = __builtin_amdgcn_mfma_f32_32x32x16_bf16(b0, qr[0], cinit, 0, 0, 0); p1 = __builtin_amdgcn_mfma_f32_32x32x16_bf16(b1, qr[0], cinit, 0, 0, 0); }
                else { p0 = __builtin_amdgcn_mfma_f32_32x32x16_bf16(b0, qr[d0], p0, 0, 0, 0); p1 = __builtin_amdgcn_mfma_f32_32x32x16_bf16(b1, qr[d0], p1, 0, 0, 0); }
            }
            if (t >= cw - 2) {
                const LAS float* tp = tb + (64 * (t - cw) + 191 - qi + 4 * hi);
#pragma unroll
                for (int r = 0; r < 16; ++r) { p0[r] += tp[(r & 3) + 8 * (r >> 2)]; p1[r] += tp[32 + (r & 3) + 8 * (r >> 2)]; }
            }
            float sacc = 0.f;
#pragma unroll
            for (int r = 0; r < 16; ++r) { p0[r] = __builtin_amdgcn_exp2f(p0[r]); p1[r] = __builtin_amdgcn_exp2f(p1[r]); sacc += p0[r] + p1[r]; }
            l_reg += sacc;
            u32x4 pw[4];
#pragma unroll
            for (int q = 0; q < 4; ++q) { pw[0][q] = cvtpk(p0[2 * q], p0[2 * q + 1]); pw[1][q] = cvtpk(p0[8 + 2 * q], p0[9 + 2 * q]);
                pw[2][q] = cvtpk(p1[2 * q], p1[2 * q + 1]); pw[3][q] = cvtpk(p1[8 + 2 * q], p1[9 + 2 * q]); }
#pragma unroll
            for (int d0 = 0; d0 < ND; ++d0)
#pragma unroll
                for (int ks = 0; ks < 4; ++ks) {
                    const s16x4 vlo = vtr(vp + d0 * 4096 + ks * 1024), vhi = vtr(vp + d0 * 4096 + ks * 1024 + 512);
                    const bf16x8 vf = (bf16x8){vlo[0], vlo[1], vlo[2], vlo[3], vhi[0], vhi[1], vhi[2], vhi[3]};
                    o[d0] = __builtin_amdgcn_mfma_f32_32x32x16_bf16(__builtin_bit_cast(bf16x8, pw[ks]), vf, o[d0], 0, 0, 0);
                }
        }
        sl = (sl == 2) ? 0 : sl + 1;
    }
#undef ATT_DMA
    { auto rr = __builtin_amdgcn_permlane32_swap(__float_as_uint(l_reg), __float_as_uint(l_reg), false, false); l_reg = __uint_as_float(rr[0]) + __uint_as_float(rr[1]); }
    if (hi == 0) wsf[r32] = l_reg;
    LDS_WAIT();
    float rli[16];
#pragma unroll
    for (int r = 0; r < 16; ++r) rli[r] = __builtin_amdgcn_rcpf(wsf[crow(r, hi)]);
    const long orow0 = rowbase + q0 + 32 * j;
    if (NS == 2) {
        LAS float* X = (LAS float*)((LAS char*)shm + LDS_X);
        asm volatile("s_waitcnt lgkmcnt(0)\n\ts_barrier" ::: "memory");
        if (s == 1) {
#pragma unroll
            for (int d0 = 0; d0 < ND; ++d0)
#pragma unroll
                for (int r = 0; r < 16; ++r) X[((j * ND + d0) * 16 + r) * 64 + lane] = lam * o[d0][r] * rli[r];
        }
        asm volatile("s_waitcnt lgkmcnt(0)\n\ts_barrier" ::: "memory");
        if (s == 0) {
            float gs[ND];
#pragma unroll
            for (int d0 = 0; d0 < ND; ++d0) gs[d0] = gsub[32 * d0 + r32] * 0.8f;
#pragma unroll
            for (int r = 0; r < 16; ++r) {
                float ss = 0.f;
#pragma unroll
                for (int d0 = 0; d0 < ND; ++d0) { o[d0][r] = o[d0][r] * rli[r] - X[((j * ND + d0) * 16 + r) * 64 + lane]; ss += o[d0][r] * o[d0][r]; }
#pragma unroll
                for (int m = 1; m < 32; m <<= 1) ss += __shfl_xor(ss, m);
                const float rs = __builtin_amdgcn_rsqf(ss * (1.f / DV) + EPS);
                bf16* op = OUT + (orow0 + crow(r, hi)) * 1024 + r32;
#pragma unroll
                for (int d0 = 0; d0 < ND; ++d0) op[32 * d0] = (bf16)(cvtpk(o[d0][r] * rs * gs[d0], 0.f) & 0xffffu);
            }
        }
    } else {
#pragma unroll
        for (int r = 0; r < 16; ++r) {
            bf16* op = OUT + (orow0 + crow(r, hi)) * 1024 + r32;
#pragma unroll
            for (int d0 = 0; d0 < ND; ++d0) op[32 * d0] = (bf16)(cvtpk(o[d0][r] * rli[r], 0.f) & 0xffffu);
        }
    }
    asm volatile("s_waitcnt vmcnt(0) lgkmcnt(0)\n\ts_barrier" ::: "memory");
}


constexpr int LDS_CONV = 101376, CONV_PITCH = 1040, CONV_BUF = 8 * CONV_PITCH, CONV_N = 96;
struct ConvState { int jd, jc, bd, bc, sgu, sd, dgu, dd; unsigned long long wg, d1, d2, WGUT, WDT; };
__device__ __forceinline__ void conv_init(ConvState& cv, int c, int wid, const float* wg, const float* wu, const float* wd, bf16* WGUT, bf16* WDT) {
    cv.jd = 0; cv.jc = 0; cv.bd = 0; cv.bc = 0; cv.wg = (unsigned long long)(uintptr_t)wg; cv.d1 = (unsigned long long)(uintptr_t)wu - cv.wg; cv.d2 = (unsigned long long)(uintptr_t)wd - (unsigned long long)(uintptr_t)wu;
    cv.WGUT = (unsigned long long)(uintptr_t)WGUT; cv.WDT = (unsigned long long)(uintptr_t)WDT;
    cv.sgu = (64 * (c >> 4) + 8 * wid) * 512 + 32 * (c & 15); cv.sd = (64 * (c >> 5) + 8 * wid) * 1024 + 32 * (c & 31);
    { const int n0 = 32 * (c & 15); cv.dgu = ((n0 >> 7) * 256 + (n0 & 127)) * 1024 + 64 * (c >> 4); } cv.dd = (32 * (c & 31)) * 512 + 64 * (c >> 5);
}
__device__ __forceinline__ void conv_dma(ConvState& cv, int wid, int lane, unsigned lds0) {
    const int j = cv.jd; const bool gu = j < 64;
    unsigned long long a = cv.wg + ((unsigned long long)(j & 31) * 524288ull + (unsigned long long)(gu ? cv.sgu : cv.sd)) * 4ull;
    a += (j >= 32) ? cv.d1 : 0ull; a += (j >= 64) ? cv.d2 : 0ull;
    glds16((const void*)(uintptr_t)a, (unsigned)((lane >> 3) * (gu ? 2048 : 4096) + (lane & 7) * 16), (unsigned)__builtin_amdgcn_readfirstlane(lds0 + LDS_CONV + cv.bd + wid * CONV_PITCH));
    cv.jd = j + 1; cv.bd = (cv.bd == 2 * CONV_BUF) ? 0 : cv.bd + CONV_BUF;
}
__device__ __forceinline__ void conv_convert(ConvState& cv, bool mine, int wsel, int lane, char* shm) {
    const int j = cv.jc;
    if (mine) {
        const bool gu = j < 64;
        const int nl = 8 * wsel + (lane >> 3), kc = lane & 7;
        const LAS char* p = (const LAS char*)shm + LDS_CONV + cv.bc + kc * CONV_PITCH + (nl >> 2) * 16 + (nl & 3) * 4;
        float f[8];
#pragma unroll
        for (int i = 0; i < 8; ++i) f[i] = *(const LAS float*)(p + 128 * i);
        u32x4 o; o.x = cvtpk(f[0], f[1]); o.y = cvtpk(f[2], f[3]); o.z = cvtpk(f[4], f[5]); o.w = cvtpk(f[6], f[7]);
        const unsigned long long eoff = gu ? ((unsigned long long)(j & 31) * 1048576ull + (unsigned long long)(j >> 5) * 131072ull + (unsigned long long)cv.dgu) : ((unsigned long long)(j & 31) * 524288ull + (unsigned long long)cv.dd);
        const unsigned long long pa = (gu ? cv.WGUT : cv.WDT) + eoff * 2ull;
        *(GAS u32x4*)(uintptr_t)(pa + (unsigned long long)(nl * (gu ? 2048 : 1024) + kc * 16)) = o;
    }
    cv.jc = j + 1; cv.bc = (cv.bc == 2 * CONV_BUF) ? 0 : cv.bc + CONV_BUF;
}
template <int NS, int DV, int QP, int VP>
__device__ __forceinline__ void attn_unit_pipe(const bf16* Q0, const bf16* Q1p, const bf16* K0, const bf16* K1p, const bf16* V, long rowbase, int q0,
                                          const float* tblg, const float* gsub, float lam, bf16* OUT  , char* shm, ConvState& cv) {
    constexpr int KSLOT = NS * 8192, VSLOT = DV * 128, ND = DV / 32, NVP = DV / 64, NG = 4 * ND, EPG = 32 / NG, CPG = EPG / 2, LAG = NG / 4;
    const int tid = threadIdx.x, lane = tid & 63, r32 = lane & 31, hi = lane >> 5; const int wid = __builtin_amdgcn_readfirstlane(tid >> 6);
    const int s = (NS == 2) ? (wid >> 2) : 0, j = (NS == 2) ? (wid & 3) : wid;
    const int ROWS = (NS == 2) ? 128 : 256;
    const int cw = (q0 + 32 * j) >> 6, qi = ((32 * j) & 63) + r32;
    const int t1 = (q0 + ROWS - 1) >> 6;
    int t0 = 0, lo_w = 0;
    if (NS == 1) { t0 = (q0 >> 6) - 8; if (t0 < 0) t0 = 0; lo_w = cw - 8; if (lo_w < 0) lo_w = 0; }
    const unsigned lds0 = (unsigned)(uintptr_t)shm;
    LAS float* tb = (LAS float*)((LAS char*)shm + LDS_TBL);
    LAS float* wsf = (LAS float*)((LAS char*)shm + LDS_WS) + wid * 64;
    if (tid < 256) tb[tid] = tblg[tid];
    const bf16* Qs = (s == 0) ? Q0 : Q1p;
    const bf16* Qw = Qs + (rowbase + q0 + 32 * j) * QP;
    const unsigned koff = (unsigned)(wid * 1024 + lane * 16);
    unsigned voffv[NVP];
#pragma unroll
    for (int i_ = 0; i_ < NVP; ++i_) voffv[i_] = (unsigned)((wid + 8 * i_) * 1024 + lane * 16);
    const char* kb0 = (const char*)K0; const char* kb1 = (const char*)K1p; const char* vb = (const char*)V;
    const unsigned kdst = lds0 + LDS_K + wid * 1024, vdst = lds0 + LDS_V;
    bf16x8 qr[4];
#pragma unroll
    for (int d0 = 0; d0 < 4; ++d0) qr[d0] = *reinterpret_cast<const bf16x8*>(&Qw[(long)r32 * QP + d0 * 16 + hi * 8]);
#define ATT_DMA_K(t, sl) do { \
        glds16(kb0 + (long)(t) * 8192, koff, (unsigned)__builtin_amdgcn_readfirstlane(kdst + (sl) * KSLOT)); \
        if (NS == 2) glds16(kb1 + (long)(t) * 8192, koff, (unsigned)__builtin_amdgcn_readfirstlane(kdst + (sl) * KSLOT + 8192)); } while (0)
#define ATT_DMA_V(t, sl) do { \
        _Pragma("unroll") for (int i_ = 0; i_ < NVP; ++i_) { const int p_ = wid + 8 * i_; \
            glds16(vb + (long)(t) * (DV * 128), voffv[i_], (unsigned)__builtin_amdgcn_readfirstlane(vdst + (sl) * VSLOT + p_ * 1024)); } } while (0)
    ATT_DMA_K(t0, 0); ATT_DMA_V(t0, 0);
    if (t0 + 1 <= t1) ATT_DMA_K(t0 + 1, 1);
    if (t0 + 2 <= t1) ATT_DMA_K(t0 + 2, 2);
    f32x16 o[ND];
#pragma unroll
    for (int d = 0; d < ND; ++d) o[d] = f32x16{};
    float l_reg = 0.f;
    ATT_WAIT_BAR(0);
    asm volatile("" :: "v"(qr[0]), "v"(qr[1]), "v"(qr[2]), "v"(qr[3]));
    const lds_cptr shm3 = (lds_cptr)shm;
    const lds_cptr kp0 = shm3 + LDS_K + s * 8192 + hi * 1024 + r32 * 16;
    const lds_cptr vp0 = shm3 + LDS_V + ((lane >> 4) & 1) * 32 + (lane & 3) * 8 + (4 * hi + ((lane & 15) >> 2)) * 64;
    bf16x8 kf[8];
#define ATT_KRD(i, kp) do { kf[i] = *(const LAS bf16x8*)((kp) + ((i) >> 1) * 2048 + ((i) & 1) * 512); } while (0)
#pragma unroll
    for (int i = 0; i < 8; ++i) ATT_KRD(i, kp0);
    ATT_WAIT_BAR(0);
    f32x16 S0, S1;
    const f32x16 z16 = f32x16{};
    u32x4 pw[4];
#define ATT_VRD(g) do { vlo[g] = vtr(vp + ((g) % ND) * 4096 + ((g) / ND) * 1024); vhi[g] = vtr(vp + ((g) % ND) * 4096 + ((g) / ND) * 1024 + 512); } while (0)
#define ATT_VF(g) (bf16x8){vlo[g][0], vlo[g][1], vlo[g][2], vlo[g][3], vhi[g][0], vhi[g][1], vhi[g][2], vhi[g][3]}
#define ATT_NEAR(t) do { if ((t) >= cw - 2) { const LAS float* tp = tb + (64 * ((t) - cw) + 191 - qi + 4 * hi); \
            _Pragma("unroll") for (int r = 0; r < 16; ++r) { S0[r] += tp[(r & 3) + 8 * (r >> 2)]; S1[r] += tp[32 + (r & 3) + 8 * (r >> 2)]; } } } while (0)
#define ATT_ENDW(t) do { if ((t) + 3 <= t1) { ATT_WAIT_BAR(4); } else if ((t) + 1 <= t1) { ATT_WAIT_BAR(2); } else { ATT_WAIT_BAR(0); } } while (0)
    static_assert(NS == 2 && DV == 128, "pipelined unit: differential attention only");
    { const int tk_ = (t0 + 3 <= t1) ? t0 + 3 : t1, tv_ = (t0 + 1 <= t1) ? t0 + 1 : t1; ATT_DMA_K(tk_, 0); ATT_DMA_V(tv_, 1); }
    {
        S0 = ATT_MFMA(kf[0], qr[0], z16); S1 = ATT_MFMA(kf[1], qr[0], z16);
#pragma unroll
        for (int d0 = 1; d0 < 4; ++d0) { S0 = ATT_MFMA(kf[2 * d0], qr[d0], S0); S1 = ATT_MFMA(kf[2 * d0 + 1], qr[d0], S1); }
        ATT_NEAR(t0);
#pragma unroll
        for (int r = 0; r < 16; ++r) { S0[r] = __builtin_amdgcn_exp2f(S0[r]); S1[r] = __builtin_amdgcn_exp2f(S1[r]); l_reg += S0[r] + S1[r]; }
#pragma unroll
        for (int q = 0; q < 4; ++q) { pw[0][q] = cvtpk(S0[2 * q], S0[2 * q + 1]); pw[1][q] = cvtpk(S0[8 + 2 * q], S0[9 + 2 * q]); pw[2][q] = cvtpk(S1[2 * q], S1[2 * q + 1]); pw[3][q] = 0u; }
        const lds_cptr kpn = kp0 + 1 * KSLOT;
#pragma unroll
        for (int i = 0; i < 8; ++i) ATT_KRD(i, kpn);
    }
    ATT_WAIT_BAR(4);
    int sl = 1;
    for (int t = t0 + 1; t <= t1 + 1; ++t) {
        const int slp = (sl == 0) ? 2 : sl - 1, sln = (sl == 2) ? 0 : sl + 1;
        if (cv.jc < CONV_N && cv.jc + 2 <= cv.jd) conv_convert(cv, (wid >> 2) == (cv.jc & 1), wid & 3, lane, shm);
        { const int tk = (t + 3 <= t1) ? t + 3 : t1, tv = (t + 1 <= t1) ? t + 1 : t1; ATT_DMA_K(tk, sl); ATT_DMA_V(tv, sln); }
        const bool cd = cv.jd < CONV_N;
        if (cd) conv_dma(cv, wid, lane, lds0); else if (cv.jd < CONV_N + 2) cv.jd += 1;
        if (t - 1 <= cw) {
            const lds_cptr vp = vp0 + slp * VSLOT;
            const lds_cptr kpn = kp0 + sln * KSLOT;
            const float l_keep = l_reg;
            s16x4 vlo[NG], vhi[NG];
            ATT_SB();
            {   const f32x16 So = S1;
                S0 = ATT_MFMA(kf[0], qr[0], z16);
                pw[3][0] = cvtpk(So[8], So[9]); pw[3][1] = cvtpk(So[10], So[11]); pw[3][2] = cvtpk(So[12], So[13]); pw[3][3] = cvtpk(So[14], So[15]); ATT_PIN(pw[3]); ATT_SB(); }
            S1 = ATT_MFMA(kf[1], qr[0], z16); ATT_SB();
            S0 = ATT_MFMA(kf[2], qr[1], S0); ATT_SB();
            S1 = ATT_MFMA(kf[3], qr[1], S1); ATT_SB();
            S0 = ATT_MFMA(kf[4], qr[2], S0); ATT_SB();
            S1 = ATT_MFMA(kf[5], qr[2], S1); ATT_VRD(0); ATT_SB();
            S0 = ATT_MFMA(kf[6], qr[3], S0); ATT_VRD(1); ATT_SB();
            S1 = ATT_MFMA(kf[7], qr[3], S1); ATT_SB();
            if (t <= cw) ATT_NEAR(t);
            ATT_SB();
#pragma unroll
            for (int g = 0; g < NG; ++g) {
                o[g % ND] = ATT_MFMA(__builtin_bit_cast(bf16x8, pw[g / ND]), ATT_VF(g), o[g % ND]);
#pragma unroll
                for (int e = g * EPG; e < (g + 1) * EPG; ++e) { if (e < 16) { S0[e] = __builtin_amdgcn_exp2f(S0[e]); } else { S1[e - 16] = __builtin_amdgcn_exp2f(S1[e - 16]); } }
#pragma unroll
                for (int e = g * EPG; e < (g + 1) * EPG; ++e) { if (e < 16) l_reg += S0[e]; else l_reg += S1[e - 16]; }
                if (g >= LAG) {
#pragma unroll
                    for (int q = (g - LAG) * CPG; q < (g - LAG + 1) * CPG; ++q) { if (q < 8) pw[q >> 2][q & 3] = cvtpk(S0[2 * q], S0[2 * q + 1]); else pw[q >> 2][q & 3] = cvtpk(S1[2 * q - 16], S1[2 * q - 15]); }
                }
                if (g + 2 < NG) ATT_VRD(g + 2);
                if (g >= 2 && g < 10) ATT_KRD(g - 2, kpn);
                ATT_PIN(S0); ATT_PIN(S1); ATT_PIN(l_reg);
                if (g >= LAG) { ATT_PIN(pw[(((g - LAG) * CPG) >> 2)]); }
                ATT_SB();
            }
            if (t > cw) l_reg = l_keep;
        }
        if (cd) { ATT_WAIT_BAR(5); } else { ATT_WAIT_BAR(4); }
        sl = sln;
    }
#undef ATT_ENDW
    ATT_WAIT_BAR(0);
#undef ATT_DMA_K
#undef ATT_DMA_V
#undef ATT_VRD
#undef ATT_VF
#undef ATT_NEAR
#undef ATT_KRD
    { auto rr = __builtin_amdgcn_permlane32_swap(__float_as_uint(l_reg), __float_as_uint(l_reg), false, false); l_reg = __uint_as_float(rr[0]) + __uint_as_float(rr[1]); }
    if (hi == 0) wsf[r32] = l_reg;
    LDS_WAIT();
    float rli[16];
#pragma unroll
    for (int r = 0; r < 16; ++r) rli[r] = __builtin_amdgcn_rcpf(wsf[crow(r, hi)]);
    int lane_e = lane; asm volatile("" : "+v"(lane_e));
    const int r32e = lane_e & 31, hie = lane_e >> 5;
    bf16* obase = OUT + (rowbase + q0 + 32 * j + 4 * hie) * 1024 + r32e;
    if (NS == 2) {
        LAS float* X = (LAS float*)((LAS char*)shm + LDS_X);
        if (s == 1) {
#pragma unroll
            for (int d0 = 0; d0 < ND; ++d0)
#pragma unroll
                for (int r = 0; r < 16; ++r) X[((j * ND + d0) * 16 + r) * 64 + lane_e] = lam * o[d0][r] * rli[r];
        }
        asm volatile("s_waitcnt lgkmcnt(0)\n\ts_barrier" ::: "memory");
        if (s == 0) {
            float gs[ND];
#pragma unroll
            for (int d0 = 0; d0 < ND; ++d0) gs[d0] = gsub[32 * d0 + r32e] * 0.8f;
#pragma unroll
            for (int r = 0; r < 16; ++r) {
                float ss = 0.f;
#pragma unroll
                for (int d0 = 0; d0 < ND; ++d0) { o[d0][r] = o[d0][r] * rli[r] - X[((j * ND + d0) * 16 + r) * 64 + lane_e]; ss += o[d0][r] * o[d0][r]; }
#pragma unroll
                for (int m = 1; m < 32; m <<= 1) ss += __shfl_xor(ss, m);
                const float rs = __builtin_amdgcn_rsqf(ss * (1.f / DV) + EPS);
                bf16* op = obase + ((r & 3) + 8 * (r >> 2)) * 1024;
#pragma unroll
                for (int d0 = 0; d0 < ND; ++d0) op[32 * d0] = (bf16)(cvtpk(o[d0][r] * rs * gs[d0], 0.f) & 0xffffu);
            }
        }
    } else {
#pragma unroll
        for (int r = 0; r < 16; ++r) {
            bf16* op = obase + ((r & 3) + 8 * (r >> 2)) * 1024;
#pragma unroll
            for (int d0 = 0; d0 < ND; ++d0) op[32 * d0] = (bf16)(cvtpk(o[d0][r] * rli[r], 0.f) & 0xffffu);
        }
    }
    asm volatile("s_waitcnt vmcnt(0) lgkmcnt(0)\n\ts_barrier" ::: "memory");
}
}

__device__ __forceinline__ unsigned f2bf(float f) { unsigned u = __builtin_bit_cast(unsigned, f); return (u + 0x7fffu + ((u >> 16) & 1u)) >> 16; }
__device__ __forceinline__ unsigned pk2(float lo, float hi) { return f2bf(lo) | (f2bf(hi) << 16); }
struct TrItem { const GAS f32x4* src; GAS u32x4* d; int ls, ds; };
__device__ __forceinline__ TrItem tr_item(const float* W, int ldw, int k0, int n0, bf16* dst, int ldd, int drow0, int kd0, int lane) {
    const int kc = lane >> 3, nq = lane & 7; TrItem t;
    t.src = (const GAS f32x4*)(W + (size_t)(k0 + 8 * kc) * ldw + n0 + 4 * nq); t.ls = ldw / 4;
    t.d = (GAS u32x4*)(dst + (size_t)(drow0 + 4 * nq) * ldd + kd0 + 8 * kc); t.ds = ldd / 8; return t;
}
__device__ __forceinline__ void tr_load(const TrItem& t, f32x4 (&v)[8]) {
#pragma unroll
    for (int i = 0; i < 8; ++i) v[i] = t.src[(size_t)i * t.ls];
}
__device__ __forceinline__ void tr_store(const TrItem& t, const f32x4 (&v)[8]) {
#pragma unroll
    for (int j = 0; j < 4; ++j) { u32x4 o; o.x = cvt_pk_bf16(v[0][j], v[1][j]); o.y = cvt_pk_bf16(v[2][j], v[3][j]); o.z = cvt_pk_bf16(v[4][j], v[5][j]); o.w = cvt_pk_bf16(v[6][j], v[7][j]);
        t.d[(size_t)j * t.ds] = o; }
}
__device__ __forceinline__ int t5_bucket(int rel) {
    const int side = rel > 0 ? 16 : 0; const int n = rel < 0 ? -rel : rel;
    int b;
    if (n < 8) b = n; else if (n < 12) b = 8; else if (n < 16) b = 9; else if (n < 23) b = 10; else if (n < 32) b = 11; else if (n < 46) b = 12; else if (n < 64) b = 13; else if (n < 91) b = 14; else b = 15;
    return side + b;
}

struct Args { const float* in[22]; float* out; unsigned char* ws; int ph_lo, ph_hi; };

__global__ void __launch_bounds__(512, 2) mk_fwd(Args args) {
    extern __shared__ __attribute__((aligned(16))) unsigned char lds_raw[];
    LAS unsigned char* lds = (LAS unsigned char*)lds_raw;
    volatile LAS unsigned* MISC = (volatile LAS unsigned*)(lds + MISC_OFF);
    const int tid = threadIdx.x, lane = tid & 63, wave = __builtin_amdgcn_readfirstlane(tid >> 6);
    const int G = gridDim.x; const int bx = blockIdx.x; const int vcu = (G % 8 == 0) ? (bx % 8) * (G / 8) + bx / 8 : bx;
    unsigned char* ws = args.ws;
    unsigned* ctl = (unsigned*)(ws + WS_CTL);
    for (int u = tid; u < 64; u += 512) ((LAS unsigned*)(lds + MISC_OFF))[u] = 0u;
    __syncthreads();
    XcdBarrier bar; bar.bar = ctl + CW_BAR; bar.x = 0; bar.st = nullptr;
    if (MK_N_LAUNCHES == 1) bar = xcd_barrier_post(ctl + CW_BAR, MISC + 8);
    const int lo = args.ph_lo, hi = args.ph_hi;
    unsigned long long ts_a = 0, ts_b = 0;
#define IN(k) (lo <= (k) && (k) < hi)
#define SEAM(k) do { if (MK_N_LAUNCHES == 1 && IN(k) && IN((k) + 1)) xcd_barrier(bar); } while (0)

    const float* x = args.in[0];
    float* out = args.out;
    bf16* WINT = (bf16*)(ws + WS_WINT); bf16* WABT = (bf16*)(ws + WS_WABT); bf16* WOT = (bf16*)(ws + WS_WOT); bf16* WGUT = (bf16*)(ws + WS_WGUT); bf16* WDT = (bf16*)(ws + WS_WDT);
    bf16* XB = (bf16*)(ws + WS_XB); bf16* OAB = (bf16*)(ws + WS_OAB); bf16* QK = (bf16*)(ws + WS_QK); bf16* MIXED = (bf16*)(ws + WS_MIXED);
    bf16* VA = (bf16*)(ws + WS_VA); bf16* QBb = (bf16*)(ws + WS_QB); bf16* KBb = (bf16*)(ws + WS_KB); bf16* VBb = (bf16*)(ws + WS_VB);
    bf16* HN = (bf16*)out;
    bf16* HB = (bf16*)(ws + WS_H); bf16* YB = (bf16*)(ws + WS_Y); bf16* AO = (bf16*)(ws + WS_AO);
    bf16* GATES = (bf16*)out;
    float* TBLA = (float*)(ws + WS_TBLA); float* TBLB = (float*)(ws + WS_TBLB); float* LAMV = (float*)(ws + WS_LAM);
    bf16* WRH = (bf16*)(ws + WS_WR); bf16* WRL = WRH + 48 * 1024; float* LISTR = (float*)(ws + WS_LISTR);
    int* TOKPOS = (int*)(ws + WS_TOKPOS); int* LISTTOK = (int*)(ws + WS_LISTTOK); float* LISTW = (float*)(ws + WS_LISTW); unsigned* CURSOR = ctl + CW_CURSOR;

    if (TS_PHASE == 0) ts_a = __builtin_amdgcn_s_memrealtime();
    if (IN(0)) for (int rep = 0; rep < REP0; ++rep) {
        const int gw = vcu * 8 + wave, NGW = G * 8;
        constexpr int I_IN = 16 * 160, I_A = 8 * 32, I_B = 8 * 32, I_O = 16 * 32;
        constexpr int NITEMS = I_IN + I_A + I_B + I_O;
        static_assert(I_IN % 2 == 0 && I_A % 2 == 0 && I_B % 2 == 0 && I_O % 2 == 0, "batches of 2 items never straddle two matrices");
        for (int bt = gw; bt < NITEMS / 2; bt += NGW) {
            TrItem ti[2];
#pragma unroll
            for (int u = 0; u < 2; ++u) {
                int r = bt * 2 + u;
                if (r < I_IN) { const int kb = r / 160, nb = r % 160, n0 = 32 * nb, pn = n0 >> 8, cg = (n0 & 255) >> 5, wcc = cg >> 1, bjj = cg & 1;
                    ti[u] = tr_item(args.in[2], PROJ, 64 * kb, n0, WINT, 1024, pn * 256 + (pn >= 12 ? 32 * cg : 128 * bjj + 32 * wcc), 64 * kb, lane); }
                else if ((r -= I_IN) < I_A) { const int kb = r / 32, nb = r % 32; ti[u] = tr_item(args.in[11], 1024, 64 * kb, 32 * nb, WABT, 1024, 32 * nb, 64 * kb, lane); }
                else if ((r -= I_A) < I_B) { const int kb = r / 32, nb = r % 32; ti[u] = tr_item(args.in[12], 1024, 64 * kb, 32 * nb, WABT, 1024, 32 * nb, 512 + 64 * kb, lane); }
                else { r -= I_B; const int kb = r / 32, nb = r % 32; ti[u] = tr_item(args.in[13], 1024, 64 * kb, 32 * nb, WOT, 1024, 32 * nb, 64 * kb, lane); }
            }
            f32x4 v[2][8];
#pragma unroll
            for (int u = 0; u < 2; ++u) tr_load(ti[u], v[u]);
#pragma unroll
            for (int u = 0; u < 2; ++u) tr_store(ti[u], v[u]);
        }
        {   const GAS f32x4* gr = (const GAS f32x4*)args.in[1] + lane; f32x4 gg[4];
#pragma unroll
            for (int j = 0; j < 4; ++j) gg[j] = gr[64 * j];
            for (int m0 = gw * 4; m0 < T; m0 += NGW * 4) {
                f32x4 v[4][4];
#pragma unroll
                for (int u = 0; u < 4; ++u) { const GAS f32x4* xr = (const GAS f32x4*)(x + (size_t)(m0 + u) * D) + lane;
#pragma unroll
                    for (int j = 0; j < 4; ++j) v[u][j] = xr[64 * j]; }
#pragma unroll
                for (int u = 0; u < 4; ++u) { float ssq = 0.f;
#pragma unroll
                    for (int j = 0; j < 4; ++j) ssq += (v[u][j].x * v[u][j].x + v[u][j].y * v[u][j].y) + (v[u][j].z * v[u][j].z + v[u][j].w * v[u][j].w);
                    const float rstd = __builtin_amdgcn_rsqf(wave_sum(ssq) * (1.f / D) + EPS);
                    GAS u32x2* o8 = (GAS u32x2*)(XB + (size_t)(m0 + u) * D) + lane;
#pragma unroll
                    for (int j = 0; j < 4; ++j) { u32x2 w; w.x = cvt_pk_bf16(v[u][j].x * rstd * gg[j].x, v[u][j].y * rstd * gg[j].y); w.y = cvt_pk_bf16(v[u][j].z * rstd * gg[j].z, v[u][j].w * rstd * gg[j].w); o8[64 * j] = w; } }
            }
        }
        for (int idx = gw * 64 + lane; idx < 48 * 1024; idx += NGW * 64) { const int n = idx >> 10, k = idx & 1023; float w = 0.f;
            if (n < 32) w = args.in[17][k * 32 + n]; else if (n < 36) w = args.in[15][k * 4 + (n - 32)];
            w *= args.in[14][k]; const unsigned hb = cvt_pk_bf16(w, 0.f) & 0xffffu; WRH[idx] = (bf16)hb; WRL[idx] = (bf16)(cvt_pk_bf16(w - __uint_as_float(hb << 16), 0.f) & 0xffffu); }
        for (int idx = gw * 64 + lane; idx < 12 * 256; idx += NGW * 64) {
            const int hh = idx >> 8, i = idx & 255; const bool isA = hh < 4; const int h = isA ? hh : hh - 4;
            const float farv = isA ? args.in[7][15 * 4 + h] : args.in[10][0 * 8 + h];
            float v;
            if (i == 255) v = farv * LOG2E;
            else { const int rel = i - 191; float b;
                if (isA) b = args.in[7][t5_bucket(rel) * 4 + h];
                else { int ri = rel < -128 ? -128 : (rel > 128 ? 128 : rel); b = args.in[10][(ri + 128) * 8 + h]; }
                v = (b - farv) * LOG2E; }
            (isA ? TBLA : TBLB)[h * 256 + i] = v;
        }
        if (gw == 0) { const float* lp = args.in[5]; const float a = wave_sum(lp[lane] * lp[64 + lane]), b = wave_sum(lp[128 + lane] * lp[192 + lane]);
            if (lane == 0) LAMV[0] = expf(a) - expf(b) + 0.2f; }
    }
    SEAM(0);
    if (TS_PHASE == 0) ts_b = __builtin_amdgcn_s_memrealtime();

    if (TS_PHASE == 1 || (TS_PHASE >= 120 && TS_PHASE <= 129)) ts_a = __builtin_amdgcn_s_memrealtime();
    if (IN(1)) for (int rep = 0; rep < REP1; ++rep) {
        pg8::DenseSched S{(const char*)XB, (const char*)WINT, 1024, 1024, T / 256, PROJ / 256, G, bx, 1, 1024};
        EpiProj E{QK, VA, QBb, KBb, VBb, GATES, args.in[3], args.in[4], args.in[8], args.in[9]};
        pg8::gemm_phase<EpiProj, pg8::DenseSched, true>(lds, 1024, S, E);
    }
    SEAM(1);
    if (TS_PHASE >= 120 && TS_PHASE <= 129) ts_b = *(LAS unsigned long long*)(lds + MISC_OFF + 128);
    if (TS_PHASE == 1) ts_b = __builtin_amdgcn_s_memrealtime();

    if (TS_PHASE == 2) ts_a = __builtin_amdgcn_s_memrealtime();
    if (IN(2)) {
        const float lam = LAMV[0];
        att::ConvState cv; att::conv_init(cv, vcu, wave, args.in[19], args.in[20], args.in[21], WGUT, WDT);
        for (int i = 0; i < 2 * REP2A; ++i) {
            const int uidx = vcu; const int bh = uidx >> 5, sidx = uidx & 31; const int qb = ((i & 1) == 0) ? sidx : 63 - sidx;
            const int b = bh >> 2, h = bh & 3;
            if (vcu < 256)
            att::attn_unit_pipe<2, 128, 256, 512>(QK + h * 64, QK + (size_t)T * 256 + h * 64, QK + (size_t)2 * T * 256 + (size_t)(b * 4 + h) * 128 * 4096, QK + (size_t)3 * T * 256 + (size_t)(b * 4 + h) * 128 * 4096, VA + (size_t)(b * 4 + h) * 128 * 8192,
                                              (long)b * SEQ, qb * 128, TBLA + h * 256, args.in[6], lam, OAB + h * 128, (char*)lds_raw, cv);
        }
        while (cv.jc < att::CONV_N) {
            asm volatile("s_waitcnt vmcnt(0) lgkmcnt(0)\n\ts_barrier" ::: "memory");
            if (cv.jc + 2 <= cv.jd) att::conv_convert(cv, wave < 4, wave & 3, lane, (char*)lds_raw);
            if (cv.jd < att::CONV_N) att::conv_dma(cv, wave, lane, (unsigned)(uintptr_t)(char*)lds_raw); else if (cv.jd < att::CONV_N + 2) cv.jd += 1;
        }
        asm volatile("s_waitcnt vmcnt(0) lgkmcnt(0)\n\ts_barrier" ::: "memory");
        for (int i = 0; i < 2 * REP2B; ++i) {
            const int uidx = vcu * 2 + (i & 1); const int bh = uidx >> 5, grp = uidx & 31; const int b = bh >> 3, h = bh & 7;
            if (vcu < 256)
            att::attn_unit_simple<1, 64, 512, 512>(QBb + h * 64, nullptr, KBb + (size_t)(b * 8 + h) * 128 * 4096, nullptr, VBb + (size_t)(b * 8 + h) * 128 * 4096, (long)b * SEQ, grp * 256, TBLB + h * 256, nullptr, 0.f, OAB + 512 + h * 64, (char*)lds_raw);
        }
    }
    SEAM(2);
    if (TS_PHASE == 2) ts_b = __builtin_amdgcn_s_memrealtime();

    if (TS_PHASE == 3 || TS_PHASE == 107) ts_a = __builtin_amdgcn_s_memrealtime();
    if (IN(3)) for (int rep = 0; rep < REP3; ++rep) {
        pg8::DenseSched S{(const char*)OAB, (const char*)WABT, 1024, 1024, T / 256, D / 256, G, bx, 2, 512};
        EpiAB E{GATES, MIXED, ctl + CW_MIXCTR};
        pg8::gemm_phase<EpiAB, pg8::DenseSched, true>(lds, 512, S, E);
        if (TS_PHASE == 107) { __syncthreads(); ts_b = __builtin_amdgcn_s_memrealtime(); }
    }
    if (TS_PHASE == 3) ts_b = __builtin_amdgcn_s_memrealtime();

#define TILE_WAIT2(p0, p1) do { if (wave == 0) { unsigned* cps_[2] = {(p0), (p1)}; \
            _Pragma("unroll") for (int w_ = 0; w_ < 2; ++w_) { unsigned spins_ = 0; \
                while ((unsigned)__builtin_amdgcn_readfirstlane(__hip_atomic_load(cps_[w_], __ATOMIC_RELAXED, __HIP_MEMORY_SCOPE_AGENT)) < 32u) { __builtin_amdgcn_s_sleep(2); if (++spins_ > (1u << 22)) break; } } \
            __builtin_amdgcn_fence(__ATOMIC_ACQUIRE, "agent"); asm volatile("s_waitcnt vmcnt(0)" ::: "memory"); } \
        __syncthreads(); } while (0)
    if (TS_PHASE == 4 || TS_PHASE == 108) ts_a = __builtin_amdgcn_s_memrealtime();
    if (IN(4)) for (int rep = 0; rep < REP4; ++rep) {
        pg8::DenseSched S{(const char*)MIXED, (const char*)WOT, 1024, 1024, T / 256, D / 256, G, bx, 1, 1024};
        { pg8::Unit u0; if (S.next(0, u0)) { unsigned* cp = ctl + CW_MIXCTR + 64 * u0.pm; TILE_WAIT2(cp, cp); } else { __syncthreads(); } }
        EpiAO E{AO, ctl + CW_AOCTR};
        pg8::gemm_phase<EpiAO, pg8::DenseSched, true>(lds, 1024, S, E);
        if (TS_PHASE == 108) { __syncthreads(); ts_b = __builtin_amdgcn_s_memrealtime(); }
    }
    if (TS_PHASE == 4) ts_b = __builtin_amdgcn_s_memrealtime();

    if (TS_PHASE == 5 || TS_PHASE == 105 || TS_PHASE == 106) ts_a = __builtin_amdgcn_s_memrealtime();
    if (IN(5)) for (int rep = 0; rep < REP5; ++rep) {
        LAS float* LG = (LAS float*)lds;
        LAS float* SQ = LG + 2 * 64 * 48;
        LAS int* CNT = (LAS int*)(SQ + 128); LAS int* BASE = CNT + 32;
        if (tid < 32) CNT[tid] = 0;
        __syncthreads();
        for (int task = vcu; task < T / 64; task += G) {
            TILE_WAIT2(ctl + CW_AOCTR + 64 * (task >> 2), ctl + CW_MIXCTR + 64 * (task >> 3));
            {
                const int rl = lane & 15, q = lane >> 4, rb = (wave & 3) * 16, kh = wave >> 2; const int row = task * 64 + rb + rl;
                const float* xr = x + (size_t)row * D + 512 * kh + 8 * q; const bf16* aop = AO + (size_t)row * D + 512 * kh + 8 * q; const bf16* whp = WRH + (size_t)rl * 1024 + 512 * kh + 8 * q; const bf16* wlp = WRL + (size_t)rl * 1024 + 512 * kh + 8 * q;
                const float* g2p = args.in[14] + 512 * kh + 8 * q; bf16* hp = HN + (size_t)row * D + 512 * kh + 8 * q;
                f32x4 a0 = {0.f, 0.f, 0.f, 0.f}, a1 = a0, a2 = a0; float ssq = 0.f;
#pragma unroll 4
                for (int c = 0; c < 16; ++c) {
                    f32x4 x0 = *(const f32x4*)(xr + 32 * c), x1v = *(const f32x4*)(xr + 32 * c + 4);
                    { const u32x4 aw = *(const u32x4*)(aop + 32 * c);
                      x0[0] += __uint_as_float(aw.x << 16); x0[1] += __uint_as_float(aw.x & 0xffff0000u); x0[2] += __uint_as_float(aw.y << 16); x0[3] += __uint_as_float(aw.y & 0xffff0000u);
                      x1v[0] += __uint_as_float(aw.z << 16); x1v[1] += __uint_as_float(aw.z & 0xffff0000u); x1v[2] += __uint_as_float(aw.w << 16); x1v[3] += __uint_as_float(aw.w & 0xffff0000u); }
                    const f32x4 g0 = *(const f32x4*)(g2p + 32 * c), g1 = *(const f32x4*)(g2p + 32 * c + 4);
                    const bf16x8 h0 = *(const bf16x8*)(whp + 32 * c), h1 = *(const bf16x8*)(whp + 16 * 1024 + 32 * c), h2 = *(const bf16x8*)(whp + 32 * 1024 + 32 * c);
                    const bf16x8 l0 = *(const bf16x8*)(wlp + 32 * c), l1 = *(const bf16x8*)(wlp + 16 * 1024 + 32 * c), l2 = *(const bf16x8*)(wlp + 32 * 1024 + 32 * c);
                    u32x4 xh, xl;
                    { const float f[8] = {x0[0], x0[1], x0[2], x0[3], x1v[0], x1v[1], x1v[2], x1v[3]};
#pragma unroll
                      for (int p = 0; p < 4; ++p) { const unsigned hw = cvt_pk_bf16(f[2 * p], f[2 * p + 1]); xh[p] = hw;
                          xl[p] = cvt_pk_bf16(f[2 * p] - __uint_as_float(hw << 16), f[2 * p + 1] - __uint_as_float(hw & 0xffff0000u)); } }
                    { u32x4 hw; hw.x = cvt_pk_bf16(x0[0] * g0[0], x0[1] * g0[1]); hw.y = cvt_pk_bf16(x0[2] * g0[2], x0[3] * g0[3]); hw.z = cvt_pk_bf16(x1v[0] * g1[0], x1v[1] * g1[1]); hw.w = cvt_pk_bf16(x1v[2] * g1[2], x1v[3] * g1[3]);
                      *(u32x4*)(hp + 32 * c) = hw; }
                    const bf16x8 ah = __builtin_bit_cast(bf16x8, xh), al = __builtin_bit_cast(bf16x8, xl);
                    a0 = __builtin_amdgcn_mfma_f32_16x16x32_bf16(ah, h0, a0, 0, 0, 0); a1 = __builtin_amdgcn_mfma_f32_16x16x32_bf16(ah, h1, a1, 0, 0, 0); a2 = __builtin_amdgcn_mfma_f32_16x16x32_bf16(ah, h2, a2, 0, 0, 0);
                    a0 = __builtin_amdgcn_mfma_f32_16x16x32_bf16(ah, l0, a0, 0, 0, 0); a1 = __builtin_amdgcn_mfma_f32_16x16x32_bf16(ah, l1, a1, 0, 0, 0); a2 = __builtin_amdgcn_mfma_f32_16x16x32_bf16(ah, l2, a2, 0, 0, 0);
                    a0 = __builtin_amdgcn_mfma_f32_16x16x32_bf16(al, h0, a0, 0, 0, 0); a1 = __builtin_amdgcn_mfma_f32_16x16x32_bf16(al, h1, a1, 0, 0, 0); a2 = __builtin_amdgcn_mfma_f32_16x16x32_bf16(al, h2, a2, 0, 0, 0);
                    ssq += (x0.x * x0.x + x0.y * x0.y) + (x0.z * x0.z + x0.w * x0.w) + (x1v.x * x1v.x + x1v.y * x1v.y) + (x1v.z * x1v.z + x1v.w * x1v.w);
                }
                ssq += __shfl_xor(ssq, 16); ssq += __shfl_xor(ssq, 32);
#pragma unroll
                for (int r = 0; r < 4; ++r) { LAS float* lp = LG + (kh * 64 + rb + 4 * q + r) * 48 + rl; lp[0] = a0[r]; lp[16] = a1[r]; lp[32] = a2[r]; }
                if (q == 0) SQ[kh * 64 + rb + rl] = ssq;
            }
            __syncthreads();
            if (TS_PHASE == 105) ts_b = __builtin_amdgcn_s_memrealtime();
            if (wave == 0) {
                const int row = task * 64 + lane; const float rs = __builtin_amdgcn_rsqf((SQ[lane] + SQ[64 + lane]) * (1.f / D) + EPS); const LAS float* lg = LG + lane * 48; const LAS float* lg2 = lg + 64 * 48;
                float gl[4]; float gmax = -3.0e38f; int gi = 0;
#pragma unroll
                for (int jj = 0; jj < 4; ++jj) { gl[jj] = (lg[32 + jj] + lg2[32 + jj]) * rs + args.in[16][jj]; if (gl[jj] > gmax) { gmax = gl[jj]; gi = jj; } }
                float gsum = 0.f;
#pragma unroll
                for (int jj = 0; jj < 4; ++jj) gsum += __expf(gl[jj] - gmax);
                const float pg = 1.f / gsum;
                float el[8]; float b1 = -3.0e38f, b2 = -3.0e38f; int i1 = 0, i2 = 0;
#pragma unroll
                for (int jj = 0; jj < 8; ++jj) { el[jj] = (lg[8 * gi + jj] + lg2[8 * gi + jj]) * rs + args.in[18][8 * gi + jj]; if (el[jj] > b1) { b1 = el[jj]; i1 = jj; } }
#pragma unroll
                for (int jj = 0; jj < 8; ++jj) { if (jj != i1 && el[jj] > b2) { b2 = el[jj]; i2 = jj; } }
                const float wa = pg / (1.f + __expf(b2 - b1)), wb = pg - wa;
                const int e1 = 8 * gi + i1, e2 = 8 * gi + i2;
                const int r1 = __hip_atomic_fetch_add(&CNT[e1], 1, __ATOMIC_RELAXED, __HIP_MEMORY_SCOPE_WORKGROUP), r2 = __hip_atomic_fetch_add(&CNT[e2], 1, __ATOMIC_RELAXED, __HIP_MEMORY_SCOPE_WORKGROUP);
                LDS_WAIT();
                if (lane < 32) { const int c = CNT[lane]; CNT[lane] = 0; BASE[lane] = c > 0 ? (int)__hip_atomic_fetch_add(CURSOR + 64 * lane, (unsigned)c, __ATOMIC_RELAXED, __HIP_MEMORY_SCOPE_AGENT) : 0; }
                LDS_WAIT();
                const int p1 = BASE[e1] + r1, p2 = BASE[e2] + r2;
                LISTTOK[e1 * CAP + p1] = row; LISTW[e1 * CAP + p1] = wa; LISTR[e1 * CAP + p1] = rs; LISTTOK[e2 * CAP + p2] = row; LISTW[e2 * CAP + p2] = wb; LISTR[e2 * CAP + p2] = rs;
                TOKPOS[2 * row] = (e1 << 16) | p1; TOKPOS[2 * row + 1] = (e2 << 16) | p2;
            }
            __syncthreads();
            if (TS_PHASE == 106) ts_b = __builtin_amdgcn_s_memrealtime();
        }
    }
    SEAM(5);
    if (TS_PHASE == 5) ts_b = __builtin_amdgcn_s_memrealtime();

    LAS int* MOE_CNT = (LAS int*)(lds + MISC_OFF + 256); LAS int* MOE_TB = MOE_CNT + 32;
    if (hi > 6) {
        if (wave == 0) {
            const int e = lane & 31; const int cnt = (int)__hip_atomic_load(CURSOR + 64 * e, __ATOMIC_RELAXED, __HIP_MEMORY_SCOPE_AGENT); const int nt = (cnt + 255) >> 8;
            int incl = nt;
#pragma unroll
            for (int o = 1; o < 32; o <<= 1) { const int v = __shfl_up(incl, o); if ((lane & 31) >= o) incl += v; }
            if (lane < 32) { MOE_CNT[e] = cnt; MOE_TB[e] = incl - nt; if (e == 31) MOE_TB[32] = incl; }
        }
        __syncthreads();
    }
    const int cmoe = (G == 256) ? 4 * (((vcu & 31) >> 2) * 8 + (vcu >> 5)) + (vcu & 3) : vcu;
#define MOE_LOOKUP(mu, nunits, cc) do { nunits = MOE_TB[32] * 4; \
        _Pragma("unroll") for (int i_ = 0; i_ < 3; ++i_) { const int L_ = i_ * G + (cc); int e_ = 0, p_ = 0, n_ = 1; \
            if (L_ < nunits) { const int rt_ = L_ >> 2; for (int q_ = 0; q_ < 32; ++q_) { if (MOE_TB[q_] <= rt_ && rt_ < MOE_TB[q_ + 1]) e_ = q_; } p_ = (rt_ - MOE_TB[e_]) * 256; n_ = MOE_CNT[e_]; } \
            mu.e[i_] = __builtin_amdgcn_readfirstlane(e_); mu.pos0[i_] = __builtin_amdgcn_readfirstlane(p_); mu.n[i_] = __builtin_amdgcn_readfirstlane(n_); } } while (0)

    if (TS_PHASE == 6) ts_a = __builtin_amdgcn_s_memrealtime();
    if (IN(6)) for (int rep = 0; rep < REP6; ++rep) {
        pg8::MoeUnits mu; int nunits; MOE_LOOKUP(mu, nunits, cmoe);
        pg8::MoeSched<true> S{(const char*)HN, (const char*)WGUT, LISTTOK, 1024, 1024, G, cmoe, nunits, mu, (size_t)1024 * 1024 * 2, 0, 3};
        EpiGU E{HB, LISTR, ctl + CW_TILECTR};
        pg8::gemm_phase<EpiGU, pg8::MoeSched<true>, true>(lds, 1024, S, E);
    }
    if (TS_PHASE == 6) ts_b = __builtin_amdgcn_s_memrealtime();

    if (TS_PHASE == 7) ts_a = __builtin_amdgcn_s_memrealtime();
    if (IN(7)) for (int rep = 0; rep < REP7; ++rep) {
        const int cc = G - 1 - cmoe;
        pg8::MoeUnits mu; int nunits; MOE_LOOKUP(mu, nunits, cc);
        EpiDown E{YB, LISTW};
#pragma unroll
        for (int part = 0; part < 2; ++part) {
            const int i0 = part * 2, i1 = part == 0 ? 2 : 3;
            if (wave == 0) {
                for (int i = i0; i < i1; ++i) { const int L = i * G + cc; if (L >= nunits) break;
                    unsigned* cp = ctl + CW_TILECTR + 64 * (L >> 2); unsigned spins = 0;
                    while ((unsigned)__builtin_amdgcn_readfirstlane(__hip_atomic_load(cp, __ATOMIC_RELAXED, __HIP_MEMORY_SCOPE_AGENT)) < 32u) { __builtin_amdgcn_s_sleep(2); if (++spins > (1u << 22)) break; } }
                __builtin_amdgcn_fence(__ATOMIC_ACQUIRE, "agent");
                asm volatile("s_waitcnt vmcnt(0)" ::: "memory");
            }
            __syncthreads();
            pg8::MoeSched<false> S{(const char*)HB, (const char*)WDT, LISTTOK, 512, 512, G, cc, nunits, mu, (size_t)1024 * 512 * 2, i0, i1 - i0};
            pg8::gemm_phase<EpiDown, pg8::MoeSched<false>, true>(lds, 512, S, E);
        }
    }
    SEAM(7);
    if (TS_PHASE == 7) ts_b = __builtin_amdgcn_s_memrealtime();

    if (TS_PHASE == 8) ts_a = __builtin_amdgcn_s_memrealtime();
    if (IN(8)) {
        const int gw = vcu * 8 + wave, NGW = G * 8;
        for (int m = gw; m < T; m += NGW) {
            const int c1 = TOKPOS[2 * m], c2 = TOKPOS[2 * m + 1];
            const int s1 = MOE_TB[c1 >> 16] * 256 + (c1 & 0xffff), s2 = MOE_TB[c2 >> 16] * 256 + (c2 & 0xffff);
            const GAS f32x4* xr = (const GAS f32x4*)(x + (size_t)m * D) + lane; GAS f32x4* orow = (GAS f32x4*)(out + (size_t)m * D) + lane;
            const GAS u32x2* y1 = (const GAS u32x2*)(YB + (size_t)s1 * D) + lane; const GAS u32x2* y2 = (const GAS u32x2*)(YB + (size_t)s2 * D) + lane; const GAS u32x2* ar = (const GAS u32x2*)(AO + (size_t)m * D) + lane;
#pragma unroll
            for (int j = 0; j < 4; ++j) { f32x4 v = xr[64 * j]; const u32x2 a = y1[64 * j], b = y2[64 * j], c = ar[64 * j];
                v.x += __uint_as_float(c.x << 16) + (__uint_as_float(a.x << 16) + __uint_as_float(b.x << 16)); v.y += __uint_as_float(c.x & 0xffff0000u) + (__uint_as_float(a.x & 0xffff0000u) + __uint_as_float(b.x & 0xffff0000u));
                v.z += __uint_as_float(c.y << 16) + (__uint_as_float(a.y << 16) + __uint_as_float(b.y << 16)); v.w += __uint_as_float(c.y & 0xffff0000u) + (__uint_as_float(a.y & 0xffff0000u) + __uint_as_float(b.y & 0xffff0000u));
                orow[64 * j] = v; }
        }
    }
    if (TS_PHASE >= 0 && blockIdx.x == 0) { if (TS_PHASE == 8) ts_b = __builtin_amdgcn_s_memrealtime(); const unsigned long long t_end = __builtin_amdgcn_s_memrealtime(), dt = ts_b - ts_a;
        while (__builtin_amdgcn_s_memrealtime() - t_end < dt) __builtin_amdgcn_s_sleep(8); }
#undef IN
#undef SEAM
}

extern "C" void kernel_launch(void* const* d_in, const int* in_sizes, int n_in, void* d_out, int out_size, void* d_ws, size_t ws_size, hipStream_t stream) {
    static int grid = 0;
    if (grid == 0) {
        if (n_in != 22 || out_size != T * D || ws_size < WS_END) { fprintf(stderr, "kernel_launch: unexpected shapes (n_in %d out %d ws %zu)\n", n_in, out_size, ws_size); grid = -1; return; }
        if (hipFuncSetAttribute((const void*)mk_fwd, hipFuncAttributeMaxDynamicSharedMemorySize, LDS_BYTES) != hipSuccess) { fprintf(stderr, "kernel_launch: hipFuncSetAttribute failed\n"); grid = -1; return; }
        int dev = 0, cus = 0, per_cu = 0;
        (void)hipGetDevice(&dev); (void)hipDeviceGetAttribute(&cus, hipDeviceAttributeMultiprocessorCount, dev);
        (void)hipOccupancyMaxActiveBlocksPerMultiprocessor(&per_cu, (const void*)mk_fwd, 512, LDS_BYTES);
        (void)hipGetLastError();
        if (cus != 256 || per_cu < 1) fprintf(stderr, "kernel_launch: note: %d CUs, occupancy query %d\n", cus, per_cu);
        grid = 256;
    }
    if (grid < 0) return;
    (void)hipMemsetAsync((char*)d_ws + WS_CTL, 0, CTL_ZERO_BYTES, stream);
    Args a{};
    for (int i = 0; i < 22; ++i) a.in[i] = (const float*)d_in[i];
    a.out = (float*)d_out; a.ws = (unsigned char*)d_ws;
    if (MK_N_LAUNCHES == 1) { a.ph_lo = 0; a.ph_hi = NPHASE; hipLaunchKernelGGL(mk_fwd, dim3(grid), dim3(512), LDS_BYTES, stream, a); }
    else { for (int p = 0; p < NPHASE; ++p) { a.ph_lo = p; a.ph_hi = p + 1; hipLaunchKernelGGL(mk_fwd, dim3(grid), dim3(512), LDS_BYTES, stream, a); } }
}
```

```cpp
#include <hip/hip_runtime.h>
#include <cstdio>
#include <cstdint>

#ifndef MK_N_LAUNCHES
#define MK_N_LAUNCHES 1
#endif
constexpr int NPHASE = 9;
#ifndef TS_PHASE
#define TS_PHASE -1
#endif
#ifndef REP0
#define REP0 1
#endif
#ifndef REP1
#define REP1 1
#endif
#ifndef REP2A
#define REP2A 1
#endif
#ifndef REP2B
#define REP2B 1
#endif
#ifndef REP3
#define REP3 1
#endif
#ifndef REP4
#define REP4 1
#endif
#ifndef REP5
#define REP5 1
#endif
#ifndef REP6
#define REP6 1
#endif
#ifndef REP7
#define REP7 1
#endif
#ifndef REP8
#define REP8 1
#endif

#define GAS __attribute__((address_space(1)))
#define LAS __attribute__((address_space(3)))
typedef unsigned short bf16;
typedef short bf16x8 __attribute__((ext_vector_type(8)));
typedef short s16x4 __attribute__((ext_vector_type(4)));
typedef float f32x4 __attribute__((ext_vector_type(4)));
typedef float f32x16 __attribute__((ext_vector_type(16)));
typedef unsigned u32x4 __attribute__((ext_vector_type(4)));
typedef unsigned u32x2 __attribute__((ext_vector_type(2)));

constexpr int T = 16384, SEQ = 8192, D = 1024, PROJ = 5120;
constexpr int NEXP = 32, DEXP = 512;
constexpr int MAXSLOT = 40960, MAXTILES = MAXSLOT / 256;
constexpr float EPS = 1e-6f;
constexpr float LOG2E = 1.4426950408889634f;
constexpr float C2 = 0.125f * LOG2E;

constexpr size_t MiB = 1u << 20;
constexpr size_t WS_CTL = 0, CTL_ZERO_BYTES = 192 * 1024;
constexpr size_t WS_TBLA = 1 * MiB;
constexpr size_t WS_TBLB = WS_TBLA + 4096;
constexpr size_t WS_LAM = WS_TBLB + 8192;
constexpr size_t WS_WR = 1 * MiB + 64 * 1024;
constexpr size_t WS_TOKPOS = 1 * MiB + 512 * 1024;
constexpr size_t WS_LISTTOK = 2 * MiB;
constexpr size_t WS_LISTW = 226 * MiB;
constexpr size_t WS_WINT = 4 * MiB;
constexpr size_t WS_WABT = 14 * MiB;
constexpr size_t WS_WOT = 16 * MiB;
constexpr size_t WS_WGUT = 18 * MiB;
constexpr size_t WS_WDT = 82 * MiB;
constexpr size_t WS_XB = 114 * MiB;
constexpr size_t WS_OAB = 114 * MiB;
constexpr size_t WS_QK = 146 * MiB;
constexpr size_t WS_MIXED = 146 * MiB;
constexpr size_t WS_VA = 178 * MiB;
constexpr size_t WS_QB = 194 * MiB, WS_KB = 210 * MiB, WS_VB = 226 * MiB;
constexpr size_t WS_AO = 114 * MiB;
constexpr size_t WS_H = 242 * MiB;
constexpr size_t WS_Y = 146 * MiB;
constexpr size_t WS_LISTR = 228 * MiB;
constexpr size_t WS_END = 282 * MiB;
constexpr int CW_BAR = 1024;
constexpr int CW_CONV = 8448;
constexpr int CW_MIXCTR = 32768, CW_AOCTR = 36864;
constexpr int CW_TILECTR = 16384;
constexpr int CW_CURSOR = 8192;
constexpr int CAP = 16384;

constexpr int RING_BYTES = 131072;
constexpr int MISC_OFF = RING_BYTES;
constexpr int LDS_BYTES = 147456;

#define LDS_WAIT() asm volatile("s_waitcnt lgkmcnt(0)" ::: "memory")
#define VM_WAIT() asm volatile("s_waitcnt vmcnt(0)" ::: "memory")
__device__ __forceinline__ unsigned cvt_pk_bf16(float lo, float hi) { unsigned r; asm volatile("v_cvt_pk_bf16_f32 %0, %1, %2" : "=v"(r) : "v"(lo), "v"(hi)); return r; }
__device__ __forceinline__ float bf2f(unsigned short b) { return __uint_as_float((unsigned)b << 16); }
__device__ __forceinline__ float wave_sum(float v) {
#pragma unroll
    for (int o = 1; o < 64; o <<= 1) v += __shfl_xor(v, o);
    return v;
}

#define XB_TMO      128
#define XB_XCNT(j)  (256  + 64 * (j))
#define XB_XSUB(j)  (1280 + 64 * (j))
#define XB_XGEN(j)  (2304 + 64 * (j))
#define XB_TOP      3328
#define XB_TOPGEN   3392
#define XCD_BAR_WORDS 3456
#define XB_SPIN_CAP (1u << 18)
__device__ __forceinline__ unsigned xb_ld(unsigned* p)              { return __hip_atomic_load(p, __ATOMIC_RELAXED, __HIP_MEMORY_SCOPE_AGENT); }
__device__ __forceinline__ unsigned xb_add(unsigned* p, unsigned v) { return __hip_atomic_fetch_add(p, v, __ATOMIC_RELAXED, __HIP_MEMORY_SCOPE_AGENT); }
__device__ __forceinline__ unsigned xb_xcc_id() { return (unsigned)__builtin_amdgcn_s_getreg((3 << 11) | 20) & 0xFu; }
#define XB_SPIN(cond, bar) do { unsigned _sp = 0; while (cond) { __builtin_amdgcn_s_sleep(1); \
    if ((++_sp & 255u) == 0u) { if (xb_ld(&(bar)[XB_TMO])) break; if (_sp > XB_SPIN_CAP) { atomicAdd(&(bar)[XB_TMO], 1u); break; } } } } while (0)
__device__ __forceinline__ int lane_now() { int l; asm volatile("v_mbcnt_lo_u32_b32 %0, -1, 0\n\tv_mbcnt_hi_u32_b32 %0, -1, %0" : "=v"(l)); return l; }
struct XcdBarrier { unsigned* bar; unsigned x; volatile LAS unsigned* st; bool w0; };
__device__ __forceinline__ XcdBarrier xcd_barrier_post(unsigned* bar, volatile LAS unsigned* st, bool w0) {
    XcdBarrier b; b.bar = bar; b.x = xb_xcc_id(); b.st = st; b.w0 = w0;
    if (w0 && lane_now() == 0) (void)xb_add(&bar[XB_XCNT(b.x)], 1u);
    return b;
}
__device__ __forceinline__ void xcd_barrier_complete(unsigned* bar, unsigned x, unsigned& nloc, unsigned& nx) {
    const unsigned G = gridDim.x * gridDim.y * gridDim.z;
    unsigned sum, cnt, mine, sp = 0u;
    for (;;) {
        sum = 0u; cnt = 0u; mine = 0u;
#pragma unroll
        for (unsigned j = 0; j < 16; ++j) { const unsigned c = xb_ld(&bar[XB_XCNT(j)]); sum += c; cnt += (c > 0u) ? 1u : 0u; mine = (j == x) ? c : mine; }
        if (sum == G) break;
        __builtin_amdgcn_s_sleep(1);
        if ((++sp & 255u) == 0u) { if (xb_ld(&bar[XB_TMO])) break; if (sp > XB_SPIN_CAP) { atomicAdd(&bar[XB_TMO], 1u); break; } }
    }
    nloc = mine > 0u ? mine : 1u; nx = cnt > 0u ? cnt : 1u;
}
__device__ __forceinline__ void xcd_barrier(const XcdBarrier& b) {
    asm volatile("s_waitcnt vmcnt(0)" ::: "memory");
    __syncthreads();
    if (b.w0 && lane_now() == 0) {
        unsigned* bar = b.bar;
        __builtin_amdgcn_s_waitcnt(0);
        unsigned nloc = b.st[0], nx = b.st[1];
        if (nloc == 0u) { xcd_barrier_complete(bar, b.x, nloc, nx); b.st[0] = nloc; b.st[1] = nx; }
        const unsigned old = xb_add(&bar[XB_XSUB(b.x)], 1u);
        const unsigned gen = old / nloc;
        if (old + 1u == (gen + 1u) * nloc) {
            __builtin_amdgcn_fence(__ATOMIC_RELEASE, "agent");
            asm volatile("s_waitcnt vmcnt(0)" ::: "memory");
            const unsigned og = xb_add(&bar[XB_TOP], 1u);
            const unsigned tg = og / nx;
            if (og + 1u == (tg + 1u) * nx) xb_add(&bar[XB_TOPGEN], 1u);
            else XB_SPIN(xb_ld(&bar[XB_TOPGEN]) == tg, bar);
            __builtin_amdgcn_fence(__ATOMIC_ACQUIRE, "agent");
            xb_add(&bar[XB_XGEN(b.x)], 1u);
            asm volatile("s_waitcnt vmcnt(0)" ::: "memory");
        } else {
            XB_SPIN(xb_ld(&bar[XB_XGEN(b.x)]) == gen, bar);
            __builtin_amdgcn_fence(__ATOMIC_ACQUIRE, "agent");
            asm volatile("s_waitcnt vmcnt(0)" ::: "memory");
        }
    }
    __syncthreads();
}

namespace pg8 {
constexpr int BM = 256, BK = 64, HALF = 128, HTB = HALF * BK * 2, NXCD = 8, WGM = 8;
__host__ __device__ __forceinline__ int lds_byte(int r, int c) { const int st = (r >> 4) * 2 + (c >> 5), rr = r & 15, cc = c & 31, ob = rr * 64 + cc * 2; return st * 1024 + (ob ^ (((ob >> 9) & 1) << 5)); }
__host__ __device__ __forceinline__ void stage_rc(int b, int& R, int& C) { const int st = b / 1024, sb = b % 1024, swz = sb ^ (((sb >> 9) & 1) << 5); R = (st >> 1) * 16 + swz / 64; C = (st & 1) * 32 + (swz % 64) / 2; }
__host__ __device__ __forceinline__ int perm32(int rho) { const int n = rho >> 4, i = rho & 15; return 8 * (i >> 2) + 4 * n + (i & 3); }

struct Unit { int pm, pn, e, part, pos0, n; };

__device__ __forceinline__ void tile_of(int L, int nM, int nN, int& pm, int& pn) {
    const int nwg = nM * nN; int wgid = L;
    { const int q = nwg / NXCD, r = nwg % NXCD, xcd = wgid % NXCD, off = wgid / NXCD; wgid = (xcd < r ? xcd * (q + 1) : r * (q + 1) + (xcd - r) * q) + off; }
    const int nig = WGM * nN, gid = wgid / nig, fm = gid * WGM, gsz = (nM - fm) < WGM ? (nM - fm) : WGM;
    pm = fm + ((wgid % nig) % gsz); pn = (wgid % nig) / gsz;
}

template <class Epi, class Sched, bool ALIGN_EPI>
__device__ __forceinline__ void gemm_phase(LAS unsigned char* lds, const int K, const Sched& S, const Epi& E, const int wv) {
    const int lane = lane_now(), wid = wv, tid = wid * 64 + lane, wr = wid >> 2, wc = wid & 3, fr = lane & 15, fq = lane >> 4;
    const int nt = K / BK;
    int Rr[2], Cc[2]; unsigned voffB[2];
#pragma unroll
    for (int i = 0; i < 2; ++i) { int R, C; stage_rc(tid * 16 + i * 8192, R, C); Rr[i] = R; Cc[i] = C; const int Rb = Epi::PERM ? ((R & ~31) + perm32(R & 31)) : R; voffB[i] = (unsigned)(Rb * S.ldb + C) * 2u; }
    const size_t kstep = (size_t)(BK * 2);
    const size_t hstepB = (size_t)HALF * S.ldb * 2;
    const unsigned ldsw = (unsigned)wid * 1024u;
    const int aoff = lds_byte(wr * 64 + fr, fq * 8), boff = lds_byte(wc * 32 + fr, fq * 8);
#define PG8_SA(b, h) (((b) * 2 + (h)) * HTB)
#define PG8_SB(b, h) ((4 + (b) * 2 + (h)) * HTB)
#define PG8_STAGE_A(bufoff, gbase, offh) do { _Pragma("unroll") for (int _i = 0; _i < 2; ++_i) \
        __builtin_amdgcn_global_load_lds((const unsigned*)((const char*)(gbase) + (offh)[_i]), (LAS unsigned*)(lds + (bufoff) + ldsw + _i * 8192), 16, 0, 0); } while (0)
#define PG8_STAGE_B(bufoff, gbase) do { _Pragma("unroll") for (int _i = 0; _i < 2; ++_i) \
        __builtin_amdgcn_global_load_lds((const unsigned*)((const char*)(gbase) + voffB[_i]), (LAS unsigned*)(lds + (bufoff) + ldsw + _i * 8192), 16, 0, 0); } while (0)
#define PG8_LDA(dst, b, h) do { _Pragma("unroll") for (int m = 0; m < 4; ++m) _Pragma("unroll") for (int k = 0; k < 2; ++k) dst[m][k] = *(const LAS bf16x8*)(lds + PG8_SA(b, h) + aoff + m * 2048 + k * 1024); } while (0)
#define PG8_LDB(dst, b, h) do { _Pragma("unroll") for (int n = 0; n < 2; ++n) _Pragma("unroll") for (int k = 0; k < 2; ++k) dst[n][k] = *(const LAS bf16x8*)(lds + PG8_SB(b, h) + boff + n * 2048 + k * 1024); } while (0)
#define PG8_MMA(ai, bj, At, Bt) do { __builtin_amdgcn_s_setprio(1); _Pragma("unroll") for (int m = 0; m < 4; ++m) _Pragma("unroll") for (int n = 0; n < 2; ++n) _Pragma("unroll") for (int k = 0; k < 2; ++k) \
        acc[ai][bj][m][n] = __builtin_amdgcn_mfma_f32_16x16x32_bf16(Bt[n][k], At[m][k], acc[ai][bj][m][n], 0, 0, 0); __builtin_amdgcn_s_setprio(0); } while (0)
#define PG8_WAIT_V(n) asm volatile("s_waitcnt vmcnt(" #n ")" ::: "memory")
#define PG8_WAIT_L(n) asm volatile("s_waitcnt lgkmcnt(" #n ")" ::: "memory")
#define PG8_BAR __builtin_amdgcn_s_barrier()
#define PG8_SCHED __builtin_amdgcn_sched_barrier(0)
    Unit cur, nxt; int ui = 0;
    if (!S.next(0, cur)) return;
    f32x4 acc[2][2][4][2];
#pragma unroll
    for (int a = 0; a < 2; ++a)
#pragma unroll
        for (int b = 0; b < 2; ++b)
#pragma unroll
            for (int m = 0; m < 4; ++m)
#pragma unroll
                for (int n = 0; n < 2; ++n) acc[a][b][m][n] = (f32x4){0.f, 0.f, 0.f, 0.f};
    bf16x8 At[4][2], B0[2][2], B1[2][2];
    const char* cA = S.a_base(cur); const char* cB = S.b_base(cur);
    unsigned oA[2][2], nraw[2][2];
    {
        unsigned raw[2][2];
#pragma unroll
        for (int h = 0; h < 2; ++h)
#pragma unroll
            for (int i = 0; i < 2; ++i) raw[h][i] = S.a_raw(cur, h, Rr[i]);
        if (Sched::GATHER) PG8_WAIT_V(0);
#pragma unroll
        for (int h = 0; h < 2; ++h)
#pragma unroll
            for (int i = 0; i < 2; ++i) oA[h][i] = S.a_conv(raw[h][i], Cc[i]);
    }
    PG8_STAGE_B(PG8_SB(0, 0), cB); PG8_STAGE_B(PG8_SB(0, 1), cB + hstepB); PG8_STAGE_A(PG8_SA(0, 0), cA, oA[0]); PG8_STAGE_A(PG8_SA(0, 1), cA, oA[1]);
    if (wr == 1) PG8_BAR;
    PG8_WAIT_V(2); PG8_BAR;
    PG8_STAGE_B(PG8_SB(1, 0), cB + kstep); PG8_STAGE_A(PG8_SA(1, 0), cA + kstep, oA[0]); PG8_STAGE_B(PG8_SB(1, 1), cB + hstepB + kstep);
    PG8_WAIT_V(6); PG8_BAR;
    for (;;) {
        const bool has_next = S.next(ui + 1, nxt);
        const char* nA = has_next ? S.a_base(nxt) : cA; const char* nB = has_next ? S.b_base(nxt) : cB;
        if (Sched::GATHER && has_next) {
#pragma unroll
            for (int h = 0; h < 2; ++h)
#pragma unroll
                for (int i = 0; i < 2; ++i) nraw[h][i] = S.a_raw(nxt, h, Rr[i]);
        }
        for (int t = 0; t < nt; t += 2) {
            const bool last = (t == nt - 2);
            const char* a1 = cA + (size_t)(t + 1) * kstep;
            const char* a2 = last ? nA : cA + (size_t)(t + 2) * kstep; const char* b2 = last ? nB : cB + (size_t)(t + 2) * kstep;
            const char* a3 = a2 + kstep; const char* b3 = b2 + kstep;
            PG8_LDB(B0, 0, 0); PG8_LDB(B1, 0, 1); PG8_SCHED; PG8_LDA(At, 0, 0); PG8_STAGE_A(PG8_SA(1, 1), a1, oA[1]);
            PG8_WAIT_V(8); PG8_WAIT_L(0); PG8_BAR; PG8_MMA(0, 0, At, B0); PG8_MMA(0, 1, At, B1); PG8_BAR; PG8_SCHED;
            if (last && has_next) {
#pragma unroll
                for (int h = 0; h < 2; ++h)
#pragma unroll
                    for (int i = 0; i < 2; ++i) oA[h][i] = S.a_conv(Sched::GATHER ? nraw[h][i] : S.a_raw(nxt, h, Rr[i]), Cc[i]);
            }
            PG8_LDA(At, 0, 1); PG8_STAGE_B(PG8_SB(0, 0), b2); PG8_STAGE_B(PG8_SB(0, 1), b2 + hstepB); PG8_STAGE_A(PG8_SA(0, 0), a2, oA[0]);
            PG8_WAIT_V(8); PG8_WAIT_L(0); PG8_BAR; PG8_MMA(1, 0, At, B0); PG8_MMA(1, 1, At, B1); PG8_BAR; PG8_SCHED;
            PG8_LDB(B0, 1, 0); PG8_LDB(B1, 1, 1); PG8_SCHED; PG8_LDA(At, 1, 0); PG8_STAGE_A(PG8_SA(0, 1), a2, oA[1]);
            PG8_WAIT_V(8); PG8_WAIT_L(0); PG8_BAR; PG8_MMA(0, 0, At, B0); PG8_MMA(0, 1, At, B1); PG8_BAR; PG8_SCHED;
            PG8_LDA(At, 1, 1); PG8_STAGE_B(PG8_SB(1, 0), b3); PG8_STAGE_B(PG8_SB(1, 1), b3 + hstepB); PG8_STAGE_A(PG8_SA(1, 0), a3, oA[0]);
            PG8_WAIT_V(8); PG8_WAIT_L(0); PG8_BAR; PG8_MMA(1, 0, At, B0); PG8_MMA(1, 1, At, B1); PG8_BAR; PG8_SCHED;
        }
        if constexpr (ALIGN_EPI) { if (wr == 0) PG8_BAR; }
        if (TS_PHASE >= 120 && TS_PHASE <= 129 && (TS_PHASE & 1) == 0 && ui == (TS_PHASE - 120) / 2 && tid == 0) *(LAS unsigned long long*)(lds + MISC_OFF + 128) = __builtin_amdgcn_s_memrealtime();
        E(acc, cur, wr, wc, fr, fq);
        if (TS_PHASE >= 120 && TS_PHASE <= 129 && (TS_PHASE & 1) == 1 && ui == (TS_PHASE - 121) / 2 && tid == 256) *(LAS unsigned long long*)(lds + MISC_OFF + 128) = __builtin_amdgcn_s_memrealtime();
        if (!has_next) break;
        if (!E.keep(cur)) {
#pragma unroll
            for (int a = 0; a < 2; ++a)
#pragma unroll
                for (int b = 0; b < 2; ++b)
#pragma unroll
                    for (int m = 0; m < 4; ++m)
#pragma unroll
                        for (int n = 0; n < 2; ++n) acc[a][b][m][n] = (f32x4){0.f, 0.f, 0.f, 0.f};
        }
        cur = nxt; cA = nA; cB = nB; ++ui;
        if constexpr (ALIGN_EPI) { if (wr == 1) PG8_BAR; }
    }
    PG8_WAIT_V(0);
    if constexpr (!ALIGN_EPI) { if (wr == 0) PG8_BAR; }
    PG8_BAR;
#undef PG8_SA
#undef PG8_SB
#undef PG8_STAGE_A
#undef PG8_STAGE_B
#undef PG8_LDA
#undef PG8_LDB
#undef PG8_MMA
#undef PG8_WAIT_V
#undef PG8_WAIT_L
#undef PG8_BAR
#undef PG8_SCHED
}

struct DenseSched {
    static constexpr bool GATHER = false;
    const char* A; const char* Bt; int lda, ldb, nM, nN, G, c, nparts, K;
    __device__ __forceinline__ bool next(int i, Unit& u) const {
        const int ti = i / nparts; const long L = (long)ti * G + c; if (L >= (long)nM * nN) return false;
        tile_of((int)L, nM, nN, u.pm, u.pn); u.part = i - ti * nparts; u.e = 0; return true;
    }
    __device__ __forceinline__ const char* a_base(const Unit& u) const { return A + (size_t)u.part * K * 2; }
    __device__ __forceinline__ const char* b_base(const Unit& u) const { return Bt + ((size_t)u.pn * BM * ldb + (size_t)u.part * K) * 2; }
    __device__ __forceinline__ unsigned a_raw(const Unit& u, int h, int R) const { return (unsigned)(u.pm * BM + h * HALF + R); }
    __device__ __forceinline__ unsigned a_conv(unsigned raw, int C) const { return (raw * (unsigned)lda + (unsigned)C) * 2u; }
};
struct MoeUnits { int e[3], pos0[3], n[3]; };
template <bool GATHER_>
struct MoeSched {
    static constexpr bool GATHER = GATHER_;
    const char* A; const char* Bt; const int* list_tok; int lda, ldb, G, c, nunits; MoeUnits mu; size_t bstride; int ibase, icount;
    __device__ __forceinline__ bool next(int i_, Unit& u) const {
        const int i = i_ + ibase; const int L = i * G + c; if (i_ >= icount || i > 2 || L >= nunits) return false;
        u.pm = L >> 2; u.pn = L & 3; u.part = 0;
        u.e = (i == 0) ? mu.e[0] : (i == 1 ? mu.e[1] : mu.e[2]); u.pos0 = (i == 0) ? mu.pos0[0] : (i == 1 ? mu.pos0[1] : mu.pos0[2]); u.n = (i == 0) ? mu.n[0] : (i == 1 ? mu.n[1] : mu.n[2]);
        return true;
    }
    __device__ __forceinline__ const char* a_base(const Unit&) const { return A; }
    __device__ __forceinline__ const char* b_base(const Unit& u) const { return Bt + (size_t)u.e * bstride + (size_t)u.pn * BM * ldb * 2; }
    __device__ __forceinline__ unsigned a_raw(const Unit& u, int h, int R) const {
        if (GATHER_) { int pos = u.pos0 + h * HALF + R; pos = pos < u.n ? pos : u.n - 1;
            unsigned v; const int* p = list_tok + u.e * CAP + pos; asm volatile("global_load_dword %0, %1, off" : "=v"(v) : "v"(p) : "memory"); return v; }
        return (unsigned)(u.pm * BM + h * HALF + R);
    }
    __device__ __forceinline__ unsigned a_conv(unsigned raw, int C) const {
        if (GATHER_) { unsigned o; const unsigned c2 = (unsigned)C * 2u; asm volatile("v_mad_u32_u24 %0, %1, %2, %3" : "=v"(o) : "v"(raw), "v"((unsigned)lda * 2u), "v"(c2)); return o; }
        return (raw * (unsigned)lda + (unsigned)C) * 2u;
    }
};
}

struct EpiProj {
    static constexpr bool PERM = true;
    bf16* QK; bf16* VA; bf16* QB; bf16* KB; bf16* VB; bf16* GATES;
    const float *aq, *ak, *bq, *bk;
    __device__ __forceinline__ bool keep(const pg8::Unit&) const { return false; }
    __device__ __forceinline__ void operator()(f32x4 (&acc)[2][2][4][2], const pg8::Unit& u, int wr, int wc, int fr, int fq) const {
        const int pn = u.pn; int mode, ld, colbase; bf16* dst; const float* gain = nullptr; float scale = 1.f;
        if (pn < 4) { mode = 1; dst = QK + (size_t)pn * T * 256; ld = 256; colbase = 0; gain = pn < 2 ? aq : ak; scale = pn < 2 ? C2 : 1.f; }
        else if (pn < 6) { mode = 0; dst = VA; ld = 512; colbase = (pn - 4) * 256; }
        else if (pn < 8) { mode = 1; dst = QB; ld = 512; colbase = (pn - 6) * 256; gain = bq; scale = C2; }
        else if (pn < 10) { mode = 1; dst = KB; ld = 512; colbase = (pn - 8) * 256; gain = bk; }
        else if (pn < 12) { mode = 0; dst = VB; ld = 512; colbase = (pn - 10) * 256; }
        else { mode = 2; dst = GATES; ld = 2048; colbase = (pn - 12) * 256; }
        const int row0 = u.pm * 256 + wr * 64 + fr;
        float g[2][8];
        if (mode == 1) {
#pragma unroll
            for (int bj = 0; bj < 2; ++bj) { const f32x4 a = *(const f32x4*)(gain + 32 * bj + 8 * fq), b = *(const f32x4*)(gain + 32 * bj + 8 * fq + 4);
                g[bj][0] = a[0] * scale; g[bj][1] = a[1] * scale; g[bj][2] = a[2] * scale; g[bj][3] = a[3] * scale; g[bj][4] = b[0] * scale; g[bj][5] = b[1] * scale; g[bj][6] = b[2] * scale; g[bj][7] = b[3] * scale; }
        }
#pragma unroll
        for (int ai = 0; ai < 2; ++ai)
#pragma unroll
            for (int m = 0; m < 4; ++m) {
                float v[2][8];
#pragma unroll
                for (int bj = 0; bj < 2; ++bj)
#pragma unroll
                    for (int n = 0; n < 2; ++n)
#pragma unroll
                        for (int j = 0; j < 4; ++j) v[bj][4 * n + j] = acc[ai][bj][m][n][j];
                if (mode == 1) {
                    float ss = 0.f;
#pragma unroll
                    for (int bj = 0; bj < 2; ++bj)
#pragma unroll
                        for (int j = 0; j < 8; ++j) ss += v[bj][j] * v[bj][j];
                    ss += __shfl_xor(ss, 16); ss += __shfl_xor(ss, 32);
                    const float rs = __builtin_amdgcn_rsqf(ss * (1.f / 64.f) + EPS);
#pragma unroll
                    for (int bj = 0; bj < 2; ++bj)
#pragma unroll
                        for (int j = 0; j < 8; ++j) v[bj][j] = v[bj][j] * rs * g[bj][j];
                } else if (mode == 2) {
#pragma unroll
                    for (int bj = 0; bj < 2; ++bj)
#pragma unroll
                        for (int j = 0; j < 8; ++j) v[bj][j] = __builtin_amdgcn_rcpf(1.f + __builtin_amdgcn_exp2f(-LOG2E * v[bj][j]));
                }
                const int row = row0 + ai * 128 + m * 16;
                unsigned eo, es;
                { const unsigned bq = (unsigned)row >> 13, tile = ((unsigned)row & 8191u) >> 6, key = (unsigned)row & 63u;
                  if (pn == 2 || pn == 3) { eo = ((((bq * 4 + wc) * 128 + tile) * 8 + fq) * 64 + key) * 8; es = 4 * 64 * 8; }
                  else if (pn == 4 || pn == 5) { const unsigned head = (pn - 4) * 2 + (wc >> 1); eo = ((((bq * 4 + head) * 128 + tile) * 4 + 2 * (wc & 1)) * 64 + key) * 32 + 8 * fq; es = 64 * 32; }
                  else if (pn == 8 || pn == 9) { const unsigned head = (pn - 8) * 4 + wc; eo = ((((bq * 8 + head) * 128 + tile) * 8 + fq) * 64 + key) * 8; es = 4 * 64 * 8; }
                  else if (pn == 10 || pn == 11) { const unsigned head = (pn - 10) * 4 + wc; eo = ((((bq * 8 + head) * 128 + tile) * 2) * 64 + key) * 32 + 8 * fq; es = 64 * 32; }
                  else if (pn >= 12) { eo = ((((((unsigned)u.pm * 8 + (pn - 12)) * 2 + ai) * 4 + m) * 2) * 8 + (wr * 4 + wc)) * 512 + (fq * 16 + fr) * 8; es = 8 * 512; }
                  else { eo = (unsigned)row * (unsigned)ld + colbase + 64 * wc + 8 * fq; es = 32; } }
#pragma unroll
                for (int bj = 0; bj < 2; ++bj) { u32x4 w; w.x = cvt_pk_bf16(v[bj][0], v[bj][1]); w.y = cvt_pk_bf16(v[bj][2], v[bj][3]); w.z = cvt_pk_bf16(v[bj][4], v[bj][5]); w.w = cvt_pk_bf16(v[bj][6], v[bj][7]);
                    *(u32x4*)(dst + eo + bj * es) = w; }
            }
    }
};
struct EpiAB {
    static constexpr bool PERM = true;
    const bf16* __restrict__ GATES; bf16* __restrict__ MIXED; unsigned* ctr;
    __device__ __forceinline__ bool keep(const pg8::Unit& u) const { return u.part == 0; }
    __device__ __forceinline__ void operator()(f32x4 (&acc)[2][2][4][2], const pg8::Unit& u, int wr, int wc, int fr, int fq) const {
        const int row0 = u.pm * 256 + wr * 64 + fr, col0 = u.pn * 256 + wc * 32 + 8 * fq;
        const unsigned lo = (unsigned)((wr * 4 + wc) * 512 + (fq * 16 + fr) * 8);
        const GAS u32x4* gp = (const GAS u32x4*)(GATES + ((size_t)((u.pm * 8 + u.pn) * 2) * 4 * 2 * 8) * 512 + lo);
        constexpr int GSTR = 8 * 512 * 2 / 16, GB = 4 * 2 * 4 * 2 * GSTR;
        if (u.part == 0) {
#pragma unroll
            for (int g = 0; g < 8; g += 2) {
                u32x4 sa[2][2], sb[2][2];
#pragma unroll
                for (int gg = 0; gg < 2; ++gg)
#pragma unroll
                    for (int bj = 0; bj < 2; ++bj) { sa[gg][bj] = gp[((g + gg) * 2 + bj) * GSTR]; sb[gg][bj] = gp[((g + gg) * 2 + bj) * GSTR + GB]; }
#pragma unroll
                for (int gg = 0; gg < 2; ++gg)
#pragma unroll
                    for (int bj = 0; bj < 2; ++bj)
#pragma unroll
                        for (int q = 0; q < 4; ++q) { const int ai = (g + gg) >> 2, m = (g + gg) & 3, n = q >> 1, j = (q & 1) * 2;
                            const float sa0 = __uint_as_float(sa[gg][bj][q] << 16), sa1 = __uint_as_float(sa[gg][bj][q] & 0xffff0000u), sb0 = __uint_as_float(sb[gg][bj][q] << 16), sb1 = __uint_as_float(sb[gg][bj][q] & 0xffff0000u);
                            acc[ai][bj][m][n][j] *= sa0 * __builtin_amdgcn_rcpf(sb0); acc[ai][bj][m][n][j + 1] *= sa1 * __builtin_amdgcn_rcpf(sb1); }
            }
        } else {
            const __amdgpu_buffer_rsrc_t mrs = __builtin_amdgcn_make_buffer_rsrc(MIXED, 0, T * D * 2, 0x00020000);
#pragma unroll
            for (int g = 0; g < 8; g += 4) {
                u32x4 sb[4][2];
#pragma unroll
                for (int gg = 0; gg < 4; ++gg)
#pragma unroll
                    for (int bj = 0; bj < 2; ++bj) sb[gg][bj] = gp[((g + gg) * 2 + bj) * GSTR + GB];
#pragma unroll
                for (int gg = 0; gg < 4; ++gg) { const int ai = (g + gg) >> 2, m = (g + gg) & 3; bf16* rp = MIXED + (size_t)(row0 + ai * 128 + m * 16) * 1024 + col0;
#pragma unroll
                    for (int bj = 0; bj < 2; ++bj) { u32x4 w;
#pragma unroll
                        for (int q = 0; q < 4; ++q) { const int n = q >> 1, j = (q & 1) * 2;
                            w[q] = cvt_pk_bf16(acc[ai][bj][m][n][j] * __uint_as_float(sb[gg][bj][q] << 16), acc[ai][bj][m][n][j + 1] * __uint_as_float(sb[gg][bj][q] & 0xffff0000u)); }
                        __builtin_amdgcn_raw_buffer_store_b128(w, mrs, (unsigned)((size_t)(rp + bj * 128 - MIXED) * 2), 0, 16); } }
            }
            asm volatile("s_waitcnt vmcnt(0)" ::: "memory");
            if (lane_now() == 0) __hip_atomic_fetch_add(ctr + 64 * u.pm, 1u, __ATOMIC_RELAXED, __HIP_MEMORY_SCOPE_AGENT);
        }
    }
};
struct EpiAO {
    static constexpr bool PERM = true;
    bf16* AO; unsigned* ctr;
    __device__ __forceinline__ bool keep(const pg8::Unit&) const { return false; }
    __device__ __forceinline__ void operator()(f32x4 (&acc)[2][2][4][2], const pg8::Unit& u, int wr, int wc, int fr, int fq) const {
        const int row0 = u.pm * 256 + wr * 64 + fr, col0 = u.pn * 256 + wc * 32 + 8 * fq;
        const __amdgpu_buffer_rsrc_t ars = __builtin_amdgcn_make_buffer_rsrc(AO, 0, T * D * 2, 0x00020000);
#pragma unroll
        for (int ai = 0; ai < 2; ++ai)
#pragma unroll
            for (int m = 0; m < 4; ++m) { const unsigned ro = (unsigned)((row0 + ai * 128 + m * 16) * D + col0) * 2u;
#pragma unroll
                for (int bj = 0; bj < 2; ++bj) { u32x4 o; o.x = cvt_pk_bf16(acc[ai][bj][m][0][0], acc[ai][bj][m][0][1]); o.y = cvt_pk_bf16(acc[ai][bj][m][0][2], acc[ai][bj][m][0][3]);
                    o.z = cvt_pk_bf16(acc[ai][bj][m][1][0], acc[ai][bj][m][1][1]); o.w = cvt_pk_bf16(acc[ai][bj][m][1][2], acc[ai][bj][m][1][3]);
                    __builtin_amdgcn_raw_buffer_store_b128(o, ars, ro + bj * 256, 0, 16); } }
        asm volatile("s_waitcnt vmcnt(0)" ::: "memory");
        if (lane_now() == 0) __hip_atomic_fetch_add(ctr + 64 * u.pm, 1u, __ATOMIC_RELAXED, __HIP_MEMORY_SCOPE_AGENT);
    }
};
struct EpiGU {
    static constexpr bool PERM = true;
    bf16* H; const float* list_r; unsigned* tilectr;
    __device__ __forceinline__ bool keep(const pg8::Unit&) const { return false; }
    __device__ __forceinline__ void operator()(f32x4 (&acc)[2][2][4][2], const pg8::Unit& u, int wr, int wc, int fr, int fq) const {
        const int r0 = wr * 64 + fr, col0 = u.pn * 128 + wc * 32 + 8 * fq;
        const __amdgpu_buffer_rsrc_t hrs = __builtin_amdgcn_make_buffer_rsrc(H, 0, MAXSLOT * DEXP * 2, 0x00020000);
        float rsv[8];
#pragma unroll
        for (int g = 0; g < 8; ++g) { const int r = r0 + (g >> 2) * 128 + (g & 3) * 16; int pos = u.pos0 + r; pos = pos < u.n ? pos : u.n - 1; rsv[g] = list_r[u.e * CAP + pos]; }
#pragma unroll
        for (int ai = 0; ai < 2; ++ai)
#pragma unroll
            for (int m = 0; m < 4; ++m) {
                const int r = r0 + ai * 128 + m * 16; const float rs = rsv[ai * 4 + m];
                float h[8];
#pragma unroll
                for (int n = 0; n < 2; ++n)
#pragma unroll
                    for (int j = 0; j < 4; ++j) { const float gt = acc[ai][0][m][n][j] * rs, up = acc[ai][1][m][n][j] * rs;
                        h[4 * n + j] = gt * __builtin_amdgcn_rcpf(1.f + __builtin_amdgcn_exp2f(-LOG2E * gt)) * up; }
                u32x4 w; w.x = cvt_pk_bf16(h[0], h[1]); w.y = cvt_pk_bf16(h[2], h[3]); w.z = cvt_pk_bf16(h[4], h[5]); w.w = cvt_pk_bf16(h[6], h[7]);
                __builtin_amdgcn_raw_buffer_store_b128(w, hrs, (unsigned)(((u.pm * 256 + r) * DEXP + col0) * 2), 0, 16);
            }
        asm volatile("s_waitcnt vmcnt(0)" ::: "memory");
        if (lane_now() == 0) __hip_atomic_fetch_add(tilectr + 64 * u.pm, 1u, __ATOMIC_RELAXED, __HIP_MEMORY_SCOPE_AGENT);
    }
};
struct EpiDown {
    static constexpr bool PERM = true;
    bf16* Y; const float* list_w;
    __device__ __forceinline__ bool keep(const pg8::Unit&) const { return false; }
    __device__ __forceinline__ void operator()(f32x4 (&acc)[2][2][4][2], const pg8::Unit& u, int wr, int wc, int fr, int fq) const {
        const int r0 = wr * 64 + fr, col0 = u.pn * 256 + wc * 32 + 8 * fq;
        float wv[8];
#pragma unroll
        for (int g = 0; g < 8; ++g) { const int r = r0 + (g >> 2) * 128 + (g & 3) * 16; int pos = u.pos0 + r; pos = pos < u.n ? pos : u.n - 1; wv[g] = list_w[u.e * CAP + pos]; }
#pragma unroll
        for (int ai = 0; ai < 2; ++ai)
#pragma unroll
            for (int m = 0; m < 4; ++m) { const int r = r0 + ai * 128 + m * 16; const float w = wv[ai * 4 + m]; const int row = u.pm * 256 + r;
#pragma unroll
                for (int bj = 0; bj < 2; ++bj) { u32x4 o; o.x = cvt_pk_bf16(acc[ai][bj][m][0][0] * w, acc[ai][bj][m][0][1] * w); o.y = cvt_pk_bf16(acc[ai][bj][m][0][2] * w, acc[ai][bj][m][0][3] * w);
                    o.z = cvt_pk_bf16(acc[ai][bj][m][1][0] * w, acc[ai][bj][m][1][1] * w); o.w = cvt_pk_bf16(acc[ai][bj][m][1][2] * w, acc[ai][bj][m][1][3] * w);
                    *(u32x4*)(Y + (size_t)row * D + col0 + bj * 128) = o; } }
    }
};

namespace att {
__device__ __forceinline__ int crow(int r, int hi) { return (r & 3) + 8 * (r >> 2) + 4 * hi; }
__device__ __forceinline__ void glds16(const void* sbase_, unsigned voff, unsigned lds_dst) { unsigned keep;
    const unsigned long long a_ = (unsigned long long)(uintptr_t)sbase_;
    const unsigned long long sbase = ((unsigned long long)(unsigned)__builtin_amdgcn_readfirstlane((int)(a_ >> 32)) << 32) | (unsigned)__builtin_amdgcn_readfirstlane((int)a_);
    asm volatile("s_mov_b32 %0, m0\n\ts_mov_b32 m0, %3\n\ts_nop 0\n\tglobal_load_lds_dwordx4 %1, %2\n\ts_mov_b32 m0, %0" : "=&s"(keep) : "v"(voff), "s"(sbase), "s"(lds_dst) : "memory"); }
__device__ __forceinline__ void glds16p(const void* gsrc, unsigned lds_dst) { unsigned keep;
    asm volatile("s_mov_b32 %0, m0\n\ts_mov_b32 m0, %2\n\ts_nop 0\n\tglobal_load_lds_dwordx4 %1, off\n\ts_mov_b32 m0, %0" : "=&s"(keep) : "v"(gsrc), "s"(lds_dst) : "memory"); }
typedef LAS const char* lds_cptr;
typedef short v4i16_t __attribute__((ext_vector_type(4)));
typedef float f32x2_t __attribute__((ext_vector_type(2))); typedef __bf16 bf16x2_t __attribute__((ext_vector_type(2)));
__device__ __forceinline__ s16x4 vtr(lds_cptr p) { return __builtin_bit_cast(s16x4, __builtin_amdgcn_ds_read_tr16_b64_v4i16((LAS v4i16_t*)p)); }
__device__ __forceinline__ unsigned cvtpk(float lo, float hi) { f32x2_t v = {lo, hi}; bf16x2_t b = __builtin_convertvector(v, bf16x2_t); return __builtin_bit_cast(unsigned, b); }
#define ATT_WAIT_BAR(N) asm volatile("s_waitcnt vmcnt(" #N ") lgkmcnt(0)\n\ts_barrier" ::: "memory")
#define ATT_SB() __builtin_amdgcn_sched_barrier(0)
#define ATT_PIN(x) asm volatile("" : "+v"(x))
#define ATT_MFMA(a, b, c) __builtin_amdgcn_mfma_f32_32x32x16_bf16(a, b, c, 0, 0, 0)

constexpr int LDS_K = 0, LDS_V = 49152, LDS_TBL = 98304, LDS_WS = 99328, LDS_X = 0;

template <int NS, int DV, int QP, int VP> struct attn_dummy {};
template <int NS, int DV, int QP, int VP>
__device__ __forceinline__ void attn_unit_simple(const bf16* Q0, const bf16* Q1p, const bf16* K0, const bf16* K1p, const bf16* V, long rowbase, int q0,
                                          const float* tblg, const float* gsub, float lam, bf16* OUT  , char* shm, const int wv) {
    constexpr int KSLOT = NS * 8192, VSLOT = DV * 128, ND = DV / 32, NVP = DV / 64;
    const int lane = lane_now(), wid = wv, tid = wid * 64 + lane, r32 = lane & 31, hi = lane >> 5;
    const int s = (NS == 2) ? (wid >> 2) : 0, j = (NS == 2) ? (wid & 3) : wid;
    const int ROWS = (NS == 2) ? 128 : 256;
    const int cw = (q0 + 32 * j) >> 6, qi = ((32 * j) & 63) + r32;
    const int t1 = (q0 + ROWS - 1) >> 6;
    int t0 = 0, lo_w = 0;
    if (NS == 1) { t0 = (q0 >> 6) - 8; if (t0 < 0) t0 = 0; lo_w = cw - 8; if (lo_w < 0) lo_w = 0; }
    const unsigned lds0 = (unsigned)(uintptr_t)shm;
    LAS float* tb = (LAS float*)((LAS char*)shm + LDS_TBL);
    LAS float* wsf = (LAS float*)((LAS char*)shm + LDS_WS) + wid * 64;
    if (tid < 256) tb[tid] = tblg[tid];
    const bf16* Qs = (s == 0) ? Q0 : Q1p;
    const bf16* Qw = Qs + (rowbase + q0 + 32 * j) * QP;
    const char* ksrc0 = (const char*)K0 + wid * 1024 + lane * 16;
    const char* ksrc1 = (NS == 2) ? (const char*)K1p + wid * 1024 + lane * 16 : nullptr;
    const char* vsrc = (const char*)V + lane * 16;
    const unsigned kdst = lds0 + LDS_K + wid * 1024, vdst = lds0 + LDS_V;
    bf16x8 qr[4];
#pragma unroll
    for (int d0 = 0; d0 < 4; ++d0) qr[d0] = *reinterpret_cast<const bf16x8*>(&Qw[(long)r32 * QP + d0 * 16 + hi * 8]);
#define ATT_DMA(t, sl) do { \
        glds16p(ksrc0 + (long)(t) * 8192, (unsigned)__builtin_amdgcn_readfirstlane(kdst + (sl) * KSLOT)); \
        if (NS == 2) glds16p(ksrc1 + (long)(t) * 8192, (unsigned)__builtin_amdgcn_readfirstlane(kdst + (sl) * KSLOT + 8192)); \
        _Pragma("unroll") for (int i_ = 0; i_ < NVP; ++i_) { const int p_ = wid + 8 * i_; \
            glds16p(vsrc + (long)(t) * (DV * 128) + p_ * 1024, (unsigned)__builtin_amdgcn_readfirstlane(vdst + (sl) * VSLOT + p_ * 1024)); } \
    } while (0)
    ATT_DMA(t0, 0);
    if (t0 + 1 <= t1) ATT_DMA(t0 + 1, 1);
    f32x16 o[ND];
#pragma unroll
    for (int d = 0; d < ND; ++d) o[d] = f32x16{};
    float l_reg = 0.f;
    LDS_WAIT();
    __builtin_amdgcn_s_barrier();
    asm volatile("" :: "v"(qr[0]), "v"(qr[1]), "v"(qr[2]), "v"(qr[3]));
    const float cfar = tb[255];
    f32x16 cinit;
#pragma unroll
    for (int r = 0; r < 16; ++r) cinit[r] = cfar;
    const lds_cptr shm3 = (lds_cptr)shm;
    const lds_cptr kp0 = shm3 + LDS_K + s * 8192 + hi * 1024 + r32 * 16;
    const lds_cptr vp0 = shm3 + LDS_V + ((lane >> 4) & 1) * 32 + (lane & 3) * 8 + (4 * hi + ((lane & 15) >> 2)) * 64;
    int sl = 0;
    for (int t = t0; t <= t1; ++t) {
        if (t < t1) { if (NS == 2) ATT_WAIT_BAR(4); else ATT_WAIT_BAR(2); } else ATT_WAIT_BAR(0);
        if (t + 2 <= t1) { const int s2 = (sl == 0) ? 2 : sl - 1; ATT_DMA(t + 2, s2); }
        if (t >= lo_w && t <= cw) {
            const lds_cptr kp = kp0 + sl * KSLOT; const lds_cptr vp = vp0 + sl * VSLOT;
            f32x16 p0, p1;
#pragma unroll
            for (int d0 = 0; d0 < 4; ++d0) {
                const bf16x8 b0 = *(const LAS bf16x8*)(kp + d0 * 2048), b1 = *(const LAS bf16x8*)(kp + d0 * 2048 + 512);
                if (d0 == 0) { p0 = __builtin_amdgcn_mfma_f32_32x32x16_bf16(b0, qr[0], cinit, 0, 0, 0); p1 = __builtin_amdgcn_mfma_f32_32x32x16_bf16(b1, qr[0], cinit, 0, 0, 0); }
                else { p0 = __builtin_amdgcn_mfma_f32_32x32x16_bf16(b0, qr[d0], p0, 0, 0, 0); p1 = __builtin_amdgcn_mfma_f32_32x32x16_bf16(b1, qr[d0], p1, 0, 0, 0); }
            }
            if (t >= cw - 2) {
                const LAS float* tp = tb + (64 * (t - cw) + 191 - qi + 4 * hi);
#pragma unroll
                for (int r = 0; r < 16; ++r) { p0[r] += tp[(r & 3) + 8 * (r >> 2)]; p1[r] += tp[32 + (r & 3) + 8 * (r >> 2)]; }
            }
            float sacc = 0.f;
#pragma unroll
            for (int r = 0; r < 16; ++r) { p0[r] = __builtin_amdgcn_exp2f(p0[r]); p1[r] = __builtin_amdgcn_exp2f(p1[r]); sacc += p0[r] + p1[r]; }
            l_reg += sacc;
            u32x4 pw[4];
#pragma unroll
            for (int q = 0; q < 4; ++q) { pw[0][q] = cvtpk(p0[2 * q], p0[2 * q + 1]); pw[1][q] = cvtpk(p0[8 + 2 * q], p0[9 + 2 * q]);
                pw[2][q] = cvtpk(p1[2 * q], p1[2 * q + 1]); pw[3][q] = cvtpk(p1[8 + 2 * q], p1[9 + 2 * q]); }
#pragma unroll
            for (int d0 = 0; d0 < ND; ++d0)
#pragma unroll
                for (int ks = 0; ks < 4; ++ks) {
                    const s16x4 vlo = vtr(vp + d0 * 4096 + ks * 1024), vhi = vtr(vp + d0 * 4096 + ks * 1024 + 512);
                    const bf16x8 vf = (bf16x8){vlo[0], vlo[1], vlo[2], vlo[3], vhi[0], vhi[1], vhi[2], vhi[3]};
                    o[d0] = __builtin_amdgcn_mfma_f32_32x32x16_bf16(__builtin_bit_cast(bf16x8, pw[ks]), vf, o[d0], 0, 0, 0);
                }
        }
        sl = (sl == 2) ? 0 : sl + 1;
    }
#undef ATT_DMA
    { auto rr = __builtin_amdgcn_permlane32_swap(__float_as_uint(l_reg), __float_as_uint(l_reg), false, false); l_reg = __uint_as_float(rr[0]) + __uint_as_float(rr[1]); }
    if (hi == 0) wsf[r32] = l_reg;
    LDS_WAIT();
    float rli[16];
#pragma unroll
    for (int r = 0; r < 16; ++r) rli[r] = __builtin_amdgcn_rcpf(wsf[crow(r, hi)]);
    const long orow0 = rowbase + q0 + 32 * j;
    if (NS == 2) {
        LAS float* X = (LAS float*)((LAS char*)shm + LDS_X);
        asm volatile("s_waitcnt lgkmcnt(0)\n\ts_barrier" ::: "memory");
        if (s == 1) {
#pragma unroll
            for (int d0 = 0; d0 < ND; ++d0)
#pragma unroll
                for (int r = 0; r < 16; ++r) X[((j * ND + d0) * 16 + r) * 64 + lane] = lam * o[d0][r] * rli[r];
        }
        asm volatile("s_waitcnt lgkmcnt(0)\n\ts_barrier" ::: "memory");
        if (s == 0) {
            float gs[ND];
#pragma unroll
            for (int d0 = 0; d0 < ND; ++d0) gs[d0] = gsub[32 * d0 + r32] * 0.8f;
#pragma unroll
            for (int r = 0; r < 16; ++r) {
                float ss = 0.f;
#pragma unroll
                for (int d0 = 0; d0 < ND; ++d0) { o[d0][r] = o[d0][r] * rli[r] - X[((j * ND + d0) * 16 + r) * 64 + lane]; ss += o[d0][r] * o[d0][r]; }
#pragma unroll
                for (int m = 1; m < 32; m <<= 1) ss += __shfl_xor(ss, m);
                const float rs = __builtin_amdgcn_rsqf(ss * (1.f / DV) + EPS);
                bf16* op = OUT + (orow0 + crow(r, hi)) * 1024 + r32;
#pragma unroll
                for (int d0 = 0; d0 < ND; ++d0) op[32 * d0] = (bf16)(cvtpk(o[d0][r] * rs * gs[d0], 0.f) & 0xffffu);
            }
        }
    } else {
#pragma unroll
        for (int r = 0; r < 16; ++r) {
            bf16* op = OUT + (orow0 + crow(r, hi)) * 1024 + r32;
#pragma unroll
            for (int d0 = 0; d0 < ND; ++d0) op[32 * d0] = (bf16)(cvtpk(o[d0][r] * rli[r], 0.f) & 0xffffu);
        }
    }
    asm volatile("s_waitcnt vmcnt(0) lgkmcnt(0)\n\ts_barrier" ::: "memory");
}


constexpr int LDS_CONV = 101376, CONV_PITCH = 1040, CONV_BUF = 8 * CONV_PITCH, CONV_N = 96;
struct ConvState { int jd, jc, bd, bc, sgu, sd, dgu, dd; unsigned long long wg, d1, d2, WGUT, WDT; };
__device__ __forceinline__ void conv_init(ConvState& cv, int c, int wid, const float* wg, const float* wu, const float* wd, bf16* WGUT, bf16* WDT) {
    cv.jd = 0; cv.jc = 0; cv.bd = 0; cv.bc = 0; cv.wg = (unsigned long long)(uintptr_t)wg; cv.d1 = (unsigned long long)(uintptr_t)wu - cv.wg; cv.d2 = (unsigned long long)(uintptr_t)wd - (unsigned long long)(uintptr_t)wu;
    cv.WGUT = (unsigned long long)(uintptr_t)WGUT; cv.WDT = (unsigned long long)(uintptr_t)WDT;
    cv.sgu = (64 * (c >> 4) + 8 * wid) * 512 + 32 * (c & 15); cv.sd = (64 * (c >> 5) + 8 * wid) * 1024 + 32 * (c & 31);
    { const int n0 = 32 * (c & 15); cv.dgu = ((n0 >> 7) * 256 + (n0 & 127)) * 1024 + 64 * (c >> 4); } cv.dd = (32 * (c & 31)) * 512 + 64 * (c >> 5);
}
__device__ __forceinline__ void conv_dma(ConvState& cv, int wid, int lane, unsigned lds0) {
    const int j = cv.jd; const bool gu = j < 64;
    unsigned long long a = cv.wg + ((unsigned long long)(j & 31) * 524288ull + (unsigned long long)(gu ? cv.sgu : cv.sd)) * 4ull;
    a += (j >= 32) ? cv.d1 : 0ull; a += (j >= 64) ? cv.d2 : 0ull;
    glds16((const void*)(uintptr_t)a, (unsigned)((lane >> 3) * (gu ? 2048 : 4096) + (lane & 7) * 16), (unsigned)__builtin_amdgcn_readfirstlane(lds0 + LDS_CONV + cv.bd + wid * CONV_PITCH));
    cv.jd = j + 1; cv.bd = (cv.bd == 2 * CONV_BUF) ? 0 : cv.bd + CONV_BUF;
}
__device__ __forceinline__ void conv_convert(ConvState& cv, bool mine, int wsel, int lane, char* shm) {
    const int j = cv.jc;
    if (mine) {
        const bool gu = j < 64;
        const int nl = 8 * wsel + (lane >> 3), kc = lane & 7;
        const LAS char* p = (const LAS char*)shm + LDS_CONV + cv.bc + kc * CONV_PITCH + (nl >> 2) * 16 + (nl & 3) * 4;
        float f[8];
#pragma unroll
        for (int i = 0; i < 8; ++i) f[i] = *(const LAS float*)(p + 128 * i);
        u32x4 o; o.x = cvtpk(f[0], f[1]); o.y = cvtpk(f[2], f[3]); o.z = cvtpk(f[4], f[5]); o.w = cvtpk(f[6], f[7]);
        const unsigned long long eoff = gu ? ((unsigned long long)(j & 31) * 1048576ull + (unsigned long long)(j >> 5) * 131072ull + (unsigned long long)cv.dgu) : ((unsigned long long)(j & 31) * 524288ull + (unsigned long long)cv.dd);
        const unsigned long long pa = (gu ? cv.WGUT : cv.WDT) + eoff * 2ull;
        *(GAS u32x4*)(uintptr_t)(pa + (unsigned long long)(nl * (gu ? 2048 : 1024) + kc * 16)) = o;
    }
    cv.jc = j + 1; cv.bc = (cv.bc == 2 * CONV_BUF) ? 0 : cv.bc + CONV_BUF;
}
template <int NS, int DV, int QP, int VP>
__device__ __forceinline__ void attn_unit_pipe(const bf16* Q0, const bf16* Q1p, const bf16* K0, const bf16* K1p, const bf16* V, long rowbase, int q0,
                                          const float* tblg, const float* gsub, float lam, bf16* OUT  , char* shm, ConvState& cv, const int wv) {
    constexpr int KSLOT = NS * 8192, VSLOT = DV * 128, ND = DV / 32, NVP = DV / 64, NG = 4 * ND, EPG = 32 / NG, CPG = EPG / 2, LAG = NG / 4;
    const int lane = lane_now(), wid = wv, tid = wid * 64 + lane, r32 = lane & 31, hi = lane >> 5;
    const int s = (NS == 2) ? (wid >> 2) : 0, j = (NS == 2) ? (wid & 3) : wid;
    const int ROWS = (NS == 2) ? 128 : 256;
    const int cw = (q0 + 32 * j) >> 6, qi = ((32 * j) & 63) + r32;
    const int t1 = (q0 + ROWS - 1) >> 6;
    int t0 = 0, lo_w = 0;
    if (NS == 1) { t0 = (q0 >> 6) - 8; if (t0 < 0) t0 = 0; lo_w = cw - 8; if (lo_w < 0) lo_w = 0; }
    const unsigned lds0 = (unsigned)(uintptr_t)shm;
    LAS float* tb = (LAS float*)((LAS char*)shm + LDS_TBL);
    if (tid < 256) tb[tid] = tblg[tid];
    const bf16* Qs = (s == 0) ? Q0 : Q1p;
    const bf16* Qw = Qs + (rowbase + q0 + 32 * j) * QP;
    const unsigned koff = (unsigned)(wid * 1024 + lane * 16);
    unsigned voffv[NVP];
#pragma unroll
    for (int i_ = 0; i_ < NVP; ++i_) voffv[i_] = (unsigned)((wid + 8 * i_) * 1024 + lane * 16);
    const char* kb0 = (const char*)K0; const char* kb1 = (const char*)K1p; const char* vb = (const char*)V;
    const unsigned kdst = lds0 + LDS_K + wid * 1024, vdst = lds0 + LDS_V;
    bf16x8 qr[4];
#pragma unroll
    for (int d0 = 0; d0 < 4; ++d0) qr[d0] = *reinterpret_cast<const bf16x8*>(&Qw[(long)r32 * QP + d0 * 16 + hi * 8]);
#define ATT_DMA_K(t, sl) do { \
        glds16(kb0 + (long)(t) * 8192, koff, (unsigned)__builtin_amdgcn_readfirstlane(kdst + (sl) * KSLOT)); \
        if (NS == 2) glds16(kb1 + (long)(t) * 8192, koff, (unsigned)__builtin_amdgcn_readfirstlane(kdst + (sl) * KSLOT + 8192)); } while (0)
#define ATT_DMA_V(t, sl) do { \
        _Pragma("unroll") for (int i_ = 0; i_ < NVP; ++i_) { const int p_ = wid + 8 * i_; \
            glds16(vb + (long)(t) * (DV * 128), voffv[i_], (unsigned)__builtin_amdgcn_readfirstlane(vdst + (sl) * VSLOT + p_ * 1024)); } } while (0)
    ATT_DMA_K(t0, 0); ATT_DMA_V(t0, 0);
    if (t0 + 1 <= t1) ATT_DMA_K(t0 + 1, 1);
    if (t0 + 2 <= t1) ATT_DMA_K(t0 + 2, 2);
    f32x16 o[ND];
#pragma unroll
    for (int d = 0; d < ND; ++d) o[d] = f32x16{};
    float l_reg = 0.f;
    ATT_WAIT_BAR(0);
    asm volatile("" :: "v"(qr[0]), "v"(qr[1]), "v"(qr[2]), "v"(qr[3]));
    const lds_cptr shm3 = (lds_cptr)shm;
    const lds_cptr kp0 = shm3 + LDS_K + s * 8192 + hi * 1024 + r32 * 16;
    const lds_cptr vp0 = shm3 + LDS_V + ((lane >> 4) & 1) * 32 + (lane & 3) * 8 + (4 * hi + ((lane & 15) >> 2)) * 64;
    bf16x8 kf[8];
#define ATT_KRD(i, kp) do { kf[i] = *(const LAS bf16x8*)((kp) + ((i) >> 1) * 2048 + ((i) & 1) * 512); } while (0)
#pragma unroll
    for (int i = 0; i < 8; ++i) ATT_KRD(i, kp0);
    ATT_WAIT_BAR(0);
    f32x16 S0, S1;
    const f32x16 z16 = f32x16{};
    u32x4 pw[4];
#define ATT_VRD(g) do { vlo[g] = vtr(vp + ((g) % ND) * 4096 + ((g) / ND) * 1024); vhi[g] = vtr(vp + ((g) % ND) * 4096 + ((g) / ND) * 1024 + 512); } while (0)
#define ATT_VF(g) (bf16x8){vlo[g][0], vlo[g][1], vlo[g][2], vlo[g][3], vhi[g][0], vhi[g][1], vhi[g][2], vhi[g][3]}
#define ATT_NEAR(t) do { if ((t) >= cw - 2) { const LAS float* tp = tb + (64 * ((t) - cw) + 191 - qi + 4 * hi); asm volatile("" : "+v"(tp));   \
            _Pragma("unroll") for (int r = 0; r < 16; ++r) { S0[r] += tp[(r & 3) + 8 * (r >> 2)]; S1[r] += tp[32 + (r & 3) + 8 * (r >> 2)]; } } } while (0)
#define ATT_ENDW(t) do { if ((t) + 3 <= t1) { ATT_WAIT_BAR(4); } else if ((t) + 1 <= t1) { ATT_WAIT_BAR(2); } else { ATT_WAIT_BAR(0); } } while (0)
    static_assert(NS == 2 && DV == 128, "pipelined unit: differential attention only");
    { const int tk_ = (t0 + 3 <= t1) ? t0 + 3 : t1, tv_ = (t0 + 1 <= t1) ? t0 + 1 : t1; ATT_DMA_K(tk_, 0); ATT_DMA_V(tv_, 1); }
    {
        S0 = ATT_MFMA(kf[0], qr[0], z16); S1 = ATT_MFMA(kf[1], qr[0], z16);
#pragma unroll
        for (int d0 = 1; d0 < 4; ++d0) { S0 = ATT_MFMA(kf[2 * d0], qr[d0], S0); S1 = ATT_MFMA(kf[2 * d0 + 1], qr[d0], S1); }
        ATT_NEAR(t0);
#pragma unroll
        for (int r = 0; r < 16; ++r) { S0[r] = __builtin_amdgcn_exp2f(S0[r]); S1[r] = __builtin_amdgcn_exp2f(S1[r]); l_reg += S0[r] + S1[r]; }
#pragma unroll
        for (int q = 0; q < 4; ++q) { pw[0][q] = cvtpk(S0[2 * q], S0[2 * q + 1]); pw[1][q] = cvtpk(S0[8 + 2 * q], S0[9 + 2 * q]); pw[2][q] = cvtpk(S1[2 * q], S1[2 * q + 1]); pw[3][q] = 0u; }
        const lds_cptr kpn = kp0 + 1 * KSLOT;
#pragma unroll
        for (int i = 0; i < 8; ++i) ATT_KRD(i, kpn);
    }
#define ATT_STEP_O() do { \
        if (cv.jc < CONV_N && cv.jc + 2 <= cv.jd) conv_convert(cv, (wid >> 2) == (cv.jc & 1), wid & 3, lane, shm); \
        { const int tk = (t + 3 <= t1) ? t + 3 : t1, tv = (t + 1 <= t1) ? t + 1 : t1; ATT_DMA_K(tk, sl); ATT_DMA_V(tv, sln); } \
        if (cd) conv_dma(cv, wid, lane, lds0); else if (cv.jd < CONV_N + 2) cv.jd += 1; } while (0)
#define ATT_STEP_A(TT, VR) do { \
        ATT_SB(); \
        {   const f32x16 So = S1; \
            S0 = ATT_MFMA(kf[0], qr[0], z16); \
            pw[3][0] = cvtpk(So[8], So[9]); pw[3][1] = cvtpk(So[10], So[11]); pw[3][2] = cvtpk(So[12], So[13]); pw[3][3] = cvtpk(So[14], So[15]); ATT_PIN(pw[3]); ATT_SB(); } \
        S1 = ATT_MFMA(kf[1], qr[0], z16); ATT_SB(); \
        S0 = ATT_MFMA(kf[2], qr[1], S0); ATT_SB(); \
        S1 = ATT_MFMA(kf[3], qr[1], S1); ATT_SB(); \
        S0 = ATT_MFMA(kf[4], qr[2], S0); ATT_SB(); \
        S1 = ATT_MFMA(kf[5], qr[2], S1); if (VR) ATT_VRD(0); ATT_SB(); \
        S0 = ATT_MFMA(kf[6], qr[3], S0); if (VR) ATT_VRD(1); ATT_SB(); \
        S1 = ATT_MFMA(kf[7], qr[3], S1); ATT_SB(); \
        if ((TT) <= cw) ATT_NEAR(TT); \
        ATT_SB(); } while (0)
#define ATT_STEP_B() do { \
        _Pragma("unroll") for (int g = 0; g < NG; ++g) { \
            o[g % ND] = ATT_MFMA(__builtin_bit_cast(bf16x8, pw[g / ND]), ATT_VF(g), o[g % ND]); \
            if (g + VAHEAD < NG) ATT_VRD(g + VAHEAD); \
            _Pragma("unroll") for (int e = g * EPG; e < (g + 1) * EPG; ++e) { if (e < 16) { S0[e] = __builtin_amdgcn_exp2f(S0[e]); } else { S1[e - 16] = __builtin_amdgcn_exp2f(S1[e - 16]); } } \
            _Pragma("unroll") for (int e = g * EPG; e < (g + 1) * EPG; ++e) { if (e < 16) l_reg += S0[e]; else l_reg += S1[e - 16]; } \
            if (g >= LAG) { \
                _Pragma("unroll") for (int q = (g - LAG) * CPG; q < (g - LAG + 1) * CPG; ++q) { if (q < 8) pw[q >> 2][q & 3] = cvtpk(S0[2 * q], S0[2 * q + 1]); else pw[q >> 2][q & 3] = cvtpk(S1[2 * q - 16], S1[2 * q - 15]); } \
            } \
            if (g >= 2 && g < 10) ATT_KRD(g - 2, kpn); \
            ATT_PIN(S0); ATT_PIN(S1); ATT_PIN(l_reg); \
            if (g >= LAG) { ATT_PIN(pw[(((g - LAG) * CPG) >> 2)]); } \
            ATT_SB(); \
        } } while (0)
    constexpr int VAHEAD = 2;
    if (s == 1) { const lds_cptr vp = vp0; s16x4 vlo[NG], vhi[NG]; (void)vp; (void)vlo; (void)vhi; ATT_STEP_A(t0 + 1, false); }
    ATT_WAIT_BAR(4);
    if (s == 0) {
        int sl = 1;
        for (int t = t0 + 1; t <= t1 + 1; ++t) {
            const int slp = (sl == 0) ? 2 : sl - 1, sln = (sl == 2) ? 0 : sl + 1;
            const bool cd = cv.jd < CONV_N;
            const lds_cptr vp = vp0 + slp * VSLOT;
            const lds_cptr kpn = kp0 + sln * KSLOT;
            s16x4 vlo[NG], vhi[NG];
            ATT_STEP_O();
            if (t - 1 <= cw) { const float l_keep = l_reg; ATT_STEP_A(t, true); ATT_STEP_B(); if (t > cw) l_reg = l_keep; }
            if (cd) { ATT_WAIT_BAR(5); } else { ATT_WAIT_BAR(4); }
            sl = sln;
        }
    } else {
        int sl = 1;
        for (int t = t0 + 1; t <= t1 + 1; ++t) {
            const int slp = (sl == 0) ? 2 : sl - 1, sln = (sl == 2) ? 0 : sl + 1;
            const bool cd = cv.jd < CONV_N;
            const lds_cptr vp = vp0 + slp * VSLOT;
            const lds_cptr kpn = kp0 + sln * KSLOT;
            s16x4 vlo[NG], vhi[NG];
            if (t - 1 <= cw) { const float l_keep = l_reg; ATT_SB(); ATT_VRD(0); ATT_VRD(1); ATT_SB(); ATT_STEP_B(); if (t > cw) l_reg = l_keep; }
            ATT_STEP_O();
            if (t <= cw) ATT_STEP_A(t + 1, false);
            if (cd) { ATT_WAIT_BAR(5); } else { ATT_WAIT_BAR(4); }
            sl = sln;
        }
    }
#undef ATT_STEP_O
#undef ATT_STEP_A
#undef ATT_STEP_B
#undef ATT_ENDW
    ATT_WAIT_BAR(0);
#undef ATT_DMA_K
#undef ATT_DMA_V
#undef ATT_VRD
#undef ATT_VF
#undef ATT_NEAR
#undef ATT_KRD
    { auto rr = __builtin_amdgcn_permlane32_swap(__float_as_uint(l_reg), __float_as_uint(l_reg), false, false); l_reg = __uint_as_float(rr[0]) + __uint_as_float(rr[1]); }
    const int lane_e = lane_now();
    const int r32e = lane_e & 31, hie = lane_e >> 5;
    LAS float* wsfe = (LAS float*)((LAS char*)shm + LDS_WS) + wid * 64;
    if (hie == 0) wsfe[r32e] = l_reg;
    LDS_WAIT();
    float rli[16];
#pragma unroll
    for (int r = 0; r < 16; ++r) rli[r] = __builtin_amdgcn_rcpf(wsfe[crow(r, hie)]);
    bf16* obase = OUT + (rowbase + q0 + 32 * j + 4 * hie) * 1024 + r32e;
    if (NS == 2) {
        LAS float* X = (LAS float*)((LAS char*)shm + LDS_X);
        if (s == 1) {
#pragma unroll
            for (int d0 = 0; d0 < ND; ++d0)
#pragma unroll
                for (int r = 0; r < 16; ++r) X[((j * ND + d0) * 16 + r) * 64 + lane_e] = lam * o[d0][r] * rli[r];
        }
        asm volatile("s_waitcnt lgkmcnt(0)\n\ts_barrier" ::: "memory");
        if (s == 0) {
            float gs[ND];
#pragma unroll
            for (int d0 = 0; d0 < ND; ++d0) gs[d0] = gsub[32 * d0 + r32e] * 0.8f;
#pragma unroll
            for (int r = 0; r < 16; ++r) {
                float ss = 0.f;
#pragma unroll
                for (int d0 = 0; d0 < ND; ++d0) { o[d0][r] = o[d0][r] * rli[r] - X[((j * ND + d0) * 16 + r) * 64 + lane_e]; ss += o[d0][r] * o[d0][r]; }
#pragma unroll
                for (int m = 1; m < 32; m <<= 1) ss += __int_as_float(__builtin_amdgcn_ds_bpermute((lane_e ^ m) << 2, __float_as_int(ss)));
                const float rs = __builtin_amdgcn_rsqf(ss * (1.f / DV) + EPS);
                bf16* op = obase + ((r & 3) + 8 * (r >> 2)) * 1024;
#pragma unroll
                for (int d0 = 0; d0 < ND; ++d0) op[32 * d0] = (bf16)(cvtpk(o[d0][r] * rs * gs[d0], 0.f) & 0xffffu);
            }
        }
    } else {
#pragma unroll
        for (int r = 0; r < 16; ++r) {
            bf16* op = obase + ((r & 3) + 8 * (r >> 2)) * 1024;
#pragma unroll
            for (int d0 = 0; d0 < ND; ++d0) op[32 * d0] = (bf16)(cvtpk(o[d0][r] * rli[r], 0.f) & 0xffffu);
        }
    }
    asm volatile("s_waitcnt vmcnt(0) lgkmcnt(0)\n\ts_barrier" ::: "memory");
}
}

__device__ __forceinline__ unsigned f2bf(float f) { unsigned u = __builtin_bit_cast(unsigned, f); return (u + 0x7fffu + ((u >> 16) & 1u)) >> 16; }
__device__ __forceinline__ unsigned pk2(float lo, float hi) { return f2bf(lo) | (f2bf(hi) << 16); }
struct TrItem { const GAS f32x4* src; GAS u32x4* d; int ls, ds; };
__device__ __forceinline__ TrItem tr_item(const float* W, int ldw, int k0, int n0, bf16* dst, int ldd, int drow0, int kd0, int lane) {
    const int kc = lane >> 3, nq = lane & 7; TrItem t;
    t.src = (const GAS f32x4*)(W + (size_t)(k0 + 8 * kc) * ldw + n0 + 4 * nq); t.ls = ldw / 4;
    t.d = (GAS u32x4*)(dst + (size_t)(drow0 + 4 * nq) * ldd + kd0 + 8 * kc); t.ds = ldd / 8; return t;
}
__device__ __forceinline__ void tr_load(const TrItem& t, f32x4 (&v)[8]) {
#pragma unroll
    for (int i = 0; i < 8; ++i) v[i] = t.src[(size_t)i * t.ls];
}
__device__ __forceinline__ void tr_store(const TrItem& t, const f32x4 (&v)[8]) {
#pragma unroll
    for (int j = 0; j < 4; ++j) { u32x4 o; o.x = cvt_pk_bf16(v[0][j], v[1][j]); o.y = cvt_pk_bf16(v[2][j], v[3][j]); o.z = cvt_pk_bf16(v[4][j], v[5][j]); o.w = cvt_pk_bf16(v[6][j], v[7][j]);
        t.d[(size_t)j * t.ds] = o; }
}
__device__ __forceinline__ int t5_bucket(int rel) {
    const int side = rel > 0 ? 16 : 0; const int n = rel < 0 ? -rel : rel;
    int b;
    if (n < 8) b = n; else if (n < 12) b = 8; else if (n < 16) b = 9; else if (n < 23) b = 10; else if (n < 32) b = 11; else if (n < 46) b = 12; else if (n < 64) b = 13; else if (n < 91) b = 14; else b = 15;
    return side + b;
}

struct Args { const float* in[22]; float* out; unsigned char* ws; int ph_lo, ph_hi; };

__global__ void __launch_bounds__(512, 2) mk_fwd(Args args) {
    extern __shared__ __attribute__((aligned(16))) unsigned char lds_raw[];
    LAS unsigned char* lds = (LAS unsigned char*)lds_raw;
    volatile LAS unsigned* MISC = (volatile LAS unsigned*)(lds + MISC_OFF);
    const int wave = __builtin_amdgcn_readfirstlane((int)threadIdx.x >> 6);
#define MK_LANE_TID() const int lane = lane_now(), tid = wave * 64 + lane; (void)tid
    const int G = gridDim.x; const int bx = blockIdx.x; const int vcu = (G % 8 == 0) ? (bx % 8) * (G / 8) + bx / 8 : bx;
    unsigned char* ws = args.ws;
    unsigned* ctl = (unsigned*)(ws + WS_CTL);
    { MK_LANE_TID(); for (int u = tid; u < 64; u += 512) ((LAS unsigned*)(lds + MISC_OFF))[u] = 0u; }
    __syncthreads();
    XcdBarrier bar; bar.bar = ctl + CW_BAR; bar.x = 0; bar.st = nullptr; bar.w0 = (wave == 0);
    if (MK_N_LAUNCHES == 1) bar = xcd_barrier_post(ctl + CW_BAR, MISC + 8, wave == 0);
    const int lo = args.ph_lo, hi = args.ph_hi;
    unsigned long long ts_a = 0, ts_b = 0;
#define IN(k) (lo <= (k) && (k) < hi)
#define SEAM(k) do { if (MK_N_LAUNCHES == 1 && IN(k) && IN((k) + 1)) xcd_barrier(bar); } while (0)

    const float* x = args.in[0];
    float* out = args.out;
    bf16* WINT = (bf16*)(ws + WS_WINT); bf16* WABT = (bf16*)(ws + WS_WABT); bf16* WOT = (bf16*)(ws + WS_WOT); bf16* WGUT = (bf16*)(ws + WS_WGUT); bf16* WDT = (bf16*)(ws + WS_WDT);
    bf16* XB = (bf16*)(ws + WS_XB); bf16* OAB = (bf16*)(ws + WS_OAB); bf16* QK = (bf16*)(ws + WS_QK); bf16* MIXED = (bf16*)(ws + WS_MIXED);
    bf16* VA = (bf16*)(ws + WS_VA); bf16* QBb = (bf16*)(ws + WS_QB); bf16* KBb = (bf16*)(ws + WS_KB); bf16* VBb = (bf16*)(ws + WS_VB);
    bf16* HN = (bf16*)out;
    bf16* HB = (bf16*)(ws + WS_H); bf16* YB = (bf16*)(ws + WS_Y); bf16* AO = (bf16*)(ws + WS_AO);
    bf16* GATES = (bf16*)out;
    float* TBLA = (float*)(ws + WS_TBLA); float* TBLB = (float*)(ws + WS_TBLB); float* LAMV = (float*)(ws + WS_LAM);
    bf16* WRH = (bf16*)(ws + WS_WR); bf16* WRL = WRH + 48 * 1024; float* LISTR = (float*)(ws + WS_LISTR);
    int* TOKPOS = (int*)(ws + WS_TOKPOS); int* LISTTOK = (int*)(ws + WS_LISTTOK); float* LISTW = (float*)(ws + WS_LISTW); unsigned* CURSOR = ctl + CW_CURSOR;

    if (TS_PHASE == 0) ts_a = __builtin_amdgcn_s_memrealtime();
    if (IN(0)) for (int rep = 0; rep < REP0; ++rep) { MK_LANE_TID();
        const int gw = vcu * 8 + wave, NGW = G * 8;
        constexpr int I_IN = 16 * 160, I_A = 8 * 32, I_B = 8 * 32, I_O = 16 * 32;
        constexpr int NITEMS = I_IN + I_A + I_B + I_O;
        static_assert(I_IN % 2 == 0 && I_A % 2 == 0 && I_B % 2 == 0 && I_O % 2 == 0, "batches of 2 items never straddle two matrices");
        for (int bt = gw; bt < NITEMS / 2; bt += NGW) {
            TrItem ti[2];
#pragma unroll
            for (int u = 0; u < 2; ++u) {
                int r = bt * 2 + u;
                if (r < I_IN) { const int kb = r / 160, nb = r % 160, n0 = 32 * nb, pn = n0 >> 8, cg = (n0 & 255) >> 5, wcc = cg >> 1, bjj = cg & 1;
                    ti[u] = tr_item(args.in[2], PROJ, 64 * kb, n0, WINT, 1024, pn * 256 + (pn >= 12 ? 32 * cg : 128 * bjj + 32 * wcc), 64 * kb, lane); }
                else if ((r -= I_IN) < I_A) { const int kb = r / 32, nb = r % 32; ti[u] = tr_item(args.in[11], 1024, 64 * kb, 32 * nb, WABT, 1024, 32 * nb, 64 * kb, lane); }
                else if ((r -= I_A) < I_B) { const int kb = r / 32, nb = r % 32; ti[u] = tr_item(args.in[12], 1024, 64 * kb, 32 * nb, WABT, 1024, 32 * nb, 512 + 64 * kb, lane); }
                else { r -= I_B; const int kb = r / 32, nb = r % 32; ti[u] = tr_item(args.in[13], 1024, 64 * kb, 32 * nb, WOT, 1024, 32 * nb, 64 * kb, lane); }
            }
            f32x4 v[2][8];
#pragma unroll
            for (int u = 0; u < 2; ++u) tr_load(ti[u], v[u]);
#pragma unroll
            for (int u = 0; u < 2; ++u) tr_store(ti[u], v[u]);
        }
        {   const GAS f32x4* gr = (const GAS f32x4*)args.in[1] + lane; f32x4 gg[4];
#pragma unroll
            for (int j = 0; j < 4; ++j) gg[j] = gr[64 * j];
            for (int m0 = gw * 4; m0 < T; m0 += NGW * 4) {
                f32x4 v[4][4];
#pragma unroll
                for (int u = 0; u < 4; ++u) { const GAS f32x4* xr = (const GAS f32x4*)(x + (size_t)(m0 + u) * D) + lane;
#pragma unroll
                    for (int j = 0; j < 4; ++j) v[u][j] = xr[64 * j]; }
#pragma unroll
                for (int u = 0; u < 4; ++u) { float ssq = 0.f;
#pragma unroll
                    for (int j = 0; j < 4; ++j) ssq += (v[u][j].x * v[u][j].x + v[u][j].y * v[u][j].y) + (v[u][j].z * v[u][j].z + v[u][j].w * v[u][j].w);
                    const float rstd = __builtin_amdgcn_rsqf(wave_sum(ssq) * (1.f / D) + EPS);
                    GAS u32x2* o8 = (GAS u32x2*)(XB + (size_t)(m0 + u) * D) + lane;
#pragma unroll
                    for (int j = 0; j < 4; ++j) { u32x2 w; w.x = cvt_pk_bf16(v[u][j].x * rstd * gg[j].x, v[u][j].y * rstd * gg[j].y); w.y = cvt_pk_bf16(v[u][j].z * rstd * gg[j].z, v[u][j].w * rstd * gg[j].w); o8[64 * j] = w; } }
            }
        }
        for (int idx = gw * 64 + lane; idx < 48 * 1024; idx += NGW * 64) { const int n = idx >> 10, k = idx & 1023; float w = 0.f;
            if (n < 32) w = args.in[17][k * 32 + n]; else if (n < 36) w = args.in[15][k * 4 + (n - 32)];
            w *= args.in[14][k]; const unsigned hb = cvt_pk_bf16(w, 0.f) & 0xffffu; WRH[idx] = (bf16)hb; WRL[idx] = (bf16)(cvt_pk_bf16(w - __uint_as_float(hb << 16), 0.f) & 0xffffu); }
        for (int idx = gw * 64 + lane; idx < 12 * 256; idx += NGW * 64) {
            const int hh = idx >> 8, i = idx & 255; const bool isA = hh < 4; const int h = isA ? hh : hh - 4;
            const float farv = isA ? args.in[7][15 * 4 + h] : args.in[10][0 * 8 + h];
            float v;
            if (i == 255) v = farv * LOG2E;
            else { const int rel = i - 191; float b;
                if (isA) b = args.in[7][t5_bucket(rel) * 4 + h];
                else { int ri = rel < -128 ? -128 : (rel > 128 ? 128 : rel); b = args.in[10][(ri + 128) * 8 + h]; }
                v = (b - farv) * LOG2E; }
            (isA ? TBLA : TBLB)[h * 256 + i] = v;
        }
        if (gw == 0) { const float* lp = args.in[5]; const float a = wave_sum(lp[lane] * lp[64 + lane]), b = wave_sum(lp[128 + lane] * lp[192 + lane]);
            if (lane == 0) LAMV[0] = expf(a) - expf(b) + 0.2f; }
    }
    SEAM(0);
    if (TS_PHASE == 0) ts_b = __builtin_amdgcn_s_memrealtime();

    if (TS_PHASE == 1 || (TS_PHASE >= 120 && TS_PHASE <= 129)) ts_a = __builtin_amdgcn_s_memrealtime();
    if (IN(1)) for (int rep = 0; rep < REP1; ++rep) { MK_LANE_TID();
        pg8::DenseSched S{(const char*)XB, (const char*)WINT, 1024, 1024, T / 256, PROJ / 256, G, bx, 1, 1024};
        EpiProj E{QK, VA, QBb, KBb, VBb, GATES, args.in[3], args.in[4], args.in[8], args.in[9]};
        pg8::gemm_phase<EpiProj, pg8::DenseSched, true>(lds, 1024, S, E, wave);
    }
    SEAM(1);
    if (TS_PHASE >= 120 && TS_PHASE <= 129) ts_b = *(LAS unsigned long long*)(lds + MISC_OFF + 128);
    if (TS_PHASE == 1) ts_b = __builtin_amdgcn_s_memrealtime();

    if (TS_PHASE == 2) ts_a = __builtin_amdgcn_s_memrealtime();
    if (IN(2)) { MK_LANE_TID();
        const float lam = LAMV[0];
        att::ConvState cv; att::conv_init(cv, vcu, wave, args.in[19], args.in[20], args.in[21], WGUT, WDT);
        for (int i = 0; i < 2 * REP2A; ++i) {
            const int uidx = vcu; const int bh = uidx >> 5, sidx = uidx & 31; const int qb = ((i & 1) == 0) ? sidx : 63 - sidx;
            const int b = bh >> 2, h = bh & 3;
            if (vcu < 256)
            att::attn_unit_pipe<2, 128, 256, 512>(QK + h * 64, QK + (size_t)T * 256 + h * 64, QK + (size_t)2 * T * 256 + (size_t)(b * 4 + h) * 128 * 4096, QK + (size_t)3 * T * 256 + (size_t)(b * 4 + h) * 128 * 4096, VA + (size_t)(b * 4 + h) * 128 * 8192,
                                              (long)b * SEQ, qb * 128, TBLA + h * 256, args.in[6], lam, OAB + h * 128, (char*)lds_raw, cv, wave);
        }
        while (cv.jc < att::CONV_N) {
            asm volatile("s_waitcnt vmcnt(0) lgkmcnt(0)\n\ts_barrier" ::: "memory");
            const int ln = lane_now();
            if (cv.jc + 2 <= cv.jd) att::conv_convert(cv, wave < 4, wave & 3, ln, (char*)lds_raw);
            if (cv.jd < att::CONV_N) att::conv_dma(cv, wave, ln, (unsigned)(uintptr_t)(char*)lds_raw); else if (cv.jd < att::CONV_N + 2) cv.jd += 1;
        }
        asm volatile("s_waitcnt vmcnt(0) lgkmcnt(0)\n\ts_barrier" ::: "memory");
        for (int i = 0; i < 2 * REP2B; ++i) {
            int vcu2 = vcu; asm volatile("" : "+s"(vcu2));
            const int uidx = vcu2 * 2 + (i & 1); const int bh = uidx >> 5, grp = uidx & 31; const int b = bh >> 3, h = bh & 7;
            if (vcu2 < 256)
            att::attn_unit_simple<1, 64, 512, 512>(QBb + h * 64, nullptr, KBb + (size_t)(b * 8 + h) * 128 * 4096, nullptr, VBb + (size_t)(b * 8 + h) * 128 * 4096, (long)b * SEQ, grp * 256, TBLB + h * 256, nullptr, 0.f, OAB + 512 + h * 64, (char*)lds_raw, wave);
        }
    }
    SEAM(2);
    if (TS_PHASE == 2) ts_b = __builtin_amdgcn_s_memrealtime();

    if (TS_PHASE == 3 || TS_PHASE == 107) ts_a = __builtin_amdgcn_s_memrealtime();
    if (IN(3)) for (int rep = 0; rep < REP3; ++rep) { MK_LANE_TID();
        pg8::DenseSched S{(const char*)OAB, (const char*)WABT, 1024, 1024, T / 256, D / 256, G, bx, 2, 512};
        EpiAB E{GATES, MIXED, ctl + CW_MIXCTR};
        pg8::gemm_phase<EpiAB, pg8::DenseSched, true>(lds, 512, S, E, wave);
        if (TS_PHASE == 107) { __syncthreads(); ts_b = __builtin_amdgcn_s_memrealtime(); }
    }
    if (TS_PHASE == 3) ts_b = __builtin_amdgcn_s_memrealtime();

#define TILE_WAIT2(p0, p1) do { if (wave == 0) { unsigned* cps_[2] = {(p0), (p1)}; \
            _Pragma("unroll") for (int w_ = 0; w_ < 2; ++w_) { unsigned spins_ = 0; \
                while ((unsigned)__builtin_amdgcn_readfirstlane(__hip_atomic_load(cps_[w_], __ATOMIC_RELAXED, __HIP_MEMORY_SCOPE_AGENT)) < 32u) { __builtin_amdgcn_s_sleep(2); if (++spins_ > (1u << 22)) break; } } \
            __builtin_amdgcn_fence(__ATOMIC_ACQUIRE, "agent"); asm volatile("s_waitcnt vmcnt(0)" ::: "memory"); } \
        __syncthreads(); } while (0)
    if (TS_PHASE == 4 || TS_PHASE == 108) ts_a = __builtin_amdgcn_s_memrealtime();
    if (IN(4)) for (int rep = 0; rep < REP4; ++rep) { MK_LANE_TID();
        pg8::DenseSched S{(const char*)MIXED, (const char*)WOT, 1024, 1024, T / 256, D / 256, G, bx, 1, 1024};
        { pg8::Unit u0; if (S.next(0, u0)) { unsigned* cp = ctl + CW_MIXCTR + 64 * u0.pm; TILE_WAIT2(cp, cp); } else { __syncthreads(); } }
        EpiAO E{AO, ctl + CW_AOCTR};
        pg8::gemm_phase<EpiAO, pg8::DenseSched, true>(lds, 1024, S, E, wave);
        if (TS_PHASE == 108) { __syncthreads(); ts_b = __builtin_amdgcn_s_memrealtime(); }
    }
    if (TS_PHASE == 4) ts_b = __builtin_amdgcn_s_memrealtime();

    if (TS_PHASE == 5 || TS_PHASE == 105 || TS_PHASE == 106) ts_a = __builtin_amdgcn_s_memrealtime();
    if (IN(5)) for (int rep = 0; rep < REP5; ++rep) { MK_LANE_TID();
        LAS float* LG = (LAS float*)lds;
        LAS float* SQ = LG + 2 * 64 * 48;
        LAS int* CNT = (LAS int*)(SQ + 128); LAS int* BASE = CNT + 32;
        if (tid < 32) CNT[tid] = 0;
        __syncthreads();
        for (int task = vcu; task < T / 64; task += G) {
            TILE_WAIT2(ctl + CW_AOCTR + 64 * (task >> 2), ctl + CW_MIXCTR + 64 * (task >> 3));
            {
                const int rl = lane & 15, q = lane >> 4, rb = (wave & 3) * 16, kh = wave >> 2; const int row = task * 64 + rb + rl;
                const float* xr = x + (size_t)row * D + 512 * kh + 8 * q; const bf16* aop = AO + (size_t)row * D + 512 * kh + 8 * q; const bf16* whp = WRH + (size_t)rl * 1024 + 512 * kh + 8 * q; const bf16* wlp = WRL + (size_t)rl * 1024 + 512 * kh + 8 * q;
                const float* g2p = args.in[14] + 512 * kh + 8 * q; bf16* hp = HN + (size_t)row * D + 512 * kh + 8 * q;
                f32x4 a0 = {0.f, 0.f, 0.f, 0.f}, a1 = a0, a2 = a0; float ssq = 0.f;
#pragma unroll 4
                for (int c = 0; c < 16; ++c) {
                    f32x4 x0 = *(const f32x4*)(xr + 32 * c), x1v = *(const f32x4*)(xr + 32 * c + 4);
                    { const u32x4 aw = *(const u32x4*)(aop + 32 * c);
                      x0[0] += __uint_as_float(aw.x << 16); x0[1] += __uint_as_float(aw.x & 0xffff0000u); x0[2] += __uint_as_float(aw.y << 16); x0[3] += __uint_as_float(aw.y & 0xffff0000u);
                      x1v[0] += __uint_as_float(aw.z << 16); x1v[1] += __uint_as_float(aw.z & 0xffff0000u); x1v[2] += __uint_as_float(aw.w << 16); x1v[3] += __uint_as_float(aw.w & 0xffff0000u); }
                    const f32x4 g0 = *(const f32x4*)(g2p + 32 * c), g1 = *(const f32x4*)(g2p + 32 * c + 4);
                    const bf16x8 h0 = *(const bf16x8*)(whp + 32 * c), h1 = *(const bf16x8*)(whp + 16 * 1024 + 32 * c), h2 = *(const bf16x8*)(whp + 32 * 1024 + 32 * c);
                    const bf16x8 l0 = *(const bf16x8*)(wlp + 32 * c), l1 = *(const bf16x8*)(wlp + 16 * 1024 + 32 * c), l2 = *(const bf16x8*)(wlp + 32 * 1024 + 32 * c);
                    u32x4 xh, xl;
                    { const float f[8] = {x0[0], x0[1], x0[2], x0[3], x1v[0], x1v[1], x1v[2], x1v[3]};
#pragma unroll
                      for (int p = 0; p < 4; ++p) { const unsigned hw = cvt_pk_bf16(f[2 * p], f[2 * p + 1]); xh[p] = hw;
                          xl[p] = cvt_pk_bf16(f[2 * p] - __uint_as_float(hw << 16), f[2 * p + 1] - __uint_as_float(hw & 0xffff0000u)); } }
                    { u32x4 hw; hw.x = cvt_pk_bf16(x0[0] * g0[0], x0[1] * g0[1]); hw.y = cvt_pk_bf16(x0[2] * g0[2], x0[3] * g0[3]); hw.z = cvt_pk_bf16(x1v[0] * g1[0], x1v[1] * g1[1]); hw.w = cvt_pk_bf16(x1v[2] * g1[2], x1v[3] * g1[3]);
                      *(u32x4*)(hp + 32 * c) = hw; }
                    const bf16x8 ah = __builtin_bit_cast(bf16x8, xh), al = __builtin_bit_cast(bf16x8, xl);
                    a0 = __builtin_amdgcn_mfma_f32_16x16x32_bf16(ah, h0, a0, 0, 0, 0); a1 = __builtin_amdgcn_mfma_f32_16x16x32_bf16(ah, h1, a1, 0, 0, 0); a2 = __builtin_amdgcn_mfma_f32_16x16x32_bf16(ah, h2, a2, 0, 0, 0);
                    a0 = __builtin_amdgcn_mfma_f32_16x16x32_bf16(ah, l0, a0, 0, 0, 0); a1 = __builtin_amdgcn_mfma_f32_16x16x32_bf16(ah, l1, a1, 0, 0, 0); a2 = __builtin_amdgcn_mfma_f32_16x16x32_bf16(ah, l2, a2, 0, 0, 0);
                    a0 = __builtin_amdgcn_mfma_f32_16x16x32_bf16(al, h0, a0, 0, 0, 0); a1 = __builtin_amdgcn_mfma_f32_16x16x32_bf16(al, h1, a1, 0, 0, 0); a2 = __builtin_amdgcn_mfma_f32_16x16x32_bf16(al, h2, a2, 0, 0, 0);
                    ssq += (x0.x * x0.x + x0.y * x0.y) + (x0.z * x0.z + x0.w * x0.w) + (x1v.x * x1v.x + x1v.y * x1v.y) + (x1v.z * x1v.z + x1v.w * x1v.w);
                }
                ssq += __shfl_xor(ssq, 16); ssq += __shfl_xor(ssq, 32);
#pragma unroll
                for (int r = 0; r < 4; ++r) { LAS float* lp = LG + (kh * 64 + rb + 4 * q + r) * 48 + rl; lp[0] = a0[r]; lp[16] = a1[r]; lp[32] = a2[r]; }
                if (q == 0) SQ[kh * 64 + rb + rl] = ssq;
            }
            __syncthreads();
            if (TS_PHASE == 105) ts_b = __builtin_amdgcn_s_memrealtime();
            if (wave == 0) {
                const int row = task * 64 + lane; const float rs = __builtin_amdgcn_rsqf((SQ[lane] + SQ[64 + lane]) * (1.f / D) + EPS); const LAS float* lg = LG + lane * 48; const LAS float* lg2 = lg + 64 * 48;
                float gl[4]; float gmax = -3.0e38f; int gi = 0;
#pragma unroll
                for (int jj = 0; jj < 4; ++jj) { gl[jj] = (lg[32 + jj] + lg2[32 + jj]) * rs + args.in[16][jj]; if (gl[jj] > gmax) { gmax = gl[jj]; gi = jj; } }
                float gsum = 0.f;
#pragma unroll
                for (int jj = 0; jj < 4; ++jj) gsum += __expf(gl[jj] - gmax);
                const float pg = 1.f / gsum;
                float el[8]; float b1 = -3.0e38f, b2 = -3.0e38f; int i1 = 0, i2 = 0;
#pragma unroll
                for (int jj = 0; jj < 8; ++jj) { el[jj] = (lg[8 * gi + jj] + lg2[8 * gi + jj]) * rs + args.in[18][8 * gi + jj]; if (el[jj] > b1) { b1 = el[jj]; i1 = jj; } }
#pragma unroll
                for (int jj = 0; jj < 8; ++jj) { if (jj != i1 && el[jj] > b2) { b2 = el[jj]; i2 = jj; } }
                const float wa = pg / (1.f + __expf(b2 - b1)), wb = pg - wa;
                const int e1 = 8 * gi + i1, e2 = 8 * gi + i2;
                const int r1 = __hip_atomic_fetch_add(&CNT[e1], 1, __ATOMIC_RELAXED, __HIP_MEMORY_SCOPE_WORKGROUP), r2 = __hip_atomic_fetch_add(&CNT[e2], 1, __ATOMIC_RELAXED, __HIP_MEMORY_SCOPE_WORKGROUP);
                LDS_WAIT();
                if (lane < 32) { const int c = CNT[lane]; CNT[lane] = 0; BASE[lane] = c > 0 ? (int)__hip_atomic_fetch_add(CURSOR + 64 * lane, (unsigned)c, __ATOMIC_RELAXED, __HIP_MEMORY_SCOPE_AGENT) : 0; }
                LDS_WAIT();
                const int p1 = BASE[e1] + r1, p2 = BASE[e2] + r2;
                LISTTOK[e1 * CAP + p1] = row; LISTW[e1 * CAP + p1] = wa; LISTR[e1 * CAP + p1] = rs; LISTTOK[e2 * CAP + p2] = row; LISTW[e2 * CAP + p2] = wb; LISTR[e2 * CAP + p2] = rs;
                TOKPOS[2 * row] = (e1 << 16) | p1; TOKPOS[2 * row + 1] = (e2 << 16) | p2;
            }
            __syncthreads();
            if (TS_PHASE == 106) ts_b = __builtin_amdgcn_s_memrealtime();
        }
    }
    SEAM(5);
    if (TS_PHASE == 5) ts_b = __builtin_amdgcn_s_memrealtime();

    LAS int* MOE_CNT = (LAS int*)(lds + MISC_OFF + 256); LAS int* MOE_TB = MOE_CNT + 32;
    if (hi > 6) {
        if (wave == 0) { MK_LANE_TID();
            const int e = lane & 31; const int cnt = (int)__hip_atomic_load(CURSOR + 64 * e, __ATOMIC_RELAXED, __HIP_MEMORY_SCOPE_AGENT); const int nt = (cnt + 255) >> 8;
            int incl = nt;
#pragma unroll
            for (int o = 1; o < 32; o <<= 1) { const int v = __shfl_up(incl, o); if ((lane & 31) >= o) incl += v; }
            if (lane < 32) { MOE_CNT[e] = cnt; MOE_TB[e] = incl - nt; if (e == 31) MOE_TB[32] = incl; }
        }
        __syncthreads();
    }
    const int cmoe = (G == 256) ? 4 * (((vcu & 31) >> 2) * 8 + (vcu >> 5)) + (vcu & 3) : vcu;
#define MOE_LOOKUP(mu, nunits, cc) do { nunits = MOE_TB[32] * 4; \
        _Pragma("unroll") for (int i_ = 0; i_ < 3; ++i_) { const int L_ = i_ * G + (cc); int e_ = 0, p_ = 0, n_ = 1; \
            if (L_ < nunits) { const int rt_ = L_ >> 2; for (int q_ = 0; q_ < 32; ++q_) { if (MOE_TB[q_] <= rt_ && rt_ < MOE_TB[q_ + 1]) e_ = q_; } p_ = (rt_ - MOE_TB[e_]) * 256; n_ = MOE_CNT[e_]; } \
            mu.e[i_] = __builtin_amdgcn_readfirstlane(e_); mu.pos0[i_] = __builtin_amdgcn_readfirstlane(p_); mu.n[i_] = __builtin_amdgcn_readfirstlane(n_); } } while (0)

    if (TS_PHASE == 6) ts_a = __builtin_amdgcn_s_memrealtime();
    if (IN(6)) for (int rep = 0; rep < REP6; ++rep) { MK_LANE_TID();
        pg8::MoeUnits mu; int nunits; MOE_LOOKUP(mu, nunits, cmoe);
        pg8::MoeSched<true> S{(const char*)HN, (const char*)WGUT, LISTTOK, 1024, 1024, G, cmoe, nunits, mu, (size_t)1024 * 1024 * 2, 0, 3};
        EpiGU E{HB, LISTR, ctl + CW_TILECTR};
        pg8::gemm_phase<EpiGU, pg8::MoeSched<true>, true>(lds, 1024, S, E, wave);
    }
    if (TS_PHASE == 6) ts_b = __builtin_amdgcn_s_memrealtime();

    if (TS_PHASE == 7) ts_a = __builtin_amdgcn_s_memrealtime();
    if (IN(7)) for (int rep = 0; rep < REP7; ++rep) { MK_LANE_TID();
        const int cc = G - 1 - cmoe;
        pg8::MoeUnits mu; int nunits; MOE_LOOKUP(mu, nunits, cc);
        EpiDown E{YB, LISTW};
#pragma unroll
        for (int part = 0; part < 2; ++part) {
            const int i0 = part * 2, i1 = part == 0 ? 2 : 3;
            if (wave == 0) {
                for (int i = i0; i < i1; ++i) { const int L = i * G + cc; if (L >= nunits) break;
                    unsigned* cp = ctl + CW_TILECTR + 64 * (L >> 2); unsigned spins = 0;
                    while ((unsigned)__builtin_amdgcn_readfirstlane(__hip_atomic_load(cp, __ATOMIC_RELAXED, __HIP_MEMORY_SCOPE_AGENT)) < 32u) { __builtin_amdgcn_s_sleep(2); if (++spins > (1u << 22)) break; } }
                __builtin_amdgcn_fence(__ATOMIC_ACQUIRE, "agent");
                asm volatile("s_waitcnt vmcnt(0)" ::: "memory");
            }
            __syncthreads();
            pg8::MoeSched<false> S{(const char*)HB, (const char*)WDT, LISTTOK, 512, 512, G, cc, nunits, mu, (size_t)1024 * 512 * 2, i0, i1 - i0};
            pg8::gemm_phase<EpiDown, pg8::MoeSched<false>, true>(lds, 512, S, E, wave);
        }
    }
    SEAM(7);
    if (TS_PHASE == 7) ts_b = __builtin_amdgcn_s_memrealtime();

    if (TS_PHASE == 8) ts_a = __builtin_amdgcn_s_memrealtime();
    if (IN(8)) { MK_LANE_TID();
        const int gw = vcu * 8 + wave, NGW = G * 8;
        for (int m = gw; m < T; m += NGW) {
            const int c1 = TOKPOS[2 * m], c2 = TOKPOS[2 * m + 1];
            const int s1 = MOE_TB[c1 >> 16] * 256 + (c1 & 0xffff), s2 = MOE_TB[c2 >> 16] * 256 + (c2 & 0xffff);
            const GAS f32x4* xr = (const GAS f32x4*)(x + (size_t)m * D) + lane; GAS f32x4* orow = (GAS f32x4*)(out + (size_t)m * D) + lane;
            const GAS u32x2* y1 = (const GAS u32x2*)(YB + (size_t)s1 * D) + lane; const GAS u32x2* y2 = (const GAS u32x2*)(YB + (size_t)s2 * D) + lane; const GAS u32x2* ar = (const GAS u32x2*)(AO + (size_t)m * D) + lane;
#pragma unroll
            for (int j = 0; j < 4; ++j) { f32x4 v = xr[64 * j]; const u32x2 a = y1[64 * j], b = y2[64 * j], c = ar[64 * j];
                v.x += __uint_as_float(c.x << 16) + (__uint_as_float(a.x << 16) + __uint_as_float(b.x << 16)); v.y += __uint_as_float(c.x & 0xffff0000u) + (__uint_as_float(a.x & 0xffff0000u) + __uint_as_float(b.x & 0xffff0000u));
                v.z += __uint_as_float(c.y << 16) + (__uint_as_float(a.y << 16) + __uint_as_float(b.y << 16)); v.w += __uint_as_float(c.y & 0xffff0000u) + (__uint_as_float(a.y & 0xffff0000u) + __uint_as_float(b.y & 0xffff0000u));
                orow[64 * j] = v; }
        }
    }
    if (TS_PHASE >= 0 && blockIdx.x == 0) { if (TS_PHASE == 8) ts_b = __builtin_amdgcn_s_memrealtime(); const unsigned long long t_end = __builtin_amdgcn_s_memrealtime(), dt = ts_b - ts_a;
        while (__builtin_amdgcn_s_memrealtime() - t_end < dt) __builtin_amdgcn_s_sleep(8); }
#undef IN
#undef SEAM
}

extern "C" void kernel_launch(void* const* d_in, const int* in_sizes, int n_in, void* d_out, int out_size, void* d_ws, size_t ws_size, hipStream_t stream) {
    static int grid = 0;
    if (grid == 0) {
        if (n_in != 22 || out_size != T * D || ws_size < WS_END) { fprintf(stderr, "kernel_launch: unexpected shapes (n_in %d out %d ws %zu)\n", n_in, out_size, ws_size); grid = -1; return; }
        if (hipFuncSetAttribute((const void*)mk_fwd, hipFuncAttributeMaxDynamicSharedMemorySize, LDS_BYTES) != hipSuccess) { fprintf(stderr, "kernel_launch: hipFuncSetAttribute failed\n"); grid = -1; return; }
        int dev = 0, cus = 0, per_cu = 0;
        (void)hipGetDevice(&dev); (void)hipDeviceGetAttribute(&cus, hipDeviceAttributeMultiprocessorCount, dev);
        (void)hipOccupancyMaxActiveBlocksPerMultiprocessor(&per_cu, (const void*)mk_fwd, 512, LDS_BYTES);
        (void)hipGetLastError();
        if (cus != 256 || per_cu < 1) fprintf(stderr, "kernel_launch: note: %d CUs, occupancy query %d\n", cus, per_cu);
        grid = 256;
    }
    if (grid < 0) return;
    (void)hipMemsetAsync((char*)d_ws + WS_CTL, 0, CTL_ZERO_BYTES, stream);
    Args a{};
    for (int i = 0; i < 22; ++i) a.in[i] = (const float*)d_in[i];
    a.out = (float*)d_out; a.ws = (unsigned char*)d_ws;
    if (MK_N_LAUNCHES == 1) { a.ph_lo = 0; a.ph_hi = NPHASE; hipLaunchKernelGGL(mk_fwd, dim3(grid), dim3(512), LDS_BYTES, stream, a); }
    else { for (int p = 0; p < NPHASE; ++p) { a.ph_lo = p; a.ph_hi = p + 1; hipLaunchKernelGGL(mk_fwd, dim3(grid), dim3(512), LDS_BYTES, stream, a); } }
}
```

```cpp
#include <hip/hip_runtime.h>
#include <cstdio>
#include <cstdint>

#ifndef MK_N_LAUNCHES
#define MK_N_LAUNCHES 1
#endif
constexpr int NPHASE = 9;
#ifndef TS_PHASE
#define TS_PHASE -1
#endif
#ifndef REP0
#define REP0 1
#endif
#ifndef REP1
#define REP1 1
#endif
#ifndef REP2A
#define REP2A 1
#endif
#ifndef REP2B
#define REP2B 1
#endif
#ifndef REP3
#define REP3 1
#endif
#ifndef REP4
#define REP4 1
#endif
#ifndef REP5
#define REP5 1
#endif
#ifndef REP6
#define REP6 1
#endif
#ifndef REP7
#define REP7 1
#endif
#ifndef REP8
#define REP8 1
#endif

#define GAS __attribute__((address_space(1)))
#define LAS __attribute__((address_space(3)))
typedef unsigned short bf16;
typedef short bf16x8 __attribute__((ext_vector_type(8)));
typedef short s16x4 __attribute__((ext_vector_type(4)));
typedef float f32x4 __attribute__((ext_vector_type(4)));
typedef float f32x16 __attribute__((ext_vector_type(16)));
typedef unsigned u32x4 __attribute__((ext_vector_type(4)));
typedef unsigned u32x2 __attribute__((ext_vector_type(2)));

constexpr int T = 16384, SEQ = 8192, D = 1024, PROJ = 5120;
constexpr int NEXP = 32, DEXP = 512;
constexpr int MAXSLOT = 40960, MAXTILES = MAXSLOT / 256;
constexpr float EPS = 1e-6f;
constexpr float LOG2E = 1.4426950408889634f;
constexpr float C2 = 0.125f * LOG2E;

constexpr size_t MiB = 1u << 20;
constexpr size_t WS_CTL = 0, CTL_ZERO_BYTES = 192 * 1024;
constexpr size_t WS_TBLA = 1 * MiB;
constexpr size_t WS_TBLB = WS_TBLA + 4096;
constexpr size_t WS_LAM = WS_TBLB + 8192;
constexpr size_t WS_WR = 1 * MiB + 64 * 1024;
constexpr size_t WS_TOKPOS = 1 * MiB + 512 * 1024;
constexpr size_t WS_LISTTOK = 2 * MiB;
constexpr size_t WS_LISTW = 226 * MiB;
constexpr size_t WS_WINT = 4 * MiB;
constexpr size_t WS_WABT = 14 * MiB;
constexpr size_t WS_WOT = 16 * MiB;
constexpr size_t WS_WGUT = 18 * MiB;
constexpr size_t WS_WDT = 82 * MiB;
constexpr size_t WS_XB = 114 * MiB;
constexpr size_t WS_OAB = 114 * MiB;
constexpr size_t WS_QK = 146 * MiB;
constexpr size_t WS_MIXED = 146 * MiB;
constexpr size_t WS_VA = 178 * MiB;
constexpr size_t WS_QB = 194 * MiB, WS_KB = 210 * MiB, WS_VB = 226 * MiB;
constexpr size_t WS_AO = 114 * MiB;
constexpr size_t WS_H = 242 * MiB;
constexpr size_t WS_Y = 146 * MiB;
constexpr size_t WS_LISTR = 228 * MiB;
constexpr size_t WS_END = 282 * MiB;
constexpr int CW_BAR = 1024;
constexpr int CW_CONV = 8448;
constexpr int CW_MIXCTR = 32768, CW_AOCTR = 36864;
constexpr int CW_TILECTR = 16384;
constexpr int CW_CURSOR = 8192;
constexpr int CAP = 16384;

constexpr int RING_BYTES = 131072;
constexpr int MISC_OFF = 159232;
constexpr int LDS_BYTES = 163840;

#define LDS_WAIT() asm volatile("s_waitcnt lgkmcnt(0)" ::: "memory")
#define VM_WAIT() asm volatile("s_waitcnt vmcnt(0)" ::: "memory")
__device__ __forceinline__ unsigned cvt_pk_bf16(float lo, float hi) { unsigned r; asm volatile("v_cvt_pk_bf16_f32 %0, %1, %2" : "=v"(r) : "v"(lo), "v"(hi)); return r; }
__device__ __forceinline__ float bf2f(unsigned short b) { return __uint_as_float((unsigned)b << 16); }
__device__ __forceinline__ float wave_sum(float v) {
#pragma unroll
    for (int o = 1; o < 64; o <<= 1) v += __shfl_xor(v, o);
    return v;
}

#define XB_TMO      128
#define XB_XCNT(j)  (256  + 64 * (j))
#define XB_XSUB(j)  (1280 + 64 * (j))
#define XB_XGEN(j)  (2304 + 64 * (j))
#define XB_TOP      3328
#define XB_TOPGEN   3392
#define XCD_BAR_WORDS 3456
#define XB_SPIN_CAP (1u << 18)
__device__ __forceinline__ unsigned xb_ld(unsigned* p)              { return __hip_atomic_load(p, __ATOMIC_RELAXED, __HIP_MEMORY_SCOPE_AGENT); }
__device__ __forceinline__ unsigned xb_add(unsigned* p, unsigned v) { return __hip_atomic_fetch_add(p, v, __ATOMIC_RELAXED, __HIP_MEMORY_SCOPE_AGENT); }
__device__ __forceinline__ unsigned xb_xcc_id() { return (unsigned)__builtin_amdgcn_s_getreg((3 << 11) | 20) & 0xFu; }
#define XB_SPIN(cond, bar) do { unsigned _sp = 0; while (cond) { __builtin_amdgcn_s_sleep(1); \
    if ((++_sp & 255u) == 0u) { if (xb_ld(&(bar)[XB_TMO])) break; if (_sp > XB_SPIN_CAP) { atomicAdd(&(bar)[XB_TMO], 1u); break; } } } } while (0)
__device__ __forceinline__ int lane_now() { int l; asm volatile("v_mbcnt_lo_u32_b32 %0, -1, 0\n\tv_mbcnt_hi_u32_b32 %0, -1, %0" : "=v"(l)); return l; }
struct XcdBarrier { unsigned* bar; unsigned x; volatile LAS unsigned* st; bool w0; };
__device__ __forceinline__ XcdBarrier xcd_barrier_post(unsigned* bar, volatile LAS unsigned* st, bool w0) {
    XcdBarrier b; b.bar = bar; b.x = xb_xcc_id(); b.st = st; b.w0 = w0;
    if (w0 && lane_now() == 0) (void)xb_add(&bar[XB_XCNT(b.x)], 1u);
    return b;
}
__device__ __forceinline__ void xcd_barrier_complete(unsigned* bar, unsigned x, unsigned& nloc, unsigned& nx) {
    const unsigned G = gridDim.x * gridDim.y * gridDim.z;
    unsigned sum, cnt, mine, sp = 0u;
    for (;;) {
        sum = 0u; cnt = 0u; mine = 0u;
#pragma unroll
        for (unsigned j = 0; j < 16; ++j) { const unsigned c = xb_ld(&bar[XB_XCNT(j)]); sum += c; cnt += (c > 0u) ? 1u : 0u; mine = (j == x) ? c : mine; }
        if (sum == G) break;
        __builtin_amdgcn_s_sleep(1);
        if ((++sp & 255u) == 0u) { if (xb_ld(&bar[XB_TMO])) break; if (sp > XB_SPIN_CAP) { atomicAdd(&bar[XB_TMO], 1u); break; } }
    }
    nloc = mine > 0u ? mine : 1u; nx = cnt > 0u ? cnt : 1u;
}
__device__ __forceinline__ void xcd_barrier(const XcdBarrier& b) {
    asm volatile("s_waitcnt vmcnt(0)" ::: "memory");
    __syncthreads();
    if (b.w0 && lane_now() == 0) {
        unsigned* bar = b.bar;
        __builtin_amdgcn_s_waitcnt(0);
        unsigned nloc = b.st[0], nx = b.st[1];
        if (nloc == 0u) { xcd_barrier_complete(bar, b.x, nloc, nx); b.st[0] = nloc; b.st[1] = nx; }
        const unsigned old = xb_add(&bar[XB_XSUB(b.x)], 1u);
        const unsigned gen = old / nloc;
        if (old + 1u == (gen + 1u) * nloc) {
            __builtin_amdgcn_fence(__ATOMIC_RELEASE, "agent");
            asm volatile("s_waitcnt vmcnt(0)" ::: "memory");
            const unsigned og = xb_add(&bar[XB_TOP], 1u);
            const unsigned tg = og / nx;
            if (og + 1u == (tg + 1u) * nx) xb_add(&bar[XB_TOPGEN], 1u);
            else XB_SPIN(xb_ld(&bar[XB_TOPGEN]) == tg, bar);
            __builtin_amdgcn_fence(__ATOMIC_ACQUIRE, "agent");
            xb_add(&bar[XB_XGEN(b.x)], 1u);
            asm volatile("s_waitcnt vmcnt(0)" ::: "memory");
        } else {
            XB_SPIN(xb_ld(&bar[XB_XGEN(b.x)]) == gen, bar);
            __builtin_amdgcn_fence(__ATOMIC_ACQUIRE, "agent");
            asm volatile("s_waitcnt vmcnt(0)" ::: "memory");
        }
    }
    __syncthreads();
}

namespace pg8 {
constexpr int BM = 256, BK = 64, HALF = 128, HTB = HALF * BK * 2, NXCD = 8, WGM = 8;
__host__ __device__ __forceinline__ int lds_byte(int r, int c) { const int st = (r >> 4) * 2 + (c >> 5), rr = r & 15, cc = c & 31, ob = rr * 64 + cc * 2; return st * 1024 + (ob ^ (((ob >> 9) & 1) << 5)); }
__host__ __device__ __forceinline__ void stage_rc(int b, int& R, int& C) { const int st = b / 1024, sb = b % 1024, swz = sb ^ (((sb >> 9) & 1) << 5); R = (st >> 1) * 16 + swz / 64; C = (st & 1) * 32 + (swz % 64) / 2; }
__host__ __device__ __forceinline__ int perm32(int rho) { const int n = rho >> 4, i = rho & 15; return 8 * (i >> 2) + 4 * n + (i & 3); }

struct Unit { int pm, pn, e, part, pos0, n; };

__device__ __forceinline__ void tile_of(int L, int nM, int nN, int& pm, int& pn) {
    const int nwg = nM * nN; int wgid = L;
    { const int q = nwg / NXCD, r = nwg % NXCD, xcd = wgid % NXCD, off = wgid / NXCD; wgid = (xcd < r ? xcd * (q + 1) : r * (q + 1) + (xcd - r) * q) + off; }
    const int nig = WGM * nN, gid = wgid / nig, fm = gid * WGM, gsz = (nM - fm) < WGM ? (nM - fm) : WGM;
    pm = fm + ((wgid % nig) % gsz); pn = (wgid % nig) / gsz;
}

template <class Epi, class Sched, bool ALIGN_EPI>
__device__ __forceinline__ void gemm_phase(LAS unsigned char* lds, const int K, const Sched& S, const Epi& E, const int wv) {
    const int lane = lane_now(), wid = wv, tid = wid * 64 + lane, wr = wid >> 2, wc = wid & 3, fr = lane & 15, fq = lane >> 4;
    const int nt = K / BK;
    int Rr[2], Cc[2]; unsigned voffB[2];
#pragma unroll
    for (int i = 0; i < 2; ++i) { int R, C; stage_rc(tid * 16 + i * 8192, R, C); Rr[i] = R; Cc[i] = C; const int Rb = Epi::PERM ? ((R & ~31) + perm32(R & 31)) : R; voffB[i] = (unsigned)(Rb * S.ldb + C) * 2u; }
    const size_t kstep = (size_t)(BK * 2);
    const size_t hstepB = (size_t)HALF * S.ldb * 2;
    const unsigned ldsw = (unsigned)wid * 1024u;
    const int aoff = lds_byte(wr * 64 + fr, fq * 8), boff = lds_byte(wc * 32 + fr, fq * 8);
#define PG8_SA(b, h) (((b) * 2 + (h)) * HTB)
#define PG8_SB(b, h) ((4 + (b) * 2 + (h)) * HTB)
#define PG8_STAGE_A(bufoff, gbase, offh) do { _Pragma("unroll") for (int _i = 0; _i < 2; ++_i) \
        __builtin_amdgcn_global_load_lds((const unsigned*)((const char*)(gbase) + (offh)[_i]), (LAS unsigned*)(lds + (bufoff) + ldsw + _i * 8192), 16, 0, 0); } while (0)
#define PG8_STAGE_B(bufoff, gbase) do { _Pragma("unroll") for (int _i = 0; _i < 2; ++_i) \
        __builtin_amdgcn_global_load_lds((const unsigned*)((const char*)(gbase) + voffB[_i]), (LAS unsigned*)(lds + (bufoff) + ldsw + _i * 8192), 16, 0, 0); } while (0)
#define PG8_LDA(dst, b, h) do { _Pragma("unroll") for (int m = 0; m < 4; ++m) _Pragma("unroll") for (int k = 0; k < 2; ++k) dst[m][k] = *(const LAS bf16x8*)(lds + PG8_SA(b, h) + aoff + m * 2048 + k * 1024); } while (0)
#define PG8_LDB(dst, b, h) do { _Pragma("unroll") for (int n = 0; n < 2; ++n) _Pragma("unroll") for (int k = 0; k < 2; ++k) dst[n][k] = *(const LAS bf16x8*)(lds + PG8_SB(b, h) + boff + n * 2048 + k * 1024); } while (0)
#define PG8_MMA(ai, bj, At, Bt) do { __builtin_amdgcn_s_setprio(1); _Pragma("unroll") for (int m = 0; m < 4; ++m) _Pragma("unroll") for (int n = 0; n < 2; ++n) _Pragma("unroll") for (int k = 0; k < 2; ++k) \
        acc[ai][bj][m][n] = __builtin_amdgcn_mfma_f32_16x16x32_bf16(Bt[n][k], At[m][k], acc[ai][bj][m][n], 0, 0, 0); __builtin_amdgcn_s_setprio(0); } while (0)
#define PG8_WAIT_V(n) asm volatile("s_waitcnt vmcnt(" #n ")" ::: "memory")
#define PG8_WAIT_L(n) asm volatile("s_waitcnt lgkmcnt(" #n ")" ::: "memory")
#define PG8_BAR __builtin_amdgcn_s_barrier()
#define PG8_SCHED __builtin_amdgcn_sched_barrier(0)
    Unit cur, nxt; int ui = 0;
    if (!S.next(0, cur)) return;
    f32x4 acc[2][2][4][2];
#pragma unroll
    for (int a = 0; a < 2; ++a)
#pragma unroll
        for (int b = 0; b < 2; ++b)
#pragma unroll
            for (int m = 0; m < 4; ++m)
#pragma unroll
                for (int n = 0; n < 2; ++n) acc[a][b][m][n] = (f32x4){0.f, 0.f, 0.f, 0.f};
    bf16x8 At[4][2], B0[2][2], B1[2][2];
    const char* cA = S.a_base(cur); const char* cB = S.b_base(cur);
    unsigned oA[2][2], nraw[2][2];
    {
        unsigned raw[2][2];
#pragma unroll
        for (int h = 0; h < 2; ++h)
#pragma unroll
            for (int i = 0; i < 2; ++i) raw[h][i] = S.a_raw(cur, h, Rr[i]);
        if (Sched::GATHER) PG8_WAIT_V(0);
#pragma unroll
        for (int h = 0; h < 2; ++h)
#pragma unroll
            for (int i = 0; i < 2; ++i) oA[h][i] = S.a_conv(raw[h][i], Cc[i]);
    }
    PG8_STAGE_B(PG8_SB(0, 0), cB); PG8_STAGE_B(PG8_SB(0, 1), cB + hstepB); PG8_STAGE_A(PG8_SA(0, 0), cA, oA[0]); PG8_STAGE_A(PG8_SA(0, 1), cA, oA[1]);
    if (wr == 1) PG8_BAR;
    PG8_WAIT_V(2); PG8_BAR;
    PG8_STAGE_B(PG8_SB(1, 0), cB + kstep); PG8_STAGE_A(PG8_SA(1, 0), cA + kstep, oA[0]); PG8_STAGE_B(PG8_SB(1, 1), cB + hstepB + kstep);
    PG8_WAIT_V(6); PG8_BAR;
    for (;;) {
        const bool has_next = S.next(ui + 1, nxt);
        const char* nA = has_next ? S.a_base(nxt) : cA; const char* nB = has_next ? S.b_base(nxt) : cB;
        if (Sched::GATHER && has_next) {
#pragma unroll
            for (int h = 0; h < 2; ++h)
#pragma unroll
                for (int i = 0; i < 2; ++i) nraw[h][i] = S.a_raw(nxt, h, Rr[i]);
        }
        for (int t = 0; t < nt; t += 2) {
            const bool last = (t == nt - 2);
            const char* a1 = cA + (size_t)(t + 1) * kstep;
            const char* a2 = last ? nA : cA + (size_t)(t + 2) * kstep; const char* b2 = last ? nB : cB + (size_t)(t + 2) * kstep;
            const char* a3 = a2 + kstep; const char* b3 = b2 + kstep;
            PG8_LDB(B0, 0, 0); PG8_LDB(B1, 0, 1); PG8_SCHED; PG8_LDA(At, 0, 0); PG8_STAGE_A(PG8_SA(1, 1), a1, oA[1]);
            PG8_WAIT_V(8); PG8_WAIT_L(0); PG8_BAR; PG8_MMA(0, 0, At, B0); PG8_MMA(0, 1, At, B1); PG8_BAR; PG8_SCHED;
            if (last && has_next) {
#pragma unroll
                for (int h = 0; h < 2; ++h)
#pragma unroll
                    for (int i = 0; i < 2; ++i) oA[h][i] = S.a_conv(Sched::GATHER ? nraw[h][i] : S.a_raw(nxt, h, Rr[i]), Cc[i]);
            }
            PG8_LDA(At, 0, 1); PG8_STAGE_B(PG8_SB(0, 0), b2); PG8_STAGE_B(PG8_SB(0, 1), b2 + hstepB); PG8_STAGE_A(PG8_SA(0, 0), a2, oA[0]);
            PG8_WAIT_V(8); PG8_WAIT_L(0); PG8_BAR; PG8_MMA(1, 0, At, B0); PG8_MMA(1, 1, At, B1); PG8_BAR; PG8_SCHED;
            PG8_LDB(B0, 1, 0); PG8_LDB(B1, 1, 1); PG8_SCHED; PG8_LDA(At, 1, 0); PG8_STAGE_A(PG8_SA(0, 1), a2, oA[1]);
            PG8_WAIT_V(8); PG8_WAIT_L(0); PG8_BAR; PG8_MMA(0, 0, At, B0); PG8_MMA(0, 1, At, B1); PG8_BAR; PG8_SCHED;
            PG8_LDA(At, 1, 1); PG8_STAGE_B(PG8_SB(1, 0), b3); PG8_STAGE_B(PG8_SB(1, 1), b3 + hstepB); PG8_STAGE_A(PG8_SA(1, 0), a3, oA[0]);
            PG8_WAIT_V(8); PG8_WAIT_L(0); PG8_BAR; PG8_MMA(1, 0, At, B0); PG8_MMA(1, 1, At, B1); PG8_BAR; PG8_SCHED;
        }
        if constexpr (ALIGN_EPI) { if (wr == 0) PG8_BAR; }
        if (TS_PHASE >= 120 && TS_PHASE <= 129 && (TS_PHASE & 1) == 0 && ui == (TS_PHASE - 120) / 2 && tid == 0) *(LAS unsigned long long*)(lds + MISC_OFF + 128) = __builtin_amdgcn_s_memrealtime();
        E(acc, cur, wr, wc, fr, fq);
        if (TS_PHASE >= 120 && TS_PHASE <= 129 && (TS_PHASE & 1) == 1 && ui == (TS_PHASE - 121) / 2 && tid == 256) *(LAS unsigned long long*)(lds + MISC_OFF + 128) = __builtin_amdgcn_s_memrealtime();
        if (!has_next) break;
        if (!E.keep(cur)) {
#pragma unroll
            for (int a = 0; a < 2; ++a)
#pragma unroll
                for (int b = 0; b < 2; ++b)
#pragma unroll
                    for (int m = 0; m < 4; ++m)
#pragma unroll
                        for (int n = 0; n < 2; ++n) acc[a][b][m][n] = (f32x4){0.f, 0.f, 0.f, 0.f};
        }
        cur = nxt; cA = nA; cB = nB; ++ui;
        if constexpr (ALIGN_EPI) { if (wr == 1) PG8_BAR; }
    }
    PG8_WAIT_V(0);
    if constexpr (!ALIGN_EPI) { if (wr == 0) PG8_BAR; }
    PG8_BAR;
#undef PG8_SA
#undef PG8_SB
#undef PG8_STAGE_A
#undef PG8_STAGE_B
#undef PG8_LDA
#undef PG8_LDB
#undef PG8_MMA
#undef PG8_WAIT_V
#undef PG8_WAIT_L
#undef PG8_BAR
#undef PG8_SCHED
}

struct DenseSched {
    static constexpr bool GATHER = false;
    const char* A; const char* Bt; int lda, ldb, nM, nN, G, c, nparts, K;
    __device__ __forceinline__ bool next(int i, Unit& u) const {
        const int ti = i / nparts; const long L = (long)ti * G + c; if (L >= (long)nM * nN) return false;
        tile_of((int)L, nM, nN, u.pm, u.pn); u.part = i - ti * nparts; u.e = 0; return true;
    }
    __device__ __forceinline__ const char* a_base(const Unit& u) const { return A + (size_t)u.part * K * 2; }
    __device__ __forceinline__ const char* b_base(const Unit& u) const { return Bt + ((size_t)u.pn * BM * ldb + (size_t)u.part * K) * 2; }
    __device__ __forceinline__ unsigned a_raw(const Unit& u, int h, int R) const { return (unsigned)(u.pm * BM + h * HALF + R); }
    __device__ __forceinline__ unsigned a_conv(unsigned raw, int C) const { return (raw * (unsigned)lda + (unsigned)C) * 2u; }
};
struct MoeUnits { int e[3], pos0[3], n[3], L[3]; };
template <bool GATHER_>
struct MoeSched {
    static constexpr bool GATHER = GATHER_;
    const char* A; const char* Bt; const int* list_tok; int lda, ldb, G, c, nunits; MoeUnits mu; size_t bstride; int ibase, icount;
    __device__ __forceinline__ bool next(int i_, Unit& u) const {
        const int i = i_ + ibase; const int L = (i == 0) ? mu.L[0] : (i == 1 ? mu.L[1] : mu.L[2]); if (i_ >= icount || i > 2 || L >= nunits) return false;
        u.pm = L >> 2; u.pn = L & 3; u.part = 0;
        u.e = (i == 0) ? mu.e[0] : (i == 1 ? mu.e[1] : mu.e[2]); u.pos0 = (i == 0) ? mu.pos0[0] : (i == 1 ? mu.pos0[1] : mu.pos0[2]); u.n = (i == 0) ? mu.n[0] : (i == 1 ? mu.n[1] : mu.n[2]);
        return true;
    }
    __device__ __forceinline__ const char* a_base(const Unit&) const { return A; }
    __device__ __forceinline__ const char* b_base(const Unit& u) const { return Bt + (size_t)u.e * bstride + (size_t)u.pn * BM * ldb * 2; }
    __device__ __forceinline__ unsigned a_raw(const Unit& u, int h, int R) const {
        if (GATHER_) { int pos = u.pos0 + h * HALF + R; pos = pos < u.n ? pos : u.n - 1;
            unsigned v; const int* p = list_tok + u.e * CAP + pos; asm volatile("global_load_dword %0, %1, off" : "=v"(v) : "v"(p) : "memory"); return v; }
        return (unsigned)(u.pm * BM + h * HALF + R);
    }
    __device__ __forceinline__ unsigned a_conv(unsigned raw, int C) const {
        if (GATHER_) { unsigned o; const unsigned c2 = (unsigned)C * 2u; asm volatile("v_mad_u32_u24 %0, %1, %2, %3" : "=v"(o) : "v"(raw), "v"((unsigned)lda * 2u), "v"(c2)); return o; }
        return (raw * (unsigned)lda + (unsigned)C) * 2u;
    }
};
}

struct EpiProj {
    static constexpr bool PERM = true;
    bf16* QK; bf16* VA; bf16* QB; bf16* KB; bf16* VB; bf16* GATES;
    const float *aq, *ak, *bq, *bk;
    __device__ __forceinline__ bool keep(const pg8::Unit&) const { return false; }
    __device__ __forceinline__ void operator()(f32x4 (&acc)[2][2][4][2], const pg8::Unit& u, int wr, int wc, int fr, int fq) const {
        const int pn = u.pn; int mode, ld, colbase; bf16* dst; const float* gain = nullptr; float scale = 1.f;
        if (pn < 4) { mode = 1; dst = QK + (size_t)pn * T * 256; ld = 256; colbase = 0; gain = pn < 2 ? aq : ak; scale = pn < 2 ? C2 : 1.f; }
        else if (pn < 6) { mode = 0; dst = VA; ld = 512; colbase = (pn - 4) * 256; }
        else if (pn < 8) { mode = 1; dst = QB; ld = 512; colbase = (pn - 6) * 256; gain = bq; scale = C2; }
        else if (pn < 10) { mode = 1; dst = KB; ld = 512; colbase = (pn - 8) * 256; gain = bk; }
        else if (pn < 12) { mode = 0; dst = VB; ld = 512; colbase = (pn - 10) * 256; }
        else { mode = 2; dst = GATES; ld = 2048; colbase = (pn - 12) * 256; }
        const int row0 = u.pm * 256 + wr * 64 + fr;
        float g[2][8];
        if (mode == 1) {
#pragma unroll
            for (int bj = 0; bj < 2; ++bj) { const f32x4 a = *(const f32x4*)(gain + 32 * bj + 8 * fq), b = *(const f32x4*)(gain + 32 * bj + 8 * fq + 4);
                g[bj][0] = a[0] * scale; g[bj][1] = a[1] * scale; g[bj][2] = a[2] * scale; g[bj][3] = a[3] * scale; g[bj][4] = b[0] * scale; g[bj][5] = b[1] * scale; g[bj][6] = b[2] * scale; g[bj][7] = b[3] * scale; }
        }
#pragma unroll
        for (int ai = 0; ai < 2; ++ai)
#pragma unroll
            for (int m = 0; m < 4; ++m) {
                float v[2][8];
#pragma unroll
                for (int bj = 0; bj < 2; ++bj)
#pragma unroll
                    for (int n = 0; n < 2; ++n)
#pragma unroll
                        for (int j = 0; j < 4; ++j) v[bj][4 * n + j] = acc[ai][bj][m][n][j];
                if (mode == 1) {
                    float ss = 0.f;
#pragma unroll
                    for (int bj = 0; bj < 2; ++bj)
#pragma unroll
                        for (int j = 0; j < 8; ++j) ss += v[bj][j] * v[bj][j];
                    ss += __shfl_xor(ss, 16); ss += __shfl_xor(ss, 32);
                    const float rs = __builtin_amdgcn_rsqf(ss * (1.f / 64.f) + EPS);
#pragma unroll
                    for (int bj = 0; bj < 2; ++bj)
#pragma unroll
                        for (int j = 0; j < 8; ++j) v[bj][j] = v[bj][j] * rs * g[bj][j];
                } else if (mode == 2) {
#pragma unroll
                    for (int j = 0; j < 8; ++j) { const float sa = __builtin_amdgcn_rcpf(1.f + __builtin_amdgcn_exp2f(-LOG2E * v[0][j])), eb = __builtin_amdgcn_exp2f(-LOG2E * v[1][j]);
                        v[0][j] = sa * (1.f + eb); v[1][j] = __builtin_amdgcn_rcpf(1.f + eb); }
                }
                const int row = row0 + ai * 128 + m * 16;
                unsigned eo, es;
                { const unsigned bq = (unsigned)row >> 13, tile = ((unsigned)row & 8191u) >> 6, key = (unsigned)row & 63u;
                  if (pn == 2 || pn == 3) { eo = ((((bq * 4 + wc) * 128 + tile) * 8 + fq) * 64 + key) * 8; es = 4 * 64 * 8; }
                  else if (pn == 4 || pn == 5) { const unsigned head = (pn - 4) * 2 + (wc >> 1); eo = ((((bq * 4 + head) * 128 + tile) * 4 + 2 * (wc & 1)) * 64 + key) * 32 + 8 * fq; es = 64 * 32; }
                  else if (pn == 8 || pn == 9) { const unsigned head = (pn - 8) * 4 + wc; eo = ((((bq * 8 + head) * 128 + tile) * 8 + fq) * 64 + key) * 8; es = 4 * 64 * 8; }
                  else if (pn == 10 || pn == 11) { const unsigned head = (pn - 10) * 4 + wc; eo = ((((bq * 8 + head) * 128 + tile) * 2) * 64 + key) * 32 + 8 * fq; es = 64 * 32; }
                  else if (pn >= 12) { eo = ((((((unsigned)u.pm * 8 + (pn - 12)) * 2 + ai) * 4 + m) * 2) * 8 + (wr * 4 + wc)) * 512 + (fq * 16 + fr) * 8; es = 8 * 512; }
                  else { eo = (unsigned)row * (unsigned)ld + colbase + 64 * wc + 8 * fq; es = 32; } }
#pragma unroll
                for (int bj = 0; bj < 2; ++bj) { u32x4 w; w.x = cvt_pk_bf16(v[bj][0], v[bj][1]); w.y = cvt_pk_bf16(v[bj][2], v[bj][3]); w.z = cvt_pk_bf16(v[bj][4], v[bj][5]); w.w = cvt_pk_bf16(v[bj][6], v[bj][7]);
                    *(u32x4*)(dst + eo + bj * es) = w; }
            }
    }
};
struct EpiAB {
    static constexpr bool PERM = true;
    const bf16* __restrict__ GATES; bf16* __restrict__ MIXED; unsigned* ctr;
    __device__ __forceinline__ bool keep(const pg8::Unit& u) const { return u.part == 0; }
    __device__ __forceinline__ void operator()(f32x4 (&acc)[2][2][4][2], const pg8::Unit& u, int wr, int wc, int fr, int fq) const {
        const int row0 = u.pm * 256 + wr * 64 + fr, col0 = u.pn * 256 + wc * 32 + 8 * fq;
        const unsigned lo = (unsigned)((wr * 4 + wc) * 512 + (fq * 16 + fr) * 8);
        const GAS u32x4* gp = (const GAS u32x4*)(GATES + (size_t)(u.pm * 8 + 2 * u.pn) * 65536 + lo);
        constexpr int GSTR = 8 * 512 * 2 / 16, GT = 65536 * 2 / 16;
        if (u.part == 0) {
#pragma unroll
            for (int g = 0; g < 8; g += 2) {
                u32x4 sr[2][2];
#pragma unroll
                for (int gg = 0; gg < 2; ++gg)
#pragma unroll
                    for (int bj = 0; bj < 2; ++bj) sr[gg][bj] = gp[bj * GT + ((g + gg) * 2 + 0) * GSTR];
#pragma unroll
                for (int gg = 0; gg < 2; ++gg)
#pragma unroll
                    for (int bj = 0; bj < 2; ++bj)
#pragma unroll
                        for (int q = 0; q < 4; ++q) { const int ai = (g + gg) >> 2, m = (g + gg) & 3, n = q >> 1, j = (q & 1) * 2;
                            acc[ai][bj][m][n][j] *= __uint_as_float(sr[gg][bj][q] << 16); acc[ai][bj][m][n][j + 1] *= __uint_as_float(sr[gg][bj][q] & 0xffff0000u); }
            }
        } else {
            const __amdgpu_buffer_rsrc_t mrs = __builtin_amdgcn_make_buffer_rsrc(MIXED, 0, T * D * 2, 0x00020000);
#pragma unroll
            for (int g = 0; g < 8; g += 4) {
                u32x4 sb[4][2];
#pragma unroll
                for (int gg = 0; gg < 4; ++gg)
#pragma unroll
                    for (int bj = 0; bj < 2; ++bj) sb[gg][bj] = gp[bj * GT + ((g + gg) * 2 + 1) * GSTR];
#pragma unroll
                for (int gg = 0; gg < 4; ++gg) { const int ai = (g + gg) >> 2, m = (g + gg) & 3; bf16* rp = MIXED + (size_t)(row0 + ai * 128 + m * 16) * 1024 + col0;
#pragma unroll
                    for (int bj = 0; bj < 2; ++bj) { u32x4 w;
#pragma unroll
                        for (int q = 0; q < 4; ++q) { const int n = q >> 1, j = (q & 1) * 2;
                            w[q] = cvt_pk_bf16(acc[ai][bj][m][n][j] * __uint_as_float(sb[gg][bj][q] << 16), acc[ai][bj][m][n][j + 1] * __uint_as_float(sb[gg][bj][q] & 0xffff0000u)); }
                        __builtin_amdgcn_raw_buffer_store_b128(w, mrs, (unsigned)((size_t)(rp + bj * 128 - MIXED) * 2), 0, 16); } }
            }
            asm volatile("s_waitcnt vmcnt(0)" ::: "memory");
            if (lane_now() == 0) __hip_atomic_fetch_add(ctr + 64 * u.pm, 1u, __ATOMIC_RELAXED, __HIP_MEMORY_SCOPE_AGENT);
        }
    }
};
struct EpiAO {
    static constexpr bool PERM = true;
    bf16* AO; unsigned* ctr;
    __device__ __forceinline__ bool keep(const pg8::Unit&) const { return false; }
    __device__ __forceinline__ void operator()(f32x4 (&acc)[2][2][4][2], const pg8::Unit& u, int wr, int wc, int fr, int fq) const {
        const int row0 = u.pm * 256 + wr * 64 + fr, col0 = u.pn * 256 + wc * 32 + 8 * fq;
        const __amdgpu_buffer_rsrc_t ars = __builtin_amdgcn_make_buffer_rsrc(AO, 0, T * D * 2, 0x00020000);
#pragma unroll
        for (int ai = 0; ai < 2; ++ai)
#pragma unroll
            for (int m = 0; m < 4; ++m) { const unsigned ro = (unsigned)((row0 + ai * 128 + m * 16) * D + col0) * 2u;
#pragma unroll
                for (int bj = 0; bj < 2; ++bj) { u32x4 o; o.x = cvt_pk_bf16(acc[ai][bj][m][0][0], acc[ai][bj][m][0][1]); o.y = cvt_pk_bf16(acc[ai][bj][m][0][2], acc[ai][bj][m][0][3]);
                    o.z = cvt_pk_bf16(acc[ai][bj][m][1][0], acc[ai][bj][m][1][1]); o.w = cvt_pk_bf16(acc[ai][bj][m][1][2], acc[ai][bj][m][1][3]);
                    __builtin_amdgcn_raw_buffer_store_b128(o, ars, ro + bj * 256, 0, 16); } }
        asm volatile("s_waitcnt vmcnt(0)" ::: "memory");
        if (lane_now() == 0) __hip_atomic_fetch_add(ctr + 64 * u.pm, 1u, __ATOMIC_RELAXED, __HIP_MEMORY_SCOPE_AGENT);
    }
};
struct EpiGU {
    static constexpr bool PERM = true;
    bf16* H; const float* list_r; unsigned* tilectr;
    __device__ __forceinline__ bool keep(const pg8::Unit&) const { return false; }
    __device__ __forceinline__ void operator()(f32x4 (&acc)[2][2][4][2], const pg8::Unit& u, int wr, int wc, int fr, int fq) const {
        const int r0 = wr * 64 + fr, col0 = u.pn * 128 + wc * 32 + 8 * fq;
        const __amdgpu_buffer_rsrc_t hrs = __builtin_amdgcn_make_buffer_rsrc(H, 0, MAXSLOT * DEXP * 2, 0x00020000);
        float rsv[8];
#pragma unroll
        for (int g = 0; g < 8; ++g) { const int r = r0 + (g >> 2) * 128 + (g & 3) * 16; int pos = u.pos0 + r; pos = pos < u.n ? pos : u.n - 1; rsv[g] = list_r[u.e * CAP + pos]; }
#pragma unroll
        for (int ai = 0; ai < 2; ++ai)
#pragma unroll
            for (int m = 0; m < 4; ++m) {
                const int r = r0 + ai * 128 + m * 16; const float rs = rsv[ai * 4 + m];
                float h[8];
#pragma unroll
                for (int n = 0; n < 2; ++n)
#pragma unroll
                    for (int j = 0; j < 4; ++j) { const float gt = acc[ai][0][m][n][j] * rs, up = acc[ai][1][m][n][j] * rs;
                        h[4 * n + j] = gt * __builtin_amdgcn_rcpf(1.f + __builtin_amdgcn_exp2f(-LOG2E * gt)) * up; }
                u32x4 w; w.x = cvt_pk_bf16(h[0], h[1]); w.y = cvt_pk_bf16(h[2], h[3]); w.z = cvt_pk_bf16(h[4], h[5]); w.w = cvt_pk_bf16(h[6], h[7]);
                __builtin_amdgcn_raw_buffer_store_b128(w, hrs, (unsigned)(((u.pm * 256 + r) * DEXP + col0) * 2), 0, 16);
            }
        asm volatile("s_waitcnt vmcnt(0)" ::: "memory");
        if (lane_now() == 0) __hip_atomic_fetch_add(tilectr + 64 * u.pm, 1u, __ATOMIC_RELAXED, __HIP_MEMORY_SCOPE_AGENT);
    }
};
struct EpiDown {
    static constexpr bool PERM = true;
    bf16* Y; const float* list_w;
    __device__ __forceinline__ bool keep(const pg8::Unit&) const { return false; }
    __device__ __forceinline__ void operator()(f32x4 (&acc)[2][2][4][2], const pg8::Unit& u, int wr, int wc, int fr, int fq) const {
        const int r0 = wr * 64 + fr, col0 = u.pn * 256 + wc * 32 + 8 * fq;
        float wv[8];
#pragma unroll
        for (int g = 0; g < 8; ++g) { const int r = r0 + (g >> 2) * 128 + (g & 3) * 16; int pos = u.pos0 + r; pos = pos < u.n ? pos : u.n - 1; wv[g] = list_w[u.e * CAP + pos]; }
#pragma unroll
        for (int ai = 0; ai < 2; ++ai)
#pragma unroll
            for (int m = 0; m < 4; ++m) { const int r = r0 + ai * 128 + m * 16; const float w = wv[ai * 4 + m]; const int row = u.pm * 256 + r;
#pragma unroll
                for (int bj = 0; bj < 2; ++bj) { u32x4 o; o.x = cvt_pk_bf16(acc[ai][bj][m][0][0] * w, acc[ai][bj][m][0][1] * w); o.y = cvt_pk_bf16(acc[ai][bj][m][0][2] * w, acc[ai][bj][m][0][3] * w);
                    o.z = cvt_pk_bf16(acc[ai][bj][m][1][0] * w, acc[ai][bj][m][1][1] * w); o.w = cvt_pk_bf16(acc[ai][bj][m][1][2] * w, acc[ai][bj][m][1][3] * w);
                    *(u32x4*)(Y + (size_t)row * D + col0 + bj * 128) = o; } }
    }
};

namespace att {
__device__ __forceinline__ int crow(int r, int hi) { return (r & 3) + 8 * (r >> 2) + 4 * hi; }
__device__ __forceinline__ void glds16(const void* sbase_, unsigned voff, unsigned lds_dst) { unsigned keep;
    const unsigned long long a_ = (unsigned long long)(uintptr_t)sbase_;
    const unsigned long long sbase = ((unsigned long long)(unsigned)__builtin_amdgcn_readfirstlane((int)(a_ >> 32)) << 32) | (unsigned)__builtin_amdgcn_readfirstlane((int)a_);
    asm volatile("s_mov_b32 %0, m0\n\ts_mov_b32 m0, %3\n\ts_nop 0\n\tglobal_load_lds_dwordx4 %1, %2\n\ts_mov_b32 m0, %0" : "=&s"(keep) : "v"(voff), "s"(sbase), "s"(lds_dst) : "memory"); }
__device__ __forceinline__ void glds16p(const void* gsrc, unsigned lds_dst) { unsigned keep;
    asm volatile("s_mov_b32 %0, m0\n\ts_mov_b32 m0, %2\n\ts_nop 0\n\tglobal_load_lds_dwordx4 %1, off\n\ts_mov_b32 m0, %0" : "=&s"(keep) : "v"(gsrc), "s"(lds_dst) : "memory"); }
typedef LAS const char* lds_cptr;
typedef short v4i16_t __attribute__((ext_vector_type(4)));
typedef float f32x2_t __attribute__((ext_vector_type(2))); typedef __bf16 bf16x2_t __attribute__((ext_vector_type(2)));
__device__ __forceinline__ s16x4 vtr(lds_cptr p) { return __builtin_bit_cast(s16x4, __builtin_amdgcn_ds_read_tr16_b64_v4i16((LAS v4i16_t*)p)); }
__device__ __forceinline__ unsigned cvtpk(float lo, float hi) { f32x2_t v = {lo, hi}; bf16x2_t b = __builtin_convertvector(v, bf16x2_t); return __builtin_bit_cast(unsigned, b); }
#define ATT_WAIT_BAR(N) asm volatile("s_waitcnt vmcnt(" #N ") lgkmcnt(0)\n\ts_barrier" ::: "memory")
#define ATT_SB() __builtin_amdgcn_sched_barrier(0)
#define ATT_PIN(x) asm volatile("" : "+v"(x))
#define ATT_MFMA(a, b, c) __builtin_amdgcn_mfma_f32_32x32x16_bf16(a, b, c, 0, 0, 0)

constexpr int LDS_K = 0, LDS_V = 65536, LDS_TBL = 131072, LDS_WS = 132096, LDS_X = 0;

template <int NS, int DV, int QP, int VP> struct attn_dummy {};
template <int NS, int DV, int QP, int VP>
__device__ __forceinline__ void attn_unit_simple(const bf16* Q0, const bf16* Q1p, const bf16* K0, const bf16* K1p, const bf16* V, long rowbase, int q0,
                                          const float* tblg, const float* gsub, float lam, bf16* OUT  , char* shm, const int wv) {
    constexpr int KSLOT = NS * 8192, VSLOT = DV * 128, ND = DV / 32, NVP = DV / 64;
    const int lane = lane_now(), wid = wv, tid = wid * 64 + lane, r32 = lane & 31, hi = lane >> 5;
    const int s = (NS == 2) ? (wid >> 2) : 0, j = (NS == 2) ? (wid & 3) : wid;
    const int ROWS = (NS == 2) ? 128 : 256;
    const int cw = (q0 + 32 * j) >> 6, qi = ((32 * j) & 63) + r32;
    const int t1 = (q0 + ROWS - 1) >> 6;
    int t0 = 0, lo_w = 0;
    if (NS == 1) { t0 = (q0 >> 6) - 8; if (t0 < 0) t0 = 0; lo_w = cw - 8; if (lo_w < 0) lo_w = 0; }
    const unsigned lds0 = (unsigned)(uintptr_t)shm;
    LAS float* tb = (LAS float*)((LAS char*)shm + LDS_TBL);
    LAS float* wsf = (LAS float*)((LAS char*)shm + LDS_WS) + wid * 64;
    if (tid < 256) tb[tid] = tblg[tid];
    const bf16* Qs = (s == 0) ? Q0 : Q1p;
    const bf16* Qw = Qs + (rowbase + q0 + 32 * j) * QP;
    const char* ksrc0 = (const char*)K0 + wid * 1024 + lane * 16;
    const char* ksrc1 = (NS == 2) ? (const char*)K1p + wid * 1024 + lane * 16 : nullptr;
    const char* vsrc = (const char*)V + lane * 16;
    const unsigned kdst = lds0 + LDS_K + wid * 1024, vdst = lds0 + LDS_V;
    bf16x8 qr[4];
#pragma unroll
    for (int d0 = 0; d0 < 4; ++d0) qr[d0] = *reinterpret_cast<const bf16x8*>(&Qw[(long)r32 * QP + d0 * 16 + hi * 8]);
#define ATT_DMA(t, sl) do { \
        glds16p(ksrc0 + (long)(t) * 8192, (unsigned)__builtin_amdgcn_readfirstlane(kdst + (sl) * KSLOT)); \
        if (NS == 2) glds16p(ksrc1 + (long)(t) * 8192, (unsigned)__builtin_amdgcn_readfirstlane(kdst + (sl) * KSLOT + 8192)); \
        _Pragma("unroll") for (int i_ = 0; i_ < NVP; ++i_) { const int p_ = wid + 8 * i_; \
            glds16p(vsrc + (long)(t) * (DV * 128) + p_ * 1024, (unsigned)__builtin_amdgcn_readfirstlane(vdst + (sl) * VSLOT + p_ * 1024)); } \
    } while (0)
    ATT_DMA(t0, 0);
    if (t0 + 1 <= t1) ATT_DMA(t0 + 1, 1);
    f32x16 o[ND];
#pragma unroll
    for (int d = 0; d < ND; ++d) o[d] = f32x16{};
    float l_reg = 0.f;
    LDS_WAIT();
    __builtin_amdgcn_s_barrier();
    asm volatile("" :: "v"(qr[0]), "v"(qr[1]), "v"(qr[2]), "v"(qr[3]));
    const float cfar = tb[255];
    f32x16 cinit;
#pragma unroll
    for (int r = 0; r < 16; ++r) cinit[r] = cfar;
    const lds_cptr shm3 = (lds_cptr)shm;
    const lds_cptr kp0 = shm3 + LDS_K + s * 8192 + hi * 1024 + r32 * 16;
    const lds_cptr vp0 = shm3 + LDS_V + ((lane >> 4) & 1) * 32 + (lane & 3) * 8 + (4 * hi + ((lane & 15) >> 2)) * 64;
    if (wid >= 4) __builtin_amdgcn_s_setprio(1);
    int sl = 0;
    for (int t = t0; t <= t1; ++t) {
        if (t < t1) { if (NS == 2) ATT_WAIT_BAR(4); else ATT_WAIT_BAR(2); } else ATT_WAIT_BAR(0);
        if (t + 2 <= t1) { const int s2 = (sl == 0) ? 2 : sl - 1; ATT_DMA(t + 2, s2); }
        if (t >= lo_w && t <= cw) {
            const lds_cptr kp = kp0 + sl * KSLOT; const lds_cptr vp = vp0 + sl * VSLOT;
            f32x16 p0, p1;
#pragma unroll
            for (int d0 = 0; d0 < 4; ++d0) {
                const bf16x8 b0 = *(const LAS bf16x8*)(kp + d0 * 2048), b1 = *(const LAS bf16x8*)(kp + d0 * 2048 + 512);
                if (d0 == 0) { p0 = __builtin_amdgcn_mfma_f32_32x32x16_bf16(b0, qr[0], cinit, 0, 0, 0); p1 = __builtin_amdgcn_mfma_f32_32x32x16_bf16(b1, qr[0], cinit, 0, 0, 0); }
                else { p0 = __builtin_amdgcn_mfma_f32_32x32x16_bf16(b0, qr[d0], p0, 0, 0, 0); p1 = __builtin_amdgcn_mfma_f32_32x32x16_bf16(b1, qr[d0], p1, 0, 0, 0); }
            }
            if (t >= cw - 2) {
                const LAS float* tp = tb + (64 * (t - cw) + 191 - qi + 4 * hi);
#pragma unroll
                for (int r = 0; r < 16; ++r) { p0[r] += tp[(r & 3) + 8 * (r >> 2)]; p1[r] += tp[32 + (r & 3) + 8 * (r >> 2)]; }
            }
            float sacc = 0.f;
#pragma unroll
            for (int r = 0; r < 16; ++r) { p0[r] = __builtin_amdgcn_exp2f(p0[r]); p1[r] = __builtin_amdgcn_exp2f(p1[r]); sacc += p0[r] + p1[r]; }
            l_reg += sacc;
            u32x4 pw[4];
#pragma unroll
            for (int q = 0; q < 4; ++q) { pw[0][q] = cvtpk(p0[2 * q], p0[2 * q + 1]); pw[1][q] = cvtpk(p0[8 + 2 * q], p0[9 + 2 * q]);
                pw[2][q] = cvtpk(p1[2 * q], p1[2 * q + 1]); pw[3][q] = cvtpk(p1[8 + 2 * q], p1[9 + 2 * q]); }
#pragma unroll
            for (int d0 = 0; d0 < ND; ++d0)
#pragma unroll
                for (int ks = 0; ks < 4; ++ks) {
                    const s16x4 vlo = vtr(vp + d0 * 4096 + ks * 1024), vhi = vtr(vp + d0 * 4096 + ks * 1024 + 512);
                    const bf16x8 vf = (bf16x8){vlo[0], vlo[1], vlo[2], vlo[3], vhi[0], vhi[1], vhi[2], vhi[3]};
                    o[d0] = __builtin_amdgcn_mfma_f32_32x32x16_bf16(__builtin_bit_cast(bf16x8, pw[ks]), vf, o[d0], 0, 0, 0);
                }
        }
        sl = (sl == 2) ? 0 : sl + 1;
    }
#undef ATT_DMA
    __builtin_amdgcn_s_setprio(0);
    { auto rr = __builtin_amdgcn_permlane32_swap(__float_as_uint(l_reg), __float_as_uint(l_reg), false, false); l_reg = __uint_as_float(rr[0]) + __uint_as_float(rr[1]); }
    if (hi == 0) wsf[r32] = l_reg;
    LDS_WAIT();
    float rli[16];
#pragma unroll
    for (int r = 0; r < 16; ++r) rli[r] = __builtin_amdgcn_rcpf(wsf[crow(r, hi)]);
    const long orow0 = rowbase + q0 + 32 * j;
    if (NS == 2) {
        LAS float* X = (LAS float*)((LAS char*)shm + LDS_X);
        asm volatile("s_waitcnt lgkmcnt(0)\n\ts_barrier" ::: "memory");
        if (s == 1) {
#pragma unroll
            for (int d0 = 0; d0 < ND; ++d0)
#pragma unroll
                for (int r = 0; r < 16; ++r) X[((j * ND + d0) * 16 + r) * 64 + lane] = lam * o[d0][r] * rli[r];
        }
        asm volatile("s_waitcnt lgkmcnt(0)\n\ts_barrier" ::: "memory");
        if (s == 0) {
            float gs[ND];
#pragma unroll
            for (int d0 = 0; d0 < ND; ++d0) gs[d0] = gsub[32 * d0 + r32] * 0.8f;
#pragma unroll
            for (int r = 0; r < 16; ++r) {
                float ss = 0.f;
#pragma unroll
                for (int d0 = 0; d0 < ND; ++d0) { o[d0][r] = o[d0][r] * rli[r] - X[((j * ND + d0) * 16 + r) * 64 + lane]; ss += o[d0][r] * o[d0][r]; }
#pragma unroll
                for (int m = 1; m < 32; m <<= 1) ss += __shfl_xor(ss, m);
                const float rs = __builtin_amdgcn_rsqf(ss * (1.f / DV) + EPS);
                bf16* op = OUT + (orow0 + crow(r, hi)) * 1024 + r32;
#pragma unroll
                for (int d0 = 0; d0 < ND; ++d0) op[32 * d0] = (bf16)(cvtpk(o[d0][r] * rs * gs[d0], 0.f) & 0xffffu);
            }
        }
    } else {
#pragma unroll
        for (int r = 0; r < 16; ++r) {
            bf16* op = OUT + (orow0 + crow(r, hi)) * 1024 + r32;
#pragma unroll
            for (int d0 = 0; d0 < ND; ++d0) op[32 * d0] = (bf16)(cvtpk(o[d0][r] * rli[r], 0.f) & 0xffffu);
        }
    }
    asm volatile("s_waitcnt vmcnt(0) lgkmcnt(0)\n\ts_barrier" ::: "memory");
}

template <int QP>
__device__ __forceinline__ void attn_unit_band2(const bf16* Q0, const bf16* K0, const bf16* V, long rowbase, int q0, const float* tblg, bf16* OUT  , char* shm, const int wv) {
    constexpr int KSLOT = 8192, VSLOT = 8192, ND = 2;
    const int lane = lane_now(), wid = wv, tid = wid * 64 + lane, r32 = lane & 31, hi = lane >> 5;
    const int cwa = (q0 + 32 * wid) >> 6, cwb = cwa + 4, qi = ((32 * wid) & 63) + r32;
    const int t1 = (q0 + 511) >> 6;
    int t0 = (q0 >> 6) - 8; if (t0 < 0) t0 = 0;
    int loa = cwa - 8; if (loa < 0) loa = 0;
    int lob = cwb - 8; if (lob < 0) lob = 0;
    const unsigned lds0 = (unsigned)(uintptr_t)shm;
    LAS float* tb = (LAS float*)((LAS char*)shm + LDS_TBL);
    LAS float* wsf = (LAS float*)((LAS char*)shm + LDS_WS) + wid * 64;
    if (tid < 256) tb[tid] = tblg[tid];
    const bf16* Qa = Q0 + (rowbase + q0 + 32 * wid) * QP;
    const char* ksrc0 = (const char*)K0 + wid * 1024 + lane * 16;
    const char* vsrc = (const char*)V + wid * 1024 + lane * 16;
    const unsigned kdst = lds0 + LDS_K + wid * 1024, vdst = lds0 + LDS_V + wid * 1024;
    bf16x8 qa[4], qb[4];
#pragma unroll
    for (int d0 = 0; d0 < 4; ++d0) { qa[d0] = *reinterpret_cast<const bf16x8*>(&Qa[(long)r32 * QP + d0 * 16 + hi * 8]); qb[d0] = *reinterpret_cast<const bf16x8*>(&Qa[(long)(256 + r32) * QP + d0 * 16 + hi * 8]); }
#define B2_DMA(t, sl) do { \
        glds16p(ksrc0 + (long)(t) * 8192, (unsigned)__builtin_amdgcn_readfirstlane(kdst + (sl) * KSLOT)); \
        glds16p(vsrc + (long)(t) * 8192, (unsigned)__builtin_amdgcn_readfirstlane(vdst + (sl) * VSLOT)); } while (0)
    B2_DMA(t0, 0);
    if (t0 + 1 <= t1) B2_DMA(t0 + 1, 1);
    f32x16 oa[ND], ob[ND];
#pragma unroll
    for (int d = 0; d < ND; ++d) { oa[d] = f32x16{}; ob[d] = f32x16{}; }
    float la = 0.f, lb = 0.f;
    LDS_WAIT();
    __builtin_amdgcn_s_barrier();
    asm volatile("" :: "v"(qa[0]), "v"(qa[1]), "v"(qa[2]), "v"(qa[3]), "v"(qb[0]), "v"(qb[1]), "v"(qb[2]), "v"(qb[3]));
    const float cfar = tb[255];
    f32x16 cinit;
#pragma unroll
    for (int r = 0; r < 16; ++r) cinit[r] = cfar;
    const lds_cptr shm3 = (lds_cptr)shm;
    const lds_cptr kp0 = shm3 + LDS_K + hi * 1024 + r32 * 16;
    const lds_cptr vp0 = shm3 + LDS_V + ((lane >> 4) & 1) * 32 + (lane & 3) * 8 + (4 * hi + ((lane & 15) >> 2)) * 64;
    if (wid >= 4) __builtin_amdgcn_s_setprio(1);
#define B2_TILE(QR, O, L, CW, LO) do { if (t >= (LO) && t <= (CW)) { \
            f32x16 p0, p1; \
            _Pragma("unroll") for (int d0 = 0; d0 < 4; ++d0) { \
                const bf16x8 b0 = *(const LAS bf16x8*)(kp + d0 * 2048), b1 = *(const LAS bf16x8*)(kp + d0 * 2048 + 512); \
                if (d0 == 0) { p0 = __builtin_amdgcn_mfma_f32_32x32x16_bf16(b0, QR[0], cinit, 0, 0, 0); p1 = __builtin_amdgcn_mfma_f32_32x32x16_bf16(b1, QR[0], cinit, 0, 0, 0); } \
                else { p0 = __builtin_amdgcn_mfma_f32_32x32x16_bf16(b0, QR[d0], p0, 0, 0, 0); p1 = __builtin_amdgcn_mfma_f32_32x32x16_bf16(b1, QR[d0], p1, 0, 0, 0); } } \
            if (t >= (CW) - 2) {                                         \
                const LAS float* tp = tb + (64 * (t - (CW)) + 191 - qi + 4 * hi); \
                _Pragma("unroll") for (int r = 0; r < 16; ++r) { p0[r] += tp[(r & 3) + 8 * (r >> 2)]; p1[r] += tp[32 + (r & 3) + 8 * (r >> 2)]; } } \
            float sacc = 0.f; \
            _Pragma("unroll") for (int r = 0; r < 16; ++r) { p0[r] = __builtin_amdgcn_exp2f(p0[r]); p1[r] = __builtin_amdgcn_exp2f(p1[r]); sacc += p0[r] + p1[r]; } \
            L += sacc; \
            u32x4 pw[4]; \
            _Pragma("unroll") for (int q = 0; q < 4; ++q) { pw[0][q] = cvtpk(p0[2 * q], p0[2 * q + 1]); pw[1][q] = cvtpk(p0[8 + 2 * q], p0[9 + 2 * q]); \
                pw[2][q] = cvtpk(p1[2 * q], p1[2 * q + 1]); pw[3][q] = cvtpk(p1[8 + 2 * q], p1[9 + 2 * q]); } \
            _Pragma("unroll") for (int d0 = 0; d0 < ND; ++d0) \
            _Pragma("unroll") for (int ks = 0; ks < 4; ++ks) { \
                const s16x4 vlo = vtr(vp + d0 * 4096 + ks * 1024), vhi = vtr(vp + d0 * 4096 + ks * 1024 + 512); \
                const bf16x8 vf = (bf16x8){vlo[0], vlo[1], vlo[2], vlo[3], vhi[0], vhi[1], vhi[2], vhi[3]}; \
                O[d0] = __builtin_amdgcn_mfma_f32_32x32x16_bf16(__builtin_bit_cast(bf16x8, pw[ks]), vf, O[d0], 0, 0, 0); } } } while (0)
    int sl = 0;
    for (int t = t0; t <= t1; ++t) {
        if (t < t1) ATT_WAIT_BAR(2); else ATT_WAIT_BAR(0);
        if (t + 2 <= t1) { const int s2 = (sl == 0) ? 2 : sl - 1; B2_DMA(t + 2, s2); }
        const lds_cptr kp = kp0 + sl * KSLOT; const lds_cptr vp = vp0 + sl * VSLOT;
        B2_TILE(qa, oa, la, cwa, loa);
        B2_TILE(qb, ob, lb, cwb, lob);
        sl = (sl == 2) ? 0 : sl + 1;
    }
#undef B2_TILE
#undef B2_DMA
    __builtin_amdgcn_s_setprio(0);
    const int lane_e = lane_now(); const int r32e = lane_e & 31, hie = lane_e >> 5;
#define B2_OUT(O, L, ROFF) do { \
        { auto rr = __builtin_amdgcn_permlane32_swap(__float_as_uint(L), __float_as_uint(L), false, false); L = __uint_as_float(rr[0]) + __uint_as_float(rr[1]); } \
        if (hie == 0) wsf[r32e] = L; \
        LDS_WAIT(); \
        bf16* ob_ = OUT + (rowbase + q0 + (ROFF) + 32 * wid + 4 * hie) * 1024 + r32e; \
        _Pragma("unroll") for (int r = 0; r < 16; ++r) { const float rl = __builtin_amdgcn_rcpf(wsf[crow(r, hie)]); bf16* op = ob_ + ((r & 3) + 8 * (r >> 2)) * 1024; \
            _Pragma("unroll") for (int d0 = 0; d0 < ND; ++d0) op[32 * d0] = (bf16)(cvtpk(O[d0][r] * rl, 0.f) & 0xffffu); } \
        LDS_WAIT(); } while (0)
    B2_OUT(oa, la, 0);
    B2_OUT(ob, lb, 256);
#undef B2_OUT
    asm volatile("s_waitcnt vmcnt(0) lgkmcnt(0)\n\ts_barrier" ::: "memory");
}


constexpr int LDS_CONV = 134144, CONV_PITCH = 1040, CONV_BUF = 8 * CONV_PITCH, CONV_N = 96;
static_assert(LDS_CONV + 3 * CONV_BUF <= MISC_OFF && MISC_OFF + 1024 <= LDS_BYTES, "LDS map");
struct ConvState { int jd, jc, bd, bc, sgu, sd, dgu, dd; unsigned long long wg, d1, d2, WGUT, WDT; };
__device__ __forceinline__ void conv_init(ConvState& cv, int c, int wid, const float* wg, const float* wu, const float* wd, bf16* WGUT, bf16* WDT) {
    cv.jd = 0; cv.jc = 0; cv.bd = 0; cv.bc = 0; cv.wg = (unsigned long long)(uintptr_t)wg; cv.d1 = (unsigned long long)(uintptr_t)wu - cv.wg; cv.d2 = (unsigned long long)(uintptr_t)wd - (unsigned long long)(uintptr_t)wu;
    cv.WGUT = (unsigned long long)(uintptr_t)WGUT; cv.WDT = (unsigned long long)(uintptr_t)WDT;
    cv.sgu = (64 * (c >> 4) + 8 * wid) * 512 + 32 * (c & 15); cv.sd = (64 * (c >> 5) + 8 * wid) * 1024 + 32 * (c & 31);
    { const int n0 = 32 * (c & 15); cv.dgu = ((n0 >> 7) * 256 + (n0 & 127)) * 1024 + 64 * (c >> 4); } cv.dd = (32 * (c & 31)) * 512 + 64 * (c >> 5);
}
__device__ __forceinline__ void conv_dma(ConvState& cv, int wid, int lane, unsigned lds0) {
    const int j = cv.jd; const bool gu = j < 64;
    unsigned long long a = cv.wg + ((unsigned long long)(j & 31) * 524288ull + (unsigned long long)(gu ? cv.sgu : cv.sd)) * 4ull;
    a += (j >= 32) ? cv.d1 : 0ull; a += (j >= 64) ? cv.d2 : 0ull;
    glds16((const void*)(uintptr_t)a, (unsigned)((lane >> 3) * (gu ? 2048 : 4096) + (lane & 7) * 16), (unsigned)__builtin_amdgcn_readfirstlane(lds0 + LDS_CONV + cv.bd + wid * CONV_PITCH));
    cv.jd = j + 1; cv.bd = (cv.bd == 2 * CONV_BUF) ? 0 : cv.bd + CONV_BUF;
}
__device__ __forceinline__ void conv_item(const ConvState& cv, int j, int boff, int wsel, int lane, char* shm) {
    const bool gu = j < 64;
    int ln = lane; asm volatile("" : "+v"(ln));
    const int nl = 8 * wsel + (ln >> 3), kc = ln & 7;
    const LAS char* p = (const LAS char*)shm + LDS_CONV + boff + kc * CONV_PITCH + (nl >> 2) * 16 + (nl & 3) * 4;
    float f[8];
#pragma unroll
    for (int i = 0; i < 8; ++i) f[i] = *(const LAS float*)(p + 128 * i);
    u32x4 o; o.x = cvtpk(f[0], f[1]); o.y = cvtpk(f[2], f[3]); o.z = cvtpk(f[4], f[5]); o.w = cvtpk(f[6], f[7]);
    const unsigned e = (unsigned)(j & 31);
    const unsigned off = gu ? (e << 21) + ((unsigned)(j >> 5) << 18) + 2u * (unsigned)cv.dgu : (e << 20) + 2u * (unsigned)cv.dd;
    const unsigned long long pa = (gu ? cv.WGUT : cv.WDT) + (unsigned long long)off;
    const unsigned voff = (unsigned)((nl << (gu ? 11 : 10)) + kc * 16);
    *(GAS u32x4*)((GAS char*)(uintptr_t)pa + voff) = o;
}
__device__ __forceinline__ void conv_step(ConvState& cv, int wid, int lane, char* shm, unsigned lds0) {
    const int c = cv.jd - cv.jc;
    {   const int par = (cv.jc & 1) ^ (wid >> 2);
        const int jj = cv.jc + par; const int b1 = (cv.bc == 2 * CONV_BUF) ? 0 : cv.bc + CONV_BUF, b2 = (b1 == 2 * CONV_BUF) ? 0 : b1 + CONV_BUF;
        if (jj < cv.jd) conv_item(cv, jj, par ? b1 : cv.bc, wid & 3, lane, shm);
        cv.jc += c; cv.bc = (c == 0) ? cv.bc : (c == 1 ? b1 : b2); }
    if (cv.jd < CONV_N) conv_dma(cv, wid, lane, lds0);
    if (c <= 1 && cv.jd < CONV_N) conv_dma(cv, wid, lane, lds0);
}
template <int NS, int DV, int QP, int VP>
__device__ __forceinline__ void attn_unit_pipe(const bf16* Q0, const bf16* Q1p, const bf16* K0, const bf16* K1p, const bf16* V, long rowbase, int q0,
                                          const float* tblg, const float* gsub, float lam, bf16* OUT  , char* shm, ConvState& cv, const int wv) {
    constexpr int KSLOT = NS * 8192, VSLOT = DV * 128, ND = DV / 32, NVP = DV / 64, NG = 4 * ND, EPG = 32 / NG, CPG = EPG / 2, LAG = NG / 4;
    const int lane = lane_now(), wid = wv, tid = wid * 64 + lane, r32 = lane & 31, hi = lane >> 5;
    const int s = (NS == 2) ? (wid >> 2) : 0, j = (NS == 2) ? (wid & 3) : wid;
    const int ROWS = (NS == 2) ? 128 : 256;
    const int cw = (q0 + 32 * j) >> 6, qi = ((32 * j) & 63) + r32;
    const int t1 = (q0 + ROWS - 1) >> 6;
    int t0 = 0, lo_w = 0;
    if (NS == 1) { t0 = (q0 >> 6) - 8; if (t0 < 0) t0 = 0; lo_w = cw - 8; if (lo_w < 0) lo_w = 0; }
    const unsigned lds0 = (unsigned)(uintptr_t)shm;
    LAS float* tb = (LAS float*)((LAS char*)shm + LDS_TBL);
    if (tid < 256) tb[tid] = tblg[tid];
    const bf16* Qs = (s == 0) ? Q0 : Q1p;
    const bf16* Qw = Qs + (rowbase + q0 + 32 * j) * QP;
    const unsigned koff = (unsigned)(wid * 1024 + lane * 16);
    unsigned voffv[NVP];
#pragma unroll
    for (int i_ = 0; i_ < NVP; ++i_) voffv[i_] = (unsigned)((wid + 8 * i_) * 1024 + lane * 16);
    const char* kb0 = (const char*)K0; const char* kb1 = (const char*)K1p; const char* vb = (const char*)V;
    const unsigned kdst = lds0 + LDS_K + wid * 1024, vdst = lds0 + LDS_V;
    bf16x8 qr[4];
#pragma unroll
    for (int d0 = 0; d0 < 4; ++d0) qr[d0] = *reinterpret_cast<const bf16x8*>(&Qw[(long)r32 * QP + d0 * 16 + hi * 8]);
#define ATT_DMA_K(t, sl) do { \
        glds16(kb0 + (long)(t) * 8192, koff, (unsigned)__builtin_amdgcn_readfirstlane(kdst + (sl) * KSLOT)); \
        if (NS == 2) glds16(kb1 + (long)(t) * 8192, koff, (unsigned)__builtin_amdgcn_readfirstlane(kdst + (sl) * KSLOT + 8192)); } while (0)
#define ATT_DMA_V(t, sl) do { \
        _Pragma("unroll") for (int i_ = 0; i_ < NVP; ++i_) { const int p_ = wid + 8 * i_; \
            glds16(vb + (long)(t) * (DV * 128), voffv[i_], (unsigned)__builtin_amdgcn_readfirstlane(vdst + (sl) * VSLOT + p_ * 1024)); } } while (0)
#define ATT_TK(n) (((n) <= t1) ? (n) : t1)
    ATT_DMA_K(t0, 0); ATT_DMA_V(t0, 0);
    ATT_DMA_K(ATT_TK(t0 + 1), 1); ATT_DMA_K(ATT_TK(t0 + 2), 2); ATT_DMA_K(ATT_TK(t0 + 3), 3); ATT_DMA_V(ATT_TK(t0 + 1), 1);
    f32x16 o[ND];
#pragma unroll
    for (int d = 0; d < ND; ++d) o[d] = f32x16{};
    float l_reg = 0.f;
    ATT_WAIT_BAR(0);
    asm volatile("" :: "v"(qr[0]), "v"(qr[1]), "v"(qr[2]), "v"(qr[3]));
    const lds_cptr shm3 = (lds_cptr)shm;
    const lds_cptr kp0 = shm3 + LDS_K + s * 8192 + hi * 1024 + r32 * 16;
    const lds_cptr vp0 = shm3 + LDS_V + ((lane >> 4) & 1) * 32 + (lane & 3) * 8 + (4 * hi + ((lane & 15) >> 2)) * 64;
    bf16x8 kf[8];
#define ATT_KRD(i, kp) do { kf[i] = *(const LAS bf16x8*)((kp) + ((i) >> 1) * 2048 + ((i) & 1) * 512); } while (0)
#pragma unroll
    for (int i = 0; i < 8; ++i) ATT_KRD(i, kp0);
    f32x16 S0, S1;
    const f32x16 z16 = f32x16{};
    u32x4 pw[4];
#define ATT_VRD(g) do { vlo[g] = vtr(vp + ((g) % ND) * 4096 + ((g) / ND) * 1024); vhi[g] = vtr(vp + ((g) % ND) * 4096 + ((g) / ND) * 1024 + 512); } while (0)
#define ATT_VF(g) (bf16x8){vlo[g][0], vlo[g][1], vlo[g][2], vlo[g][3], vhi[g][0], vhi[g][1], vhi[g][2], vhi[g][3]}
#define ATT_NEAR(t) do { if ((t) >= cw - 2) { const LAS float* tp = tb + (64 * ((t) - cw) + 191 - qi + 4 * hi); asm volatile("" : "+v"(tp));   \
            _Pragma("unroll") for (int r = 0; r < 16; ++r) { S0[r] += tp[(r & 3) + 8 * (r >> 2)]; S1[r] += tp[32 + (r & 3) + 8 * (r >> 2)]; } } } while (0)
#define ATT_ENDW(t) do { if ((t) + 3 <= t1) { ATT_WAIT_BAR(4); } else if ((t) + 1 <= t1) { ATT_WAIT_BAR(2); } else { ATT_WAIT_BAR(0); } } while (0)
    static_assert(NS == 2 && DV == 128, "pipelined unit: differential attention only");
    {
        S0 = ATT_MFMA(kf[0], qr[0], z16); S1 = ATT_MFMA(kf[1], qr[0], z16);
#pragma unroll
        for (int d0 = 1; d0 < 4; ++d0) { S0 = ATT_MFMA(kf[2 * d0], qr[d0], S0); S1 = ATT_MFMA(kf[2 * d0 + 1], qr[d0], S1); }
        ATT_NEAR(t0);
#pragma unroll
        for (int r = 0; r < 16; ++r) { S0[r] = __builtin_amdgcn_exp2f(S0[r]); S1[r] = __builtin_amdgcn_exp2f(S1[r]); l_reg += S0[r] + S1[r]; }
#pragma unroll
        for (int q = 0; q < 4; ++q) { pw[0][q] = cvtpk(S0[2 * q], S0[2 * q + 1]); pw[1][q] = cvtpk(S0[8 + 2 * q], S0[9 + 2 * q]); pw[2][q] = cvtpk(S1[2 * q], S1[2 * q + 1]); pw[3][q] = 0u; }
        const lds_cptr kpn = kp0 + 1 * KSLOT;
#pragma unroll
        for (int i = 0; i < 8; ++i) ATT_KRD(i, kpn);
    }
#define ATT_STEP_O2() do { \
        conv_step(cv, wid, lane, shm, lds0); \
        ATT_DMA_K(ATT_TK(t + 3), (t + 3) & 3); ATT_DMA_K(ATT_TK(t + 4), (t + 4) & 3); ATT_DMA_V(ATT_TK(t + 1), (t + 1) & 3); ATT_DMA_V(ATT_TK(t + 2), (t + 2) & 3); } while (0)
#define ATT_STEP_A(TT, VR) do { \
        ATT_SB(); \
        {   const f32x16 So = S1; \
            S0 = ATT_MFMA(kf[0], qr[0], z16); \
            pw[3][0] = cvtpk(So[8], So[9]); pw[3][1] = cvtpk(So[10], So[11]); pw[3][2] = cvtpk(So[12], So[13]); pw[3][3] = cvtpk(So[14], So[15]); ATT_PIN(pw[3]); ATT_SB(); } \
        S1 = ATT_MFMA(kf[1], qr[0], z16); ATT_SB(); \
        S0 = ATT_MFMA(kf[2], qr[1], S0); ATT_SB(); \
        S1 = ATT_MFMA(kf[3], qr[1], S1); ATT_SB(); \
        S0 = ATT_MFMA(kf[4], qr[2], S0); ATT_SB(); \
        S1 = ATT_MFMA(kf[5], qr[2], S1); if (VR) ATT_VRD(0); ATT_SB(); \
        S0 = ATT_MFMA(kf[6], qr[3], S0); if (VR) ATT_VRD(1); ATT_SB(); \
        S1 = ATT_MFMA(kf[7], qr[3], S1); ATT_SB(); \
        if ((TT) <= cw) ATT_NEAR(TT); \
        ATT_SB(); } while (0)
#define ATT_STEP_B() do { \
        _Pragma("unroll") for (int g = 0; g < NG; ++g) { \
            o[g % ND] = ATT_MFMA(__builtin_bit_cast(bf16x8, pw[g / ND]), ATT_VF(g), o[g % ND]); \
            if (g + VAHEAD < NG) ATT_VRD(g + VAHEAD); \
            _Pragma("unroll") for (int e = g * EPG; e < (g + 1) * EPG; ++e) { if (e < 16) { S0[e] = __builtin_amdgcn_exp2f(S0[e]); } else { S1[e - 16] = __builtin_amdgcn_exp2f(S1[e - 16]); } } \
            _Pragma("unroll") for (int e = g * EPG; e < (g + 1) * EPG; ++e) { if (e < 16) l_reg += S0[e]; else l_reg += S1[e - 16]; } \
            if (g >= LAG) { \
                _Pragma("unroll") for (int q = (g - LAG) * CPG; q < (g - LAG + 1) * CPG; ++q) { if (q < 8) pw[q >> 2][q & 3] = cvtpk(S0[2 * q], S0[2 * q + 1]); else pw[q >> 2][q & 3] = cvtpk(S1[2 * q - 16], S1[2 * q - 15]); } \
            } \
            if (g >= 2 && g < 10) ATT_KRD(g - 2, kpn); \
            ATT_PIN(S0); ATT_PIN(S1); ATT_PIN(l_reg); \
            if (g >= LAG) { ATT_PIN(pw[(((g - LAG) * CPG) >> 2)]); } \
            ATT_SB(); \
        } } while (0)
    constexpr int VAHEAD = 2;
    lds_cptr vp = vp0, kpn = kp0; s16x4 vlo[NG], vhi[NG];
    if (s == 1) ATT_STEP_A(t0 + 1, false);
    ATT_WAIT_BAR(0);
    if (s == 1) __builtin_amdgcn_s_setprio(1);
    if (s == 0) {
        for (int t = t0 + 1; t <= t1 + 1; t += 2) {
            ATT_STEP_O2();
            vp = vp0 + ((t - 1) & 3) * VSLOT; kpn = kp0 + ((t + 1) & 3) * KSLOT;
            if (t - 1 <= cw) { const float l_keep = l_reg; ATT_STEP_A(t, true); ATT_STEP_B(); if (t > cw) l_reg = l_keep; }
            vp = vp0 + (t & 3) * VSLOT; kpn = kp0 + ((t + 2) & 3) * KSLOT;
            if (t <= cw) { const float l_keep = l_reg; ATT_STEP_A(t + 1, true); ATT_STEP_B(); if (t + 1 > cw) l_reg = l_keep; }
            ATT_WAIT_BAR(0);
        }
    } else {
        for (int t = t0 + 1; t <= t1 + 1; t += 2) {
            vp = vp0 + ((t - 1) & 3) * VSLOT; kpn = kp0 + ((t + 1) & 3) * KSLOT;
            if (t - 1 <= cw) { const float l_keep = l_reg; ATT_SB(); ATT_VRD(0); ATT_VRD(1); ATT_SB(); ATT_STEP_B(); if (t > cw) l_reg = l_keep; }
            ATT_STEP_O2();
            if (t <= cw) ATT_STEP_A(t + 1, false);
            vp = vp0 + (t & 3) * VSLOT; kpn = kp0 + ((t + 2) & 3) * KSLOT;
            if (t <= cw) { const float l_keep = l_reg; ATT_SB(); ATT_VRD(0); ATT_VRD(1); ATT_SB(); ATT_STEP_B(); if (t + 1 > cw) l_reg = l_keep; }
            if (t + 1 <= cw) ATT_STEP_A(t + 2, false);
            ATT_WAIT_BAR(0);
        }
    }
    __builtin_amdgcn_s_setprio(0);
#undef ATT_STEP_O2
#undef ATT_TK
#undef ATT_STEP_A
#undef ATT_STEP_B
#undef ATT_ENDW
    ATT_WAIT_BAR(0);
#undef ATT_DMA_K
#undef ATT_DMA_V
#undef ATT_VRD
#undef ATT_VF
#undef ATT_NEAR
#undef ATT_KRD
    { auto rr = __builtin_amdgcn_permlane32_swap(__float_as_uint(l_reg), __float_as_uint(l_reg), false, false); l_reg = __uint_as_float(rr[0]) + __uint_as_float(rr[1]); }
    const int lane_e = lane_now();
    const int r32e = lane_e & 31, hie = lane_e >> 5;
    LAS float* wsfe = (LAS float*)((LAS char*)shm + LDS_WS) + wid * 64;
    if (hie == 0) wsfe[r32e] = l_reg;
    LDS_WAIT();
    float rli[16];
#pragma unroll
    for (int r = 0; r < 16; ++r) rli[r] = __builtin_amdgcn_rcpf(wsfe[crow(r, hie)]);
    bf16* obase = OUT + (rowbase + q0 + 32 * j + 4 * hie) * 1024 + r32e;
    if (NS == 2) {
        LAS float* X = (LAS float*)((LAS char*)shm + LDS_X);
        if (s == 1) {
#pragma unroll
            for (int d0 = 0; d0 < ND; ++d0)
#pragma unroll
                for (int r = 0; r < 16; ++r) X[((j * ND + d0) * 16 + r) * 64 + lane_e] = lam * o[d0][r] * rli[r];
        }
        asm volatile("s_waitcnt lgkmcnt(0)\n\ts_barrier" ::: "memory");
        if (s == 0) {
            float gs[ND];
#pragma unroll
            for (int d0 = 0; d0 < ND; ++d0) gs[d0] = gsub[32 * d0 + r32e] * 0.8f;
            constexpr int OPITCH = DV * 2 + 16;
            LAS char* stg = (LAS char*)shm + LDS_V + j * (32 * OPITCH) + 4 * hie * OPITCH + r32e * 2;
#pragma unroll
            for (int r = 0; r < 16; ++r) {
                float ss = 0.f;
#pragma unroll
                for (int d0 = 0; d0 < ND; ++d0) { o[d0][r] = o[d0][r] * rli[r] - X[((j * ND + d0) * 16 + r) * 64 + lane_e]; ss += o[d0][r] * o[d0][r]; }
#pragma unroll
                for (int m = 0; m < 1; ++m) {
                    ss += __int_as_float(__builtin_amdgcn_update_dpp(0, __float_as_int(ss), 0x128, 0xf, 0xf, false)); ss += __int_as_float(__builtin_amdgcn_update_dpp(0, __float_as_int(ss), 0x124, 0xf, 0xf, false));
                    ss += __int_as_float(__builtin_amdgcn_update_dpp(0, __float_as_int(ss), 0x122, 0xf, 0xf, false)); ss += __int_as_float(__builtin_amdgcn_update_dpp(0, __float_as_int(ss), 0x121, 0xf, 0xf, false)); }
                { auto r16 = __builtin_amdgcn_permlane16_swap(__float_as_uint(ss), __float_as_uint(ss), false, false); ss = __uint_as_float(r16[0]) + __uint_as_float(r16[1]); }
                const float rs = __builtin_amdgcn_rsqf(ss * (1.f / DV) + EPS);
                LAS char* sp = stg + ((r & 3) + 8 * (r >> 2)) * OPITCH;
#pragma unroll
                for (int d0 = 0; d0 < ND; ++d0) *(LAS unsigned short*)(sp + 64 * d0) = (unsigned short)(cvtpk(o[d0][r] * rs * gs[d0], 0.f) & 0xffffu);
            }
            asm volatile("s_waitcnt lgkmcnt(0)" ::: "memory");
            const LAS char* rp = (const LAS char*)shm + LDS_V + j * (32 * OPITCH) + (lane_e >> 4) * OPITCH + (lane_e & 15) * 16;
            bf16* gp = OUT + (rowbase + q0 + 32 * j + (lane_e >> 4)) * 1024 + (lane_e & 15) * 8;
#pragma unroll
            for (int i = 0; i < 8; ++i) *(u32x4*)(gp + (size_t)(4 * i) * 1024) = *(const LAS u32x4*)(rp + 4 * i * OPITCH);
        }
    } else {
#pragma unroll
        for (int r = 0; r < 16; ++r) {
            bf16* op = obase + ((r & 3) + 8 * (r >> 2)) * 1024;
#pragma unroll
            for (int d0 = 0; d0 < ND; ++d0) op[32 * d0] = (bf16)(cvtpk(o[d0][r] * rli[r], 0.f) & 0xffffu);
        }
    }
    asm volatile("s_waitcnt vmcnt(0) lgkmcnt(0)\n\ts_barrier" ::: "memory");
}
}

__device__ __forceinline__ unsigned f2bf(float f) { unsigned u = __builtin_bit_cast(unsigned, f); return (u + 0x7fffu + ((u >> 16) & 1u)) >> 16; }
__device__ __forceinline__ unsigned pk2(float lo, float hi) { return f2bf(lo) | (f2bf(hi) << 16); }
struct TrItem { const GAS f32x4* src; GAS u32x4* d; int ls, ds; };
__device__ __forceinline__ TrItem tr_item(const float* W, int ldw, int k0, int n0, bf16* dst, int ldd, int drow0, int kd0, int lane) {
    const int kc = lane >> 3, nq = lane & 7; TrItem t;
    t.src = (const GAS f32x4*)(W + (size_t)(k0 + 8 * kc) * ldw + n0 + 4 * nq); t.ls = ldw / 4;
    t.d = (GAS u32x4*)(dst + (size_t)(drow0 + 4 * nq) * ldd + kd0 + 8 * kc); t.ds = ldd / 8; return t;
}
__device__ __forceinline__ void tr_load(const TrItem& t, f32x4 (&v)[8]) {
#pragma unroll
    for (int i = 0; i < 8; ++i) v[i] = t.src[(size_t)i * t.ls];
}
__device__ __forceinline__ void tr_store(const TrItem& t, const f32x4 (&v)[8]) {
#pragma unroll
    for (int j = 0; j < 4; ++j) { u32x4 o; o.x = cvt_pk_bf16(v[0][j], v[1][j]); o.y = cvt_pk_bf16(v[2][j], v[3][j]); o.z = cvt_pk_bf16(v[4][j], v[5][j]); o.w = cvt_pk_bf16(v[6][j], v[7][j]);
        t.d[(size_t)j * t.ds] = o; }
}
__device__ __forceinline__ int t5_bucket(int rel) {
    const int side = rel > 0 ? 16 : 0; const int n = rel < 0 ? -rel : rel;
    int b;
    if (n < 8) b = n; else if (n < 12) b = 8; else if (n < 16) b = 9; else if (n < 23) b = 10; else if (n < 32) b = 11; else if (n < 46) b = 12; else if (n < 64) b = 13; else if (n < 91) b = 14; else b = 15;
    return side + b;
}

struct Args { const float* in[22]; float* out; unsigned char* ws; int ph_lo, ph_hi; };

__global__ void __launch_bounds__(512, 2) mk_fwd(Args args) {
    extern __shared__ __attribute__((aligned(16))) unsigned char lds_raw[];
    LAS unsigned char* lds = (LAS unsigned char*)lds_raw;
    volatile LAS unsigned* MISC = (volatile LAS unsigned*)(lds + MISC_OFF);
    const int wave = __builtin_amdgcn_readfirstlane((int)threadIdx.x >> 6);
#define MK_LANE_TID() const int lane = lane_now(), tid = wave * 64 + lane; (void)tid
    const int G = gridDim.x; const int bx = blockIdx.x; const int vcu = (G % 8 == 0) ? (bx % 8) * (G / 8) + bx / 8 : bx;
    unsigned char* ws = args.ws;
    unsigned* ctl = (unsigned*)(ws + WS_CTL);
    { MK_LANE_TID(); for (int u = tid; u < 64; u += 512) ((LAS unsigned*)(lds + MISC_OFF))[u] = 0u; }
    __syncthreads();
    XcdBarrier bar; bar.bar = ctl + CW_BAR; bar.x = 0; bar.st = nullptr; bar.w0 = (wave == 0);
    if (MK_N_LAUNCHES == 1) bar = xcd_barrier_post(ctl + CW_BAR, MISC + 8, wave == 0);
    const int lo = args.ph_lo, hi = args.ph_hi;
    unsigned long long ts_a = 0, ts_b = 0;
#define IN(k) (lo <= (k) && (k) < hi)
#define SEAM(k) do { if (MK_N_LAUNCHES == 1 && IN(k) && IN((k) + 1)) xcd_barrier(bar); } while (0)

    const float* x = args.in[0];
    float* out = args.out;
    bf16* WINT = (bf16*)(ws + WS_WINT); bf16* WABT = (bf16*)(ws + WS_WABT); bf16* WOT = (bf16*)(ws + WS_WOT); bf16* WGUT = (bf16*)(ws + WS_WGUT); bf16* WDT = (bf16*)(ws + WS_WDT);
    bf16* XB = (bf16*)(ws + WS_XB); bf16* OAB = (bf16*)(ws + WS_OAB); bf16* QK = (bf16*)(ws + WS_QK); bf16* MIXED = (bf16*)(ws + WS_MIXED);
    bf16* VA = (bf16*)(ws + WS_VA); bf16* QBb = (bf16*)(ws + WS_QB); bf16* KBb = (bf16*)(ws + WS_KB); bf16* VBb = (bf16*)(ws + WS_VB);
    bf16* HN = (bf16*)out;
    bf16* HB = (bf16*)(ws + WS_H); bf16* YB = (bf16*)(ws + WS_Y); bf16* AO = (bf16*)(ws + WS_AO);
    bf16* GATES = (bf16*)out;
    float* TBLA = (float*)(ws + WS_TBLA); float* TBLB = (float*)(ws + WS_TBLB); float* LAMV = (float*)(ws + WS_LAM);
    bf16* WRH = (bf16*)(ws + WS_WR); bf16* WRL = WRH + 48 * 1024; float* LISTR = (float*)(ws + WS_LISTR);
    int* TOKPOS = (int*)(ws + WS_TOKPOS); int* LISTTOK = (int*)(ws + WS_LISTTOK); float* LISTW = (float*)(ws + WS_LISTW); unsigned* CURSOR = ctl + CW_CURSOR;

    if (TS_PHASE == 0) ts_a = __builtin_amdgcn_s_memrealtime();
    if (IN(0)) for (int rep = 0; rep < REP0; ++rep) { MK_LANE_TID();
        const int gw = vcu * 8 + wave, NGW = G * 8;
        constexpr int I_IN = 16 * 160, I_A = 8 * 32, I_B = 8 * 32, I_O = 16 * 32;
        constexpr int NITEMS = I_IN + I_A + I_B + I_O;
        static_assert(I_IN % 2 == 0 && I_A % 2 == 0 && I_B % 2 == 0 && I_O % 2 == 0, "batches of 2 items never straddle two matrices");
        for (int bt = gw; bt < NITEMS / 2; bt += NGW) {
            TrItem ti[2];
#pragma unroll
            for (int u = 0; u < 2; ++u) {
                int r = bt * 2 + u;
                if (r < I_IN) { const int kb = r / 160, nb = r % 160, n0 = 32 * nb, pn = n0 >> 8, cg = (n0 & 255) >> 5, wcc = cg >> 1, bjj = cg & 1;
                    int drow = pn * 256 + 128 * bjj + 32 * wcc;
                    if (pn >= 12) { const int gcol = n0 - 3072, isb = gcol >> 10, gg = gcol & 1023; drow = (12 + (gg >> 7)) * 256 + 128 * isb + (gg & 127); }
                    ti[u] = tr_item(args.in[2], PROJ, 64 * kb, n0, WINT, 1024, drow, 64 * kb, lane); }
                else if ((r -= I_IN) < I_A) { const int kb = r / 32, nb = r % 32; ti[u] = tr_item(args.in[11], 1024, 64 * kb, 32 * nb, WABT, 1024, 32 * nb, 64 * kb, lane); }
                else if ((r -= I_A) < I_B) { const int kb = r / 32, nb = r % 32; ti[u] = tr_item(args.in[12], 1024, 64 * kb, 32 * nb, WABT, 1024, 32 * nb, 512 + 64 * kb, lane); }
                else { r -= I_B; const int kb = r / 32, nb = r % 32; ti[u] = tr_item(args.in[13], 1024, 64 * kb, 32 * nb, WOT, 1024, 32 * nb, 64 * kb, lane); }
            }
            f32x4 v[2][8];
#pragma unroll
            for (int u = 0; u < 2; ++u) tr_load(ti[u], v[u]);
#pragma unroll
            for (int u = 0; u < 2; ++u) tr_store(ti[u], v[u]);
        }
        {   const GAS f32x4* gr = (const GAS f32x4*)args.in[1] + lane; f32x4 gg[4];
#pragma unroll
            for (int j = 0; j < 4; ++j) gg[j] = gr[64 * j];
            for (int m0 = gw * 4; m0 < T; m0 += NGW * 4) {
                f32x4 v[4][4];
#pragma unroll
                for (int u = 0; u < 4; ++u) { const GAS f32x4* xr = (const GAS f32x4*)(x + (size_t)(m0 + u) * D) + lane;
#pragma unroll
                    for (int j = 0; j < 4; ++j) v[u][j] = xr[64 * j]; }
#pragma unroll
                for (int u = 0; u < 4; ++u) { float ssq = 0.f;
#pragma unroll
                    for (int j = 0; j < 4; ++j) ssq += (v[u][j].x * v[u][j].x + v[u][j].y * v[u][j].y) + (v[u][j].z * v[u][j].z + v[u][j].w * v[u][j].w);
                    const float rstd = __builtin_amdgcn_rsqf(wave_sum(ssq) * (1.f / D) + EPS);
                    GAS u32x2* o8 = (GAS u32x2*)(XB + (size_t)(m0 + u) * D) + lane;
#pragma unroll
                    for (int j = 0; j < 4; ++j) { u32x2 w; w.x = cvt_pk_bf16(v[u][j].x * rstd * gg[j].x, v[u][j].y * rstd * gg[j].y); w.y = cvt_pk_bf16(v[u][j].z * rstd * gg[j].z, v[u][j].w * rstd * gg[j].w); o8[64 * j] = w; } }
            }
        }
        for (int idx = gw * 64 + lane; idx < 48 * 1024; idx += NGW * 64) { const int n = idx >> 10, k = idx & 1023; float w = 0.f;
            if (n < 32) w = args.in[17][k * 32 + n]; else if (n < 36) w = args.in[15][k * 4 + (n - 32)];
            w *= args.in[14][k]; const unsigned hb = cvt_pk_bf16(w, 0.f) & 0xffffu;
            const size_t d = ((size_t)((k >> 7) * 2) * 16 + ((k >> 3) & 15)) * 384 + n * 8 + (k & 7);
            WRH[d] = (bf16)hb; WRH[d + 16 * 384] = (bf16)(cvt_pk_bf16(w - __uint_as_float(hb << 16), 0.f) & 0xffffu); }
        for (int idx = gw * 64 + lane; idx < 12 * 256; idx += NGW * 64) {
            const int hh = idx >> 8, i = idx & 255; const bool isA = hh < 4; const int h = isA ? hh : hh - 4;
            const float farv = isA ? args.in[7][15 * 4 + h] : args.in[10][0 * 8 + h];
            float v;
            if (i == 255) v = farv * LOG2E;
            else { const int rel = i - 191; float b;
                if (isA) b = args.in[7][t5_bucket(rel) * 4 + h];
                else { int ri = rel < -128 ? -128 : (rel > 128 ? 128 : rel); b = args.in[10][(ri + 128) * 8 + h]; }
                v = (b - farv) * LOG2E; }
            (isA ? TBLA : TBLB)[h * 256 + i] = v;
        }
        if (gw == 0) { const float* lp = args.in[5]; const float a = wave_sum(lp[lane] * lp[64 + lane]), b = wave_sum(lp[128 + lane] * lp[192 + lane]);
            if (lane == 0) LAMV[0] = expf(a) - expf(b) + 0.2f; }
    }
    SEAM(0);
    if (TS_PHASE == 0) ts_b = __builtin_amdgcn_s_memrealtime();

    if (TS_PHASE == 1 || (TS_PHASE >= 120 && TS_PHASE <= 129)) ts_a = __builtin_amdgcn_s_memrealtime();
    if (IN(1)) for (int rep = 0; rep < REP1; ++rep) { MK_LANE_TID();
        pg8::DenseSched S{(const char*)XB, (const char*)WINT, 1024, 1024, T / 256, PROJ / 256, G, bx, 1, 1024};
        EpiProj E{QK, VA, QBb, KBb, VBb, GATES, args.in[3], args.in[4], args.in[8], args.in[9]};
        pg8::gemm_phase<EpiProj, pg8::DenseSched, true>(lds, 1024, S, E, wave);
    }
    SEAM(1);
    if (TS_PHASE >= 120 && TS_PHASE <= 129) ts_b = *(LAS unsigned long long*)(lds + MISC_OFF + 128);
    if (TS_PHASE == 1) ts_b = __builtin_amdgcn_s_memrealtime();

    if (TS_PHASE == 2) ts_a = __builtin_amdgcn_s_memrealtime();
    if (IN(2)) { MK_LANE_TID();
        const float lam = LAMV[0];
        att::ConvState cv; att::conv_init(cv, vcu, wave, args.in[19], args.in[20], args.in[21], WGUT, WDT);
        for (int i = 0; i < 2 * REP2A; ++i) {
            const int uidx = vcu; const int bh = uidx >> 5, sidx = uidx & 31; const int qb = ((i & 1) == 0) ? sidx : 63 - sidx;
            const int b = bh >> 2, h = bh & 3;
            if (vcu < 256)
            att::attn_unit_pipe<2, 128, 256, 512>(QK + h * 64, QK + (size_t)T * 256 + h * 64, QK + (size_t)2 * T * 256 + (size_t)(b * 4 + h) * 128 * 4096, QK + (size_t)3 * T * 256 + (size_t)(b * 4 + h) * 128 * 4096, VA + (size_t)(b * 4 + h) * 128 * 8192,
                                              (long)b * SEQ, qb * 128, TBLA + h * 256, args.in[6], lam, OAB + h * 128, (char*)lds_raw, cv, wave);
        }
        while (cv.jc < att::CONV_N) {
            asm volatile("s_waitcnt vmcnt(0) lgkmcnt(0)\n\ts_barrier" ::: "memory");
            const int ln = lane_now();
            att::conv_step(cv, wave, ln, (char*)lds_raw, (unsigned)(uintptr_t)(char*)lds_raw);
        }
        asm volatile("s_waitcnt vmcnt(0) lgkmcnt(0)\n\ts_barrier" ::: "memory");
        for (int i = 0; i < REP2B; ++i) {
            int vcu2 = vcu; asm volatile("" : "+s"(vcu2));
            const int bh = vcu2 >> 4, g2 = vcu2 & 15; const int b = bh >> 3, h = bh & 7;
            if (vcu2 < 256)
            att::attn_unit_band2<512>(QBb + h * 64, KBb + (size_t)(b * 8 + h) * 128 * 4096, VBb + (size_t)(b * 8 + h) * 128 * 4096, (long)b * SEQ, g2 * 512, TBLB + h * 256, OAB + 512 + h * 64, (char*)lds_raw, wave);
        }
    }
    SEAM(2);
    if (TS_PHASE == 2) ts_b = __builtin_amdgcn_s_memrealtime();

    if (TS_PHASE == 3 || TS_PHASE == 107) ts_a = __builtin_amdgcn_s_memrealtime();
    if (IN(3)) for (int rep = 0; rep < REP3; ++rep) { MK_LANE_TID();
        pg8::DenseSched S{(const char*)OAB, (const char*)WABT, 1024, 1024, T / 256, D / 256, G, bx, 2, 512};
        EpiAB E{GATES, MIXED, ctl + CW_MIXCTR};
        pg8::gemm_phase<EpiAB, pg8::DenseSched, true>(lds, 512, S, E, wave);
        if (TS_PHASE == 107) { __syncthreads(); ts_b = __builtin_amdgcn_s_memrealtime(); }
    }
    if (TS_PHASE == 3) ts_b = __builtin_amdgcn_s_memrealtime();

#define TILE_WAIT2(p0, p1) do { if (wave == 0) { unsigned* cps_[2] = {(p0), (p1)}; \
            _Pragma("unroll") for (int w_ = 0; w_ < 2; ++w_) { unsigned spins_ = 0; \
                while ((unsigned)__builtin_amdgcn_readfirstlane(__hip_atomic_load(cps_[w_], __ATOMIC_RELAXED, __HIP_MEMORY_SCOPE_AGENT)) < 32u) { __builtin_amdgcn_s_sleep(2); if (++spins_ > (1u << 22)) break; } } \
            __builtin_amdgcn_fence(__ATOMIC_ACQUIRE, "agent"); asm volatile("s_waitcnt vmcnt(0)" ::: "memory"); } \
        __syncthreads(); } while (0)
    if (TS_PHASE == 4 || TS_PHASE == 108) ts_a = __builtin_amdgcn_s_memrealtime();
    if (IN(4)) for (int rep = 0; rep < REP4; ++rep) { MK_LANE_TID();
        pg8::DenseSched S{(const char*)MIXED, (const char*)WOT, 1024, 1024, T / 256, D / 256, G, bx, 1, 1024};
        { pg8::Unit u0; if (S.next(0, u0)) { unsigned* cp = ctl + CW_MIXCTR + 64 * u0.pm; TILE_WAIT2(cp, cp); } else { __syncthreads(); } }
        EpiAO E{AO, ctl + CW_AOCTR};
        pg8::gemm_phase<EpiAO, pg8::DenseSched, true>(lds, 1024, S, E, wave);
        if (TS_PHASE == 108) { __syncthreads(); ts_b = __builtin_amdgcn_s_memrealtime(); }
    }
    if (TS_PHASE == 4) ts_b = __builtin_amdgcn_s_memrealtime();

    if (TS_PHASE == 5 || TS_PHASE == 105 || TS_PHASE == 106) ts_a = __builtin_amdgcn_s_memrealtime();
    if (IN(5)) for (int rep = 0; rep < REP5; ++rep) { MK_LANE_TID();
        LAS float* LG = (LAS float*)lds;
        LAS float* SQ = LG + 2 * 64 * 48;
        LAS int* CNT = (LAS int*)(SQ + 128); LAS int* BASE = CNT + 32;
        if (tid < 32) CNT[tid] = 0;
        __syncthreads();
        for (int task = vcu; task < T / 64; task += G) {
            TILE_WAIT2(ctl + CW_AOCTR + 64 * (task >> 2), ctl + CW_MIXCTR + 64 * (task >> 3));
            {
                const int rl = lane & 15, q = lane >> 4, rb = (wave & 3) * 16, ch = wave >> 2;
                const unsigned urow = (unsigned)((task * 64 + rb) * D);
                const unsigned vx = (unsigned)(rl * D + 8 * q) * 4u, va = (unsigned)(rl * D + 8 * q) * 2u, vg = (unsigned)(8 * q) * 4u;
                const __amdgpu_buffer_rsrc_t rx = __builtin_amdgcn_make_buffer_rsrc((void*)x, 0, T * D * 4, 0x00020000), rw = __builtin_amdgcn_make_buffer_rsrc((void*)ws, 0, (int)WS_END, 0x00020000);
                const __amdgpu_buffer_rsrc_t ro = __builtin_amdgcn_make_buffer_rsrc((void*)out, 0, T * D * 4, 0x00020000), rg = __builtin_amdgcn_make_buffer_rsrc((void*)args.in[14], 0, D * 4, 0x00020000);
                constexpr unsigned STG = 32768u, STB = 24576u;
                const unsigned ldsb = (unsigned)(uintptr_t)(char*)lds_raw;
                const LAS char* wfr = (const LAS char*)lds + STG + ((8 * ch + q) * 48 + rl) * 16;
#define P5_LD(rs, vo, so) __builtin_bit_cast(u32x4, __builtin_amdgcn_raw_buffer_load_b128(rs, vo, so, 0))
#define P5_DMAW(c_, buf_) do { _Pragma("unroll") for (int p3_ = 0; p3_ < 3; ++p3_) att::glds16((const char*)WRH + (size_t)(c_) * STB, (unsigned)((wave + 8 * p3_) * 1024 + lane * 16), \
                               (unsigned)__builtin_amdgcn_readfirstlane((int)(ldsb + STG + (buf_) * STB + (unsigned)(wave + 8 * p3_) * 1024u))); } while (0)
#define P5_LOADS(b_, c_) do { _Pragma("unroll") for (int i_ = 0; i_ < 2; ++i_) { const unsigned col0_ = 128u * (c_) + 64u * ch + 32u * i_; \
                    xa[b_][i_] = __builtin_bit_cast(f32x4, P5_LD(rx, vx, (urow + col0_) * 4u)); xb[b_][i_] = __builtin_bit_cast(f32x4, P5_LD(rx, vx, (urow + col0_) * 4u + 16u)); \
                    aws[b_][i_] = P5_LD(rw, va, (unsigned)WS_AO + (urow + col0_) * 2u); \
                    ga[b_][i_] = __builtin_bit_cast(f32x4, P5_LD(rg, vg, col0_ * 4u)); gb[b_][i_] = __builtin_bit_cast(f32x4, P5_LD(rg, vg, col0_ * 4u + 16u)); } } while (0)
                f32x4 xa[2][2], xb[2][2], ga[2][2], gb[2][2]; u32x4 aws[2][2];
                f32x4 a0 = {0.f, 0.f, 0.f, 0.f}, a1 = a0, a2 = a0; float ssq = 0.f;
                P5_DMAW(0, 0); P5_LOADS(0, 0);
                asm volatile("s_waitcnt vmcnt(0) lgkmcnt(0)\n\ts_barrier" ::: "memory");
#pragma unroll
                for (int c = 0; c < 8; ++c) { const int b = c & 1;
                    if (c + 1 < 8) { P5_DMAW(c + 1, b ^ 1); P5_LOADS(b ^ 1, c + 1); }
#pragma unroll
                    for (int i = 0; i < 2; ++i) { f32x4 x0 = xa[b][i], x1v = xb[b][i]; const u32x4 aw = aws[b][i]; const f32x4 g0 = ga[b][i], g1 = gb[b][i];
                        x0[0] += __uint_as_float(aw.x << 16); x0[1] += __uint_as_float(aw.x & 0xffff0000u); x0[2] += __uint_as_float(aw.y << 16); x0[3] += __uint_as_float(aw.y & 0xffff0000u);
                        x1v[0] += __uint_as_float(aw.z << 16); x1v[1] += __uint_as_float(aw.z & 0xffff0000u); x1v[2] += __uint_as_float(aw.w << 16); x1v[3] += __uint_as_float(aw.w & 0xffff0000u);
                        u32x4 xh, xl;
                        { const float f[8] = {x0[0], x0[1], x0[2], x0[3], x1v[0], x1v[1], x1v[2], x1v[3]};
#pragma unroll
                          for (int p = 0; p < 4; ++p) { const unsigned hw = cvt_pk_bf16(f[2 * p], f[2 * p + 1]); xh[p] = hw;
                              xl[p] = cvt_pk_bf16(f[2 * p] - __uint_as_float(hw << 16), f[2 * p + 1] - __uint_as_float(hw & 0xffff0000u)); } }
                        { u32x4 hw; hw.x = cvt_pk_bf16(x0[0] * g0[0], x0[1] * g0[1]); hw.y = cvt_pk_bf16(x0[2] * g0[2], x0[3] * g0[3]); hw.z = cvt_pk_bf16(x1v[0] * g1[0], x1v[1] * g1[1]); hw.w = cvt_pk_bf16(x1v[2] * g1[2], x1v[3] * g1[3]);
                          __builtin_amdgcn_raw_buffer_store_b128(hw, ro, va, (urow + 128u * c + 64u * ch + 32u * i) * 2u, 0); }
                        const LAS char* wp = wfr + b * STB + (4 * i * 48) * 16;
                        const bf16x8 h0 = *(const LAS bf16x8*)(wp), h1 = *(const LAS bf16x8*)(wp + 256), h2 = *(const LAS bf16x8*)(wp + 512);
                        const bf16x8 l0 = *(const LAS bf16x8*)(wp + 12288), l1 = *(const LAS bf16x8*)(wp + 12288 + 256), l2 = *(const LAS bf16x8*)(wp + 12288 + 512);
                        const bf16x8 ah = __builtin_bit_cast(bf16x8, xh), al = __builtin_bit_cast(bf16x8, xl);
                        a0 = __builtin_amdgcn_mfma_f32_16x16x32_bf16(ah, h0, a0, 0, 0, 0); a1 = __builtin_amdgcn_mfma_f32_16x16x32_bf16(ah, h1, a1, 0, 0, 0); a2 = __builtin_amdgcn_mfma_f32_16x16x32_bf16(ah, h2, a2, 0, 0, 0);
                        a0 = __builtin_amdgcn_mfma_f32_16x16x32_bf16(ah, l0, a0, 0, 0, 0); a1 = __builtin_amdgcn_mfma_f32_16x16x32_bf16(ah, l1, a1, 0, 0, 0); a2 = __builtin_amdgcn_mfma_f32_16x16x32_bf16(ah, l2, a2, 0, 0, 0);
                        a0 = __builtin_amdgcn_mfma_f32_16x16x32_bf16(al, h0, a0, 0, 0, 0); a1 = __builtin_amdgcn_mfma_f32_16x16x32_bf16(al, h1, a1, 0, 0, 0); a2 = __builtin_amdgcn_mfma_f32_16x16x32_bf16(al, h2, a2, 0, 0, 0);
                        ssq += (x0.x * x0.x + x0.y * x0.y) + (x0.z * x0.z + x0.w * x0.w) + (x1v.x * x1v.x + x1v.y * x1v.y) + (x1v.z * x1v.z + x1v.w * x1v.w);
                    }
                    if (c + 1 < 8) asm volatile("s_waitcnt vmcnt(2) lgkmcnt(0)\n\ts_barrier" ::: "memory");
                }
#undef P5_LOADS
#undef P5_DMAW
#undef P5_LD
                ssq += __shfl_xor(ssq, 16); ssq += __shfl_xor(ssq, 32);
                const int kh = ch;
#pragma unroll
                for (int r = 0; r < 4; ++r) { LAS float* lp = LG + (kh * 64 + rb + 4 * q + r) * 48 + rl; lp[0] = a0[r]; lp[16] = a1[r]; lp[32] = a2[r]; }
                if (q == 0) SQ[kh * 64 + rb + rl] = ssq;
            }
            __syncthreads();
            if (TS_PHASE == 105) ts_b = __builtin_amdgcn_s_memrealtime();
            if (wave == 0) {
                const int row = task * 64 + lane; const float rs = __builtin_amdgcn_rsqf((SQ[lane] + SQ[64 + lane]) * (1.f / D) + EPS); const LAS float* lg = LG + lane * 48; const LAS float* lg2 = lg + 64 * 48;
                float gl[4]; float gmax = -3.0e38f; int gi = 0;
#pragma unroll
                for (int jj = 0; jj < 4; ++jj) { gl[jj] = (lg[32 + jj] + lg2[32 + jj]) * rs + args.in[16][jj]; if (gl[jj] > gmax) { gmax = gl[jj]; gi = jj; } }
                float gsum = 0.f;
#pragma unroll
                for (int jj = 0; jj < 4; ++jj) gsum += __expf(gl[jj] - gmax);
                const float pg = 1.f / gsum;
                float el[8]; float b1 = -3.0e38f, b2 = -3.0e38f; int i1 = 0, i2 = 0;
#pragma unroll
                for (int jj = 0; jj < 8; ++jj) { el[jj] = (lg[8 * gi + jj] + lg2[8 * gi + jj]) * rs + args.in[18][8 * gi + jj]; if (el[jj] > b1) { b1 = el[jj]; i1 = jj; } }
#pragma unroll
                for (int jj = 0; jj < 8; ++jj) { if (jj != i1 && el[jj] > b2) { b2 = el[jj]; i2 = jj; } }
                const float wa = pg / (1.f + __expf(b2 - b1)), wb = pg - wa;
                const int e1 = 8 * gi + i1, e2 = 8 * gi + i2;
                const int r1 = __hip_atomic_fetch_add(&CNT[e1], 1, __ATOMIC_RELAXED, __HIP_MEMORY_SCOPE_WORKGROUP), r2 = __hip_atomic_fetch_add(&CNT[e2], 1, __ATOMIC_RELAXED, __HIP_MEMORY_SCOPE_WORKGROUP);
                LDS_WAIT();
                if (lane < 32) { const int c = CNT[lane]; CNT[lane] = 0; BASE[lane] = c > 0 ? (int)__hip_atomic_fetch_add(CURSOR + 64 * lane, (unsigned)c, __ATOMIC_RELAXED, __HIP_MEMORY_SCOPE_AGENT) : 0; }
                LDS_WAIT();
                const int p1 = BASE[e1] + r1, p2 = BASE[e2] + r2;
                LISTTOK[e1 * CAP + p1] = row; LISTW[e1 * CAP + p1] = wa; LISTR[e1 * CAP + p1] = rs; LISTTOK[e2 * CAP + p2] = row; LISTW[e2 * CAP + p2] = wb; LISTR[e2 * CAP + p2] = rs;
                TOKPOS[2 * row] = (e1 << 16) | p1; TOKPOS[2 * row + 1] = (e2 << 16) | p2;
            }
            __syncthreads();
            if (TS_PHASE == 106) ts_b = __builtin_amdgcn_s_memrealtime();
        }
    }
    SEAM(5);
    if (TS_PHASE == 5) ts_b = __builtin_amdgcn_s_memrealtime();

    LAS int* MOE_CNT = (LAS int*)(lds + MISC_OFF + 256); LAS int* MOE_TB = MOE_CNT + 32;
    if (hi > 6) {
        if (wave == 0) { MK_LANE_TID();
            const int e = lane & 31; const int cnt = (int)__hip_atomic_load(CURSOR + 64 * e, __ATOMIC_RELAXED, __HIP_MEMORY_SCOPE_AGENT); const int nt = (cnt + 255) >> 8;
            int incl = nt;
#pragma unroll
            for (int o = 1; o < 32; o <<= 1) { const int v = __shfl_up(incl, o); if ((lane & 31) >= o) incl += v; }
            if (lane < 32) { MOE_CNT[e] = cnt; MOE_TB[e] = incl - nt; if (e == 31) MOE_TB[32] = incl; }
        }
        __syncthreads();
    }
    const int cmoe = (G == 256) ? 4 * (((vcu & 31) >> 2) * 8 + (vcu >> 5)) + (vcu & 3) : vcu;
#define MOE_LOOKUP(mu, nunits, l0, l1, l2) do { nunits = MOE_TB[32] * 4; \
        _Pragma("unroll") for (int i_ = 0; i_ < 3; ++i_) { const int L_ = (i_ == 0) ? (l0) : (i_ == 1 ? (l1) : (l2)); int e_ = 0, p_ = 0, n_ = 1; mu.L[i_] = __builtin_amdgcn_readfirstlane(L_); \
            if (L_ < nunits) { const int rt_ = L_ >> 2; for (int q_ = 0; q_ < 32; ++q_) { if (MOE_TB[q_] <= rt_ && rt_ < MOE_TB[q_ + 1]) e_ = q_; } p_ = (rt_ - MOE_TB[e_]) * 256; n_ = MOE_CNT[e_]; } \
            mu.e[i_] = __builtin_amdgcn_readfirstlane(e_); mu.pos0[i_] = __builtin_amdgcn_readfirstlane(p_); mu.n[i_] = __builtin_amdgcn_readfirstlane(n_); } } while (0)

    if (TS_PHASE == 6) ts_a = __builtin_amdgcn_s_memrealtime();
    if (IN(6)) for (int rep = 0; rep < REP6; ++rep) { MK_LANE_TID();
        pg8::MoeUnits mu; int nunits; MOE_LOOKUP(mu, nunits, cmoe, cmoe + G, cmoe + 2 * G);
        pg8::MoeSched<true> S{(const char*)HN, (const char*)WGUT, LISTTOK, 1024, 1024, G, cmoe, nunits, mu, (size_t)1024 * 1024 * 2, 0, 3};
        EpiGU E{HB, LISTR, ctl + CW_TILECTR};
        pg8::gemm_phase<EpiGU, pg8::MoeSched<true>, true>(lds, 1024, S, E, wave);
    }
    if (TS_PHASE == 6) ts_b = __builtin_amdgcn_s_memrealtime();

    if (TS_PHASE == 7) ts_a = __builtin_amdgcn_s_memrealtime();
    if (IN(7)) for (int rep = 0; rep < REP7; ++rep) { MK_LANE_TID();
        const int U = MOE_TB[32] * 4;
        int l0, l1, l2;
        if (G == 256 && U <= 640) {
            const int n3 = U > 2 * G ? U - 2 * G : 0, NL = G - n3;
            if (cmoe >= n3) { const int r = cmoe - n3; l0 = r; l1 = NL + r; l2 = 2 * NL + n3 + r; }
            else { l0 = 2 * NL + cmoe; l1 = 3 * NL + n3 + cmoe; l2 = U; }
        } else { const int cc = G - 1 - cmoe; l0 = cc; l1 = cc + G; l2 = cc + 2 * G; }
        pg8::MoeUnits mu; int nunits; MOE_LOOKUP(mu, nunits, l0, l1, l2);
        EpiDown E{YB, LISTW};
#pragma unroll
        for (int part = 0; part < 2; ++part) {
            const int i0 = part * 2, i1 = part == 0 ? 2 : 3;
            if (mu.L[i0] >= nunits) break;
            if (wave == 0) {
                for (int i = i0; i < i1; ++i) { const int L = mu.L[i]; if (L >= nunits) break;
                    unsigned* cp = ctl + CW_TILECTR + 64 * (L >> 2); unsigned spins = 0;
                    while ((unsigned)__builtin_amdgcn_readfirstlane(__hip_atomic_load(cp, __ATOMIC_RELAXED, __HIP_MEMORY_SCOPE_AGENT)) < 32u) { __builtin_amdgcn_s_sleep(2); if (++spins > (1u << 22)) break; } }
                __builtin_amdgcn_fence(__ATOMIC_ACQUIRE, "agent");
                asm volatile("s_waitcnt vmcnt(0)" ::: "memory");
            }
            __syncthreads();
            pg8::MoeSched<false> S{(const char*)HB, (const char*)WDT, LISTTOK, 512, 512, G, cmoe, nunits, mu, (size_t)1024 * 512 * 2, i0, i1 - i0};
            pg8::gemm_phase<EpiDown, pg8::MoeSched<false>, true>(lds, 512, S, E, wave);
        }
    }
    SEAM(7);
    if (TS_PHASE == 7) ts_b = __builtin_amdgcn_s_memrealtime();

    if (TS_PHASE == 8) ts_a = __builtin_amdgcn_s_memrealtime();
    if (IN(8)) { MK_LANE_TID();
        const int gw = vcu * 8 + wave, NGW = G * 8;
        for (int m = gw; m < T; m += NGW) {
            const int c1 = TOKPOS[2 * m], c2 = TOKPOS[2 * m + 1];
            const int s1 = MOE_TB[c1 >> 16] * 256 + (c1 & 0xffff), s2 = MOE_TB[c2 >> 16] * 256 + (c2 & 0xffff);
            const GAS f32x4* xr = (const GAS f32x4*)(x + (size_t)m * D) + lane; GAS f32x4* orow = (GAS f32x4*)(out + (size_t)m * D) + lane;
            const GAS u32x2* y1 = (const GAS u32x2*)(YB + (size_t)s1 * D) + lane; const GAS u32x2* y2 = (const GAS u32x2*)(YB + (size_t)s2 * D) + lane; const GAS u32x2* ar = (const GAS u32x2*)(AO + (size_t)m * D) + lane;
#pragma unroll
            for (int j = 0; j < 4; ++j) { f32x4 v = xr[64 * j]; const u32x2 a = y1[64 * j], b = y2[64 * j], c = ar[64 * j];
                v.x += __uint_as_float(c.x << 16) + (__uint_as_float(a.x << 16) + __uint_as_float(b.x << 16)); v.y += __uint_as_float(c.x & 0xffff0000u) + (__uint_as_float(a.x & 0xffff0000u) + __uint_as_float(b.x & 0xffff0000u));
                v.z += __uint_as_float(c.y << 16) + (__uint_as_float(a.y << 16) + __uint_as_float(b.y << 16)); v.w += __uint_as_float(c.y & 0xffff0000u) + (__uint_as_float(a.y & 0xffff0000u) + __uint_as_float(b.y & 0xffff0000u));
                orow[64 * j] = v; }
        }
    }
    if (TS_PHASE >= 0 && blockIdx.x == 0) { if (TS_PHASE == 8) ts_b = __builtin_amdgcn_s_memrealtime(); const unsigned long long t_end = __builtin_amdgcn_s_memrealtime(), dt = ts_b - ts_a;
        while (__builtin_amdgcn_s_memrealtime() - t_end < dt) __builtin_amdgcn_s_sleep(8); }
#undef IN
#undef SEAM
}

extern "C" void kernel_launch(void* const* d_in, const int* in_sizes, int n_in, void* d_out, int out_size, void* d_ws, size_t ws_size, hipStream_t stream) {
    static int grid = 0;
    if (grid == 0) {
        if (n_in != 22 || out_size != T * D || ws_size < WS_END) { fprintf(stderr, "kernel_launch: unexpected shapes (n_in %d out %d ws %zu)\n", n_in, out_size, ws_size); grid = -1; return; }
        if (hipFuncSetAttribute((const void*)mk_fwd, hipFuncAttributeMaxDynamicSharedMemorySize, LDS_BYTES) != hipSuccess) { fprintf(stderr, "kernel_launch: hipFuncSetAttribute failed\n"); grid = -1; return; }
        int dev = 0, cus = 0, per_cu = 0;
        (void)hipGetDevice(&dev); (void)hipDeviceGetAttribute(&cus, hipDeviceAttributeMultiprocessorCount, dev);
        (void)hipOccupancyMaxActiveBlocksPerMultiprocessor(&per_cu, (const void*)mk_fwd, 512, LDS_BYTES);
        (void)hipGetLastError();
        if (cus != 256 || per_cu < 1) fprintf(stderr, "kernel_launch: note: %d CUs, occupancy query %d\n", cus, per_cu);
        grid = 256;
    }
    if (grid < 0) return;
    (void)hipMemsetAsync((char*)d_ws + WS_CTL, 0, CTL_ZERO_BYTES, stream);
    Args a{};
    for (int i = 0; i < 22; ++i) a.in[i] = (const float*)d_in[i];
    a.out = (float*)d_out; a.ws = (unsigned char*)d_ws;
    if (MK_N_LAUNCHES == 1) { a.ph_lo = 0; a.ph_hi = NPHASE; hipLaunchKernelGGL(mk_fwd, dim3(grid), dim3(512), LDS_BYTES, stream, a); }
    else { for (int p = 0; p < NPHASE; ++p) { a.ph_lo = p; a.ph_hi = p + 1; hipLaunchKernelGGL(mk_fwd, dim3(grid), dim3(512), LDS_BYTES, stream, a); } }
}
```
